# Optimizing an MI355X kernel written in HIP

```python
import math
import jax
import jax.numpy as jnp
from jax import lax
import numpy as np

D_MODEL = 2048
BATCH = 2
SEQ = 16384
DEPTH = 2

F32 = jnp.float32
N_EVEN = (DEPTH + 1) // 2
N_ODD = DEPTH // 2
NORM_EPS = 1e-6

HG_WIDTH = D_MODEL // 2
HG_DK = 128
HG_DV = 128
HG_HEADS = HG_WIDTH // HG_DK
HG_CHUNK = 64

RW_WIDTH = D_MODEL // 2
RW_HEAD = 64
RW_HEADS = RW_WIDTH // RW_HEAD
RW_W_RANK = 96
RW_A_RANK = 96
RW_G_RANK = 256
RW_LN_EPS = 64e-5
RW_COLS = 3 * RW_WIDTH + RW_W_RANK + RW_A_RANK + RW_G_RANK
AB_COLS = 4 * HG_WIDTH + RW_COLS

S5_WIDTH = D_MODEL // 2
S5_GROUP = 16
S5_GROUPS = S5_WIDTH // S5_GROUP
S5_STATE = 64
S5_BLOCK = 128
S5_MIN_NEG = 1e-4

FOX_WIDTH = D_MODEL // 2
FOX_HEAD_DIM = 128
FOX_HEADS = FOX_WIDTH // FOX_HEAD_DIM
FOX_BLOCK = 128
CD_COLS = S5_WIDTH + 3 * FOX_WIDTH + FOX_HEADS

MOE_GROUPS = 4
MOE_EPG = 8
MOE_EXPERTS = MOE_GROUPS * MOE_EPG
MOE_TOPK = 2
MOE_FF = 512

kernel_name = 'hybrid_hgrn2_rwkv7_s5_fox_hmoe'


def rmsnorm(x, w, eps=NORM_EPS):
    xf = x.astype(F32)
    y = xf * lax.rsqrt(jnp.mean(xf * xf, axis=-1, keepdims=True) + eps)
    return (y * w.astype(F32)).astype(x.dtype)


def token_shift(p):
    return jnp.pad(p[:, :-1], ((0, 0), (1, 0), (0, 0)))


def hgrn2_recurrence(q, logf, k, v):
    B, T, H, DK = q.shape
    DV = v.shape[-1]
    C = HG_CHUNK
    n = T // C
    def to_chunks(a):
        return a.reshape(B, n, C, H, a.shape[-1]).transpose(1, 0, 3, 2, 4)
    xs = tuple(to_chunks(a.astype(F32)) for a in (q, logf, k, v))
    causal = jnp.tril(jnp.ones((C, C), bool))[None, None, :, :, None]
    def step(S, inp):
        qb, gb, kb, vb = inp
        b = jnp.cumsum(gb, axis=2)
        o_inter = jnp.einsum('bhck,bhkv->bhcv', qb * jnp.exp(b), S)
        diff = jnp.where(causal, b[:, :, :, None, :] - b[:, :, None, :, :], -jnp.inf)
        att = jnp.sum(qb[:, :, :, None, :] * kb[:, :, None, :, :] * jnp.exp(diff), axis=-1)
        o = o_inter + jnp.einsum('bhts,bhsv->bhtv', att, vb)
        b_last = b[:, :, -1:, :]
        S_new = jnp.exp(b_last[:, :, 0, :])[..., None] * S + jnp.einsum('bhck,bhcv->bhkv', kb * jnp.exp(b_last - b), vb)
        return S_new, o
    S0 = jnp.zeros((B, H, DK, DV), F32)
    _, o = lax.scan(step, S0, xs)
    return o.transpose(1, 0, 3, 2, 4).reshape(B, T, H, DV)


def hgrn2_branch(p, lb_logits, layer_idx, norm_w):
    B, T, _ = p.shape
    q, fl, i, g = jnp.split(p.astype(F32), 4, axis=-1)
    lb = jnp.cumsum(jax.nn.softmax(lb_logits.astype(F32), axis=0), axis=0)[layer_idx]
    f = lb + (1.0 - lb) * jax.nn.sigmoid(fl)
    heads = lambda t, d: t.reshape(B, T, HG_HEADS, d)
    o = hgrn2_recurrence(heads(jax.nn.silu(q), HG_DK), heads(jnp.log(f), HG_DK), heads(1.0 - f, HG_DK), heads(i, HG_DV))
    o = o * lax.rsqrt(jnp.mean(o * o, axis=-1, keepdims=True) + NORM_EPS)
    o = o.reshape(B, T, HG_WIDTH) * norm_w.astype(F32) * jax.nn.silu(g)
    return o.astype(p.dtype)


def rwkv7_recurrence(r, w, k, v, a, b):
    B, T, H, N = r.shape
    def step(S, inp):
        rt, wt, kt, vt, at, bt = inp
        sa = jnp.einsum('bhij,bhj->bhi', S, at)
        S = S * wt[:, :, None, :] + sa[..., None] * bt[:, :, None, :] + vt[..., None] * kt[:, :, None, :]
        return S, jnp.einsum('bhij,bhj->bhi', S, rt)
    xs = tuple(jnp.moveaxis(t.astype(F32), 1, 0) for t in (r, w, k, v, a, b))
    _, y = lax.scan(step, jnp.zeros((B, H, N, N), F32), xs)
    return jnp.moveaxis(y, 0, 1)


def rwkv7_branch(p, mu, w0, w2, a0, a2, g2, k_k, k_a, r_k, ln_w, ln_b):
    B, T, _ = p.shape
    pf = p.astype(F32)
    pf = pf + (token_shift(pf) - pf) * mu.astype(F32)
    W = RW_WIDTH
    r, k, v, pw, pa, pg = jnp.split(pf, [W, 2 * W, 3 * W, 3 * W + RW_W_RANK, 3 * W + RW_W_RANK + RW_A_RANK], axis=-1)
    w_log = -jax.nn.softplus(-(w0.astype(F32) + jnp.tanh(pw) @ w2.astype(F32))) - 0.5
    decay = jnp.exp(-jnp.exp(w_log))
    a = jax.nn.sigmoid(a0.astype(F32) + pa @ a2.astype(F32))
    g = jax.nn.sigmoid(pg) @ g2.astype(F32)
    heads = lambda t: t.reshape(B, T, RW_HEADS, RW_HEAD)
    kk = heads(k * k_k.astype(F32))
    kk = kk / jnp.maximum(jnp.sqrt(jnp.sum(kk * kk, axis=-1, keepdims=True)), 1e-12)
    k = k * (1.0 + (a - 1.0) * k_a.astype(F32))
    y = rwkv7_recurrence(heads(r), heads(decay), heads(k), heads(v), -kk, kk * heads(a))
    mean = jnp.mean(y, axis=-1, keepdims=True)
    var = jnp.mean(jnp.square(y - mean), axis=-1, keepdims=True)
    y = ((y - mean) * lax.rsqrt(var + RW_LN_EPS)).reshape(B, T, W) * ln_w.astype(F32) + ln_b.astype(F32)
    bonus = jnp.sum(heads(r) * heads(k) * r_k.astype(F32).reshape(RW_HEADS, RW_HEAD), axis=-1, keepdims=True) * heads(v)
    y = y + bonus.reshape(B, T, W)
    return (y * g).astype(p.dtype)


def s5_branch(u, lam_re, lam_im, log_dt, b_re, b_im, c_re, c_im, d, w_glu, b_glu):
    B, T, _ = u.shape
    L = S5_BLOCK
    nb = T // L
    lr = jnp.minimum(lam_re.astype(F32), -S5_MIN_NEG)
    li = lam_im.astype(F32)
    dt = jnp.exp(log_dt.astype(F32))[:, None]
    mag = jnp.exp(lr * dt)
    ab_re, ab_im = mag * jnp.cos(li * dt), mag * jnp.sin(li * dt)
    nr, ni = ab_re - 1.0, ab_im
    den = lr * lr + li * li
    z_re, z_im = (nr * lr + ni * li) / den, (ni * lr - nr * li) / den
    b_re, b_im = b_re.astype(F32), b_im.astype(F32)
    bb_re = z_re[..., None] * b_re - z_im[..., None] * b_im
    bb_im = z_re[..., None] * b_im + z_im[..., None] * b_re
    c_re, c_im, d = c_re.astype(F32), c_im.astype(F32), d.astype(F32)
    a_re = jnp.broadcast_to(ab_re, (B, L, S5_GROUPS, S5_STATE))
    a_im = jnp.broadcast_to(ab_im, (B, L, S5_GROUPS, S5_STATE))
    ub_all = u.astype(F32).reshape(B, nb, L, S5_GROUPS, S5_GROUP).transpose(1, 0, 2, 3, 4)
    def combine(e1, e2):
        a1r, a1i, b1r, b1i = e1
        a2r, a2i, b2r, b2i = e2
        return (a2r * a1r - a2i * a1i, a2r * a1i + a2i * a1r,
                a2r * b1r - a2i * b1i + b2r, a2r * b1i + a2i * b1r + b2i)
    def step(carry, ub):
        h_re, h_im = carry
        bu_re = jnp.einsum('blgc,gpc->blgp', ub, bb_re)
        bu_im = jnp.einsum('blgc,gpc->blgp', ub, bb_im)
        p_re, p_im, x_re, x_im = lax.associative_scan(combine, (a_re, a_im, bu_re, bu_im), axis=1)
        x_re, x_im = (x_re + p_re * h_re[:, None] - p_im * h_im[:, None],
                      x_im + p_re * h_im[:, None] + p_im * h_re[:, None])
        y = jnp.einsum('blgp,gcp->blgc', x_re, c_re) - jnp.einsum('blgp,gcp->blgc', x_im, c_im) + d * ub
        return (x_re[:, -1], x_im[:, -1]), y
    h0 = (jnp.zeros((B, S5_GROUPS, S5_STATE), F32), jnp.zeros((B, S5_GROUPS, S5_STATE), F32))
    _, y = lax.scan(step, h0, ub_all)
    y = y.transpose(1, 0, 2, 3, 4).reshape(B, T, S5_WIDTH)
    z = jax.nn.gelu(y)
    out = z * jax.nn.sigmoid(z @ w_glu.astype(F32) + b_glu.astype(F32))
    return out.astype(u.dtype)


def fox_branch(p, b_f):
    B, T, _ = p.shape
    q, k, v, fl = jnp.split(p, [FOX_WIDTH, 2 * FOX_WIDTH, 3 * FOX_WIDTH], axis=-1)
    hd = lambda t: t.reshape(B, T, FOX_HEADS, FOX_HEAD_DIM)
    q, k, v = hd(q), hd(k), hd(v)
    logf = jax.nn.log_sigmoid(fl.astype(F32) + b_f.astype(F32))
    cum = jnp.cumsum(logf, axis=1).transpose(0, 2, 1)
    nblk = T // FOX_BLOCK
    q_blocks = q.reshape(B, nblk, FOX_BLOCK, FOX_HEADS, FOX_HEAD_DIM).transpose(1, 0, 2, 3, 4)
    c_blocks = cum.reshape(B, FOX_HEADS, nblk, FOX_BLOCK).transpose(2, 0, 1, 3)
    kpos = jnp.arange(T)
    scale = FOX_HEAD_DIM ** -0.5
    def attend(args):
        qb, cb, bi = args
        s = jnp.einsum('bqhd,bkhd->bhqk', qb, k, preferred_element_type=F32) * scale
        s = s + cb[..., None] - cum[:, :, None, :]
        qpos = bi * FOX_BLOCK + jnp.arange(FOX_BLOCK)
        s = jnp.where((kpos[None, :] <= qpos[:, None])[None, None], s, -jnp.inf)
        w = jax.nn.softmax(s, axis=-1)
        return jnp.einsum('bhqk,bkhd->bqhd', w.astype(v.dtype), v, preferred_element_type=F32)
    o = lax.map(attend, (q_blocks, c_blocks, jnp.arange(nblk)))
    return o.transpose(1, 0, 2, 3, 4).reshape(B, T, FOX_WIDTH).astype(p.dtype)


def hier_moe(h, w_group, b_group, w_router, b_router, w_gate, w_up, w_down):
    B, T, D = h.shape
    xt = h.reshape(B * T, D)
    g_logits = (xt @ w_group).astype(F32) + b_group.astype(F32)
    g_prob = jax.nn.softmax(g_logits, axis=-1)
    _, g_idx = lax.top_k(g_logits, 1)
    g_hot = jax.nn.one_hot(g_idx[:, 0], MOE_GROUPS, dtype=F32)
    g_w = jnp.sum(g_prob * g_hot, axis=-1, keepdims=True)
    e_logits = ((xt @ w_router).astype(F32) + b_router.astype(F32)).reshape(-1, MOE_GROUPS, MOE_EPG)
    e_in = jnp.einsum('nge,ng->ne', e_logits, g_hot)
    top_v, top_i = lax.top_k(e_in, MOE_TOPK)
    top_w = jax.nn.softmax(top_v, axis=-1) * g_w
    expert_id = g_idx * MOE_EPG + top_i
    gates = jnp.sum(jax.nn.one_hot(expert_id, MOE_EXPERTS, dtype=F32) * top_w[..., None], axis=1)
    y = jnp.zeros((B * T, D), F32)
    for e in range(MOE_EXPERTS):
        hid = jax.nn.silu(xt @ w_gate[e]) * (xt @ w_up[e])
        y = y + gates[:, e:e + 1] * jnp.matmul(hid, w_down[e], preferred_element_type=F32)
    return y.reshape(B, T, D).astype(h.dtype)


def setup_inputs(seed: int = 0) -> dict:
    key = jax.random.key(seed)
    kit = iter(list(jax.random.split(key, 48)))
    def nrm(shape, scale):
        return jax.random.normal(next(kit), shape, F32) * scale
    def unif(shape, lo, hi):
        return jax.random.uniform(next(kit), shape, F32, lo, hi)
    def gain(shape):
        return 1.0 + nrm(shape, 0.02)
    ab_out_in = HG_WIDTH + RW_WIDTH
    cd_out_in = S5_WIDTH + FOX_WIDTH
    return {
        'x': nrm((BATCH, SEQ, D_MODEL), 1.0),
        'mix_norm_w': gain((DEPTH, D_MODEL)),
        'ffn_norm_w': gain((DEPTH, D_MODEL)),
        'final_norm_w': gain((D_MODEL,)),
        'ab_w_in': nrm((N_EVEN, D_MODEL, AB_COLS), D_MODEL ** -0.5),
        'ab_w_out': nrm((N_EVEN, ab_out_in, D_MODEL), ab_out_in ** -0.5),
        'hg_lb_logits': nrm((N_EVEN + 1, HG_WIDTH), 0.5),
        'hg_norm_w': gain((N_EVEN, HG_WIDTH)),
        'rw_mu': unif((N_EVEN, RW_COLS), 0.0, 1.0),
        'rw_w0': unif((N_EVEN, RW_WIDTH), -6.0, -1.0),
        'rw_w2': nrm((N_EVEN, RW_W_RANK, RW_WIDTH), 0.1 * RW_W_RANK ** -0.5),
        'rw_a0': nrm((N_EVEN, RW_WIDTH), 0.1),
        'rw_a2': nrm((N_EVEN, RW_A_RANK, RW_WIDTH), 0.1 * RW_A_RANK ** -0.5),
        'rw_g2': nrm((N_EVEN, RW_G_RANK, RW_WIDTH), RW_G_RANK ** -0.5),
        'rw_k_k': 0.85 + nrm((N_EVEN, RW_WIDTH), 0.02),
        'rw_k_a': gain((N_EVEN, RW_WIDTH)),
        'rw_r_k': nrm((N_EVEN, RW_WIDTH), 0.1),
        'rw_ln_w': gain((N_EVEN, RW_WIDTH)),
        'rw_ln_b': nrm((N_EVEN, RW_WIDTH), 0.02),
        'cd_w_in': nrm((N_ODD, D_MODEL, CD_COLS), D_MODEL ** -0.5),
        'cd_w_out': nrm((N_ODD, cd_out_in, D_MODEL), cd_out_in ** -0.5),
        's5_lambda_re': -0.5 + nrm((N_ODD, S5_GROUPS, S5_STATE), 0.01),
        's5_lambda_im': jnp.pi * jnp.arange(S5_STATE, dtype=F32) + nrm((N_ODD, S5_GROUPS, S5_STATE), 0.01),
        's5_log_dt': unif((N_ODD, S5_GROUPS), math.log(0.001), math.log(0.1)),
        's5_b_re': nrm((N_ODD, S5_GROUPS, S5_STATE, S5_GROUP), (2 * S5_GROUP) ** -0.5),
        's5_b_im': nrm((N_ODD, S5_GROUPS, S5_STATE, S5_GROUP), (2 * S5_GROUP) ** -0.5),
        's5_c_re': nrm((N_ODD, S5_GROUPS, S5_GROUP, S5_STATE), (2 * S5_STATE) ** -0.5),
        's5_c_im': nrm((N_ODD, S5_GROUPS, S5_GROUP, S5_STATE), (2 * S5_STATE) ** -0.5),
        's5_d': nrm((N_ODD, S5_GROUPS, S5_GROUP), 1.0),
        's5_w_glu': nrm((N_ODD, S5_WIDTH, S5_WIDTH), S5_WIDTH ** -0.5),
        's5_b_glu': nrm((N_ODD, S5_WIDTH), 0.02),
        'fox_b_f': unif((N_ODD, FOX_HEADS), 1.0, 4.0),
        'moe_w_group': nrm((DEPTH, D_MODEL, MOE_GROUPS), D_MODEL ** -0.5),
        'moe_b_group': nrm((DEPTH, MOE_GROUPS), 0.01),
        'moe_w_router': nrm((DEPTH, D_MODEL, MOE_EXPERTS), D_MODEL ** -0.5),
        'moe_b_router': nrm((DEPTH, MOE_EXPERTS), 0.01),
        'moe_w_gate': nrm((DEPTH, MOE_EXPERTS, D_MODEL, MOE_FF), D_MODEL ** -0.5),
        'moe_w_up': nrm((DEPTH, MOE_EXPERTS, D_MODEL, MOE_FF), D_MODEL ** -0.5),
        'moe_w_down': nrm((DEPTH, MOE_EXPERTS, MOE_FF, D_MODEL), MOE_FF ** -0.5),
    }


def reference(x, mix_norm_w, ffn_norm_w, final_norm_w,
              ab_w_in, ab_w_out, hg_lb_logits, hg_norm_w,
              rw_mu, rw_w0, rw_w2, rw_a0, rw_a2, rw_g2, rw_k_k, rw_k_a, rw_r_k, rw_ln_w, rw_ln_b,
              cd_w_in, cd_w_out, s5_lambda_re, s5_lambda_im, s5_log_dt, s5_b_re, s5_b_im,
              s5_c_re, s5_c_im, s5_d, s5_w_glu, s5_b_glu, fox_b_f,
              moe_w_group, moe_b_group, moe_w_router, moe_b_router, moe_w_gate, moe_w_up, moe_w_down):
    for layer in range(DEPTH):
        j = layer // 2
        h = rmsnorm(x, mix_norm_w[layer])
        if layer % 2 == 0:
            p = h @ ab_w_in[j]
            o_a = hgrn2_branch(p[..., :4 * HG_WIDTH], hg_lb_logits, j, hg_norm_w[j])
            o_b = rwkv7_branch(p[..., 4 * HG_WIDTH:], rw_mu[j], rw_w0[j], rw_w2[j], rw_a0[j], rw_a2[j],
                               rw_g2[j], rw_k_k[j], rw_k_a[j], rw_r_k[j], rw_ln_w[j], rw_ln_b[j])
            mix = jnp.concatenate([o_a, o_b], axis=-1) @ ab_w_out[j]
        else:
            p = h @ cd_w_in[j]
            o_c = s5_branch(p[..., :S5_WIDTH], s5_lambda_re[j], s5_lambda_im[j], s5_log_dt[j],
                            s5_b_re[j], s5_b_im[j], s5_c_re[j], s5_c_im[j], s5_d[j], s5_w_glu[j], s5_b_glu[j])
            o_d = fox_branch(p[..., S5_WIDTH:], fox_b_f[j])
            mix = jnp.concatenate([o_c, o_d], axis=-1) @ cd_w_out[j]
        x = x + mix.astype(x.dtype)
        h = rmsnorm(x, ffn_norm_w[layer])
        x = x + hier_moe(h, moe_w_group[layer], moe_b_group[layer], moe_w_router[layer], moe_b_router[layer],
                         moe_w_gate[layer], moe_w_up[layer], moe_w_down[layer]).astype(x.dtype)
    return rmsnorm(x, final_norm_w)
```

```cpp
#include <hip/hip_runtime.h>
#include <cstdio>
#include <cstdint>
#define MK_ONE_LAUNCH 1
#define MK_DUP -1
#define MK_RWKV_WP 0
#define MK_S5_DYN 1
#define MK_S5_SEP 0
#define MK_S5_SC1 1
#define MK_S5_NT 0
#define MK_S5_SCOPE __HIP_MEMORY_SCOPE_AGENT
namespace pg8 {
#define PG8_LAS __attribute__((address_space(3)))
typedef unsigned short bf16_t;
typedef short bf16x8 __attribute__((ext_vector_type(8)));
typedef float f32x4 __attribute__((ext_vector_type(4)));
typedef unsigned u32x4 __attribute__((ext_vector_type(4)));
constexpr int BM = 256, BK = 64, HALF = 128, HTB = HALF * BK * 2  , STAGE_BYTES = 8 * HTB, NXCD = 8, WGM = 4;

__host__ __device__ __forceinline__ int lds_byte(int r, int c) { const int st = (r >> 4) * 2 + (c >> 5), rr = r & 15, cc = c & 31, ob = rr * 64 + cc * 2; return st * 1024 + (ob ^ (((ob >> 9) & 1) << 5)); }
__host__ __device__ __forceinline__ void stage_rc(int b, int& R, int& C) { const int st = b / 1024, sb = b % 1024, swz = sb ^ (((sb >> 9) & 1) << 5); R = (st >> 1) * 16 + swz / 64; C = (st & 1) * 32 + (swz % 64) / 2; }
__host__ __device__ __forceinline__ int perm32(int rho) { const int n = rho >> 4, i = rho & 15; return 8 * (i >> 2) + 4 * n + (i & 3); }

struct Unit { int pm, pn; };
struct Gemm { const bf16_t* A; const bf16_t* Bt; int M, N, K; };

struct StaticOrder {
    int nM, nN, nwg, G, c;
    __host__ __device__ void init(int M, int N, int G_, int c_) { nM = M / BM; nN = N / BM; nwg = nM * nN; G = G_; c = c_; }
    __host__ __device__ bool next(int i, Unit& u) const {
        const long L = (long)i * G + c; if (L >= nwg) return false;
        int wgid = (int)L; { const int q = nwg / NXCD, r = nwg % NXCD, xcd = wgid % NXCD, off = wgid / NXCD; wgid = (xcd < r ? xcd * (q + 1) : r * (q + 1) + (xcd - r) * q) + off; }
        const int nig = WGM * nN, gid = wgid / nig, fm = gid * WGM, gsz = (nM - fm) < WGM ? (nM - fm) : WGM;
        u.pm = fm + ((wgid % nig) % gsz); u.pn = (wgid % nig) / gsz; return true;
    }
    __device__ __forceinline__ void a_ready(const Unit&) const {}
    __device__ __forceinline__ void done(const Unit&) const {}
};

__device__ __forceinline__ unsigned cvt_pk_bf16(float lo, float hi) { unsigned r; asm volatile("v_cvt_pk_bf16_f32 %0, %1, %2" : "=v"(r) : "v"(lo), "v"(hi)); return r; }
typedef float f32x2 __attribute__((ext_vector_type(2)));
typedef unsigned u32x2 __attribute__((ext_vector_type(2)));
__device__ __forceinline__ float fsigmoid(float x) { return 1.0f / (1.0f + __expf(-x)); }
__device__ __forceinline__ float bflo(unsigned w) { return __uint_as_float(w << 16); }
__device__ __forceinline__ float bfhi(unsigned w) { return __uint_as_float(w & 0xffff0000u); }

struct EpiStoreBf16 {
    static constexpr bool PERM = true, AFTER_DRAIN = false;
    bf16_t* O; int ldc; int colmask;
    __device__ __forceinline__ void operator()(const f32x4 (&acc)[2][2][4][2], const Unit& u, int wr, int wc, int fr, int fq) const {
        const int row0 = u.pm * BM + wr * 64 + fr, col0 = (u.pn & colmask) * BM + wc * 32 + 8 * fq;
#pragma unroll
        for (int ai = 0; ai < 2; ++ai)
#pragma unroll
            for (int m = 0; m < 4; ++m) { bf16_t* rowp = O + (size_t)(row0 + ai * HALF + m * 16) * ldc + col0;
#pragma unroll
                for (int bj = 0; bj < 2; ++bj) { const f32x4 v0 = acc[ai][bj][m][0], v1 = acc[ai][bj][m][1];
                    u32x4 w; w.x = cvt_pk_bf16(v0[0], v0[1]); w.y = cvt_pk_bf16(v0[2], v0[3]); w.z = cvt_pk_bf16(v1[0], v1[1]); w.w = cvt_pk_bf16(v1[2], v1[3]);
                    *(u32x4*)(rowp + bj * HALF) = w; } }
    }
};
struct EpiResF32 {
    static constexpr bool PERM = false, AFTER_DRAIN = false;
    const float* base; float* out; int ldc;
    __device__ __forceinline__ void operator()(const f32x4 (&acc)[2][2][4][2], const Unit& u, int wr, int wc, int fr, int fq) const {
        const int row0 = u.pm * BM + wr * 64 + fr, col0 = u.pn * BM + wc * 32 + 4 * fq;
#pragma unroll
        for (int ai = 0; ai < 2; ++ai)
#pragma unroll
            for (int m = 0; m < 4; ++m) { const size_t off = (size_t)(row0 + ai * HALF + m * 16) * ldc + col0;
#pragma unroll
                for (int bj = 0; bj < 2; ++bj)
#pragma unroll
                    for (int n = 0; n < 2; ++n) { const f32x4 b = *(const f32x4*)(base + off + bj * HALF + n * 16); *(f32x4*)(out + off + bj * HALF + n * 16) = b + acc[ai][bj][m][n]; } }
    }
};
struct EpiGlu {
    static constexpr bool PERM = true, AFTER_DRAIN = false;
    const bf16_t* Z; int ldz; const float* bias; bf16_t* O; int ldo;
    __device__ __forceinline__ void operator()(const f32x4 (&acc)[2][2][4][2], const Unit& u, int wr, int wc, int fr, int fq) const {
        const int row0 = u.pm * BM + wr * 64 + fr, col0 = u.pn * BM + wc * 32 + 8 * fq;
#pragma unroll
        for (int ai = 0; ai < 2; ++ai)
#pragma unroll
            for (int m = 0; m < 4; ++m) { const int row = row0 + ai * HALF + m * 16;
#pragma unroll
                for (int bj = 0; bj < 2; ++bj) { const int col = col0 + bj * HALF;
                    const u32x4 z = *(const u32x4*)(Z + (size_t)row * ldz + col); const f32x4 b0 = *(const f32x4*)(bias + col), b1 = *(const f32x4*)(bias + col + 4);
                    const f32x4 v0 = acc[ai][bj][m][0] + b0, v1 = acc[ai][bj][m][1] + b1;
                    u32x4 w; w.x = cvt_pk_bf16(bflo(z.x) * fsigmoid(v0[0]), bfhi(z.x) * fsigmoid(v0[1])); w.y = cvt_pk_bf16(bflo(z.y) * fsigmoid(v0[2]), bfhi(z.y) * fsigmoid(v0[3]));
                    w.z = cvt_pk_bf16(bflo(z.z) * fsigmoid(v1[0]), bfhi(z.z) * fsigmoid(v1[1])); w.w = cvt_pk_bf16(bflo(z.w) * fsigmoid(v1[2]), bfhi(z.w) * fsigmoid(v1[3]));
                    *(u32x4*)(O + (size_t)row * ldo + col) = w; } }
    }
};
struct EpiSwiGlu {
    static constexpr bool PERM = true, AFTER_DRAIN = false;
    bf16_t* HID; const float* rsp;
    __device__ __forceinline__ void operator()(const f32x4 (&acc)[2][2][4][2], const Unit& u, int wr, int wc, int fr, int fq) const {
        const int row0 = u.pm * BM + wr * 64 + fr, col0 = (u.pn & 3) * HALF + wc * 32 + 8 * fq;
#pragma unroll
        for (int ai = 0; ai < 2; ++ai)
#pragma unroll
            for (int m = 0; m < 4; ++m) { const int row = row0 + ai * HALF + m * 16;
                const float rs = rsp[row]; const f32x4 g0 = acc[ai][0][m][0] * rs, g1 = acc[ai][0][m][1] * rs, u0 = acc[ai][1][m][0] * rs, u1 = acc[ai][1][m][1] * rs;
                u32x4 w;
                w.x = cvt_pk_bf16(g0[0] * fsigmoid(g0[0]) * u0[0], g0[1] * fsigmoid(g0[1]) * u0[1]); w.y = cvt_pk_bf16(g0[2] * fsigmoid(g0[2]) * u0[2], g0[3] * fsigmoid(g0[3]) * u0[3]);
                w.z = cvt_pk_bf16(g1[0] * fsigmoid(g1[0]) * u1[0], g1[1] * fsigmoid(g1[1]) * u1[1]); w.w = cvt_pk_bf16(g1[2] * fsigmoid(g1[2]) * u1[2], g1[3] * fsigmoid(g1[3]) * u1[3]);
                *(u32x4*)(HID + (size_t)row * 512 + col0) = w; }
    }
};
struct MoeOrder {
    const int* tile_e; int ntot, NT, G, c;
    __device__ __forceinline__ bool next(int i, Unit& u) const { const long L = (long)i * G + c; if (L >= ntot) return false; const int pm = (int)(L / NT), nt = (int)(L % NT); u.pm = pm; u.pn = tile_e[pm] * NT + nt; return true; }
    __device__ __forceinline__ void a_ready(const Unit&) const {}
    __device__ __forceinline__ void done(const Unit&) const {}
};

template <class Epi, class Sched, bool ALIGN_EPI = false, bool SP2 = false>
__device__ __forceinline__ void gemm_phase(PG8_LAS unsigned char* lds, const Gemm g, const Sched& S, const Epi& E) {
    int tid_ = threadIdx.x; asm volatile("" : "+v"(tid_));
    const int tid = tid_, wid = __builtin_amdgcn_readfirstlane(tid >> 6), lane = tid & 63, wr = wid >> 2, wc = wid & 3, fr = lane & 15, fq = lane >> 4;
    const int K = g.K, nt = K / BK;
    unsigned voffA[2], voffB[2];
#pragma unroll
    for (int i = 0; i < 2; ++i) { int R, C; stage_rc(tid * 16 + i * 8192, R, C); const int Rb = Epi::PERM ? ((R & ~31) + perm32(R & 31)) : R;
        voffA[i] = (unsigned)(R * K + C) * 2u; voffB[i] = (unsigned)(Rb * K + C) * 2u; }
    const size_t kstep = (size_t)(BK * 2);
    const size_t hstep = (size_t)HALF * K * 2;
    const size_t tstep = 2 * hstep;
    const unsigned ldsw = (unsigned)wid * 1024u;
    const int aoff = lds_byte(wr * 64 + fr, fq * 8), boff = lds_byte(wc * 32 + fr, fq * 8);
#define PG8_SA(b, h) (((b) * 2 + (h)) * HTB)
#define PG8_SB(b, h) ((4 + (b) * 2 + (h)) * HTB)
#define PG8_STAGE(bufoff, gbase, voff) do { _Pragma("unroll") for (int _i = 0; _i < 2; ++_i) \
        __builtin_amdgcn_global_load_lds((const unsigned*)((const char*)(gbase) + (voff)[_i]), (PG8_LAS unsigned*)(lds + (bufoff) + ldsw + _i * 8192), 16, 0, 0); } while (0)
#define PG8_LDA(dst, b, h) do { _Pragma("unroll") for (int m = 0; m < 4; ++m) _Pragma("unroll") for (int k = 0; k < 2; ++k) dst[m][k] = *(const PG8_LAS bf16x8*)(lds + PG8_SA(b, h) + aoff + m * 2048 + k * 1024); } while (0)
#define PG8_LDB(dst, b, h) do { _Pragma("unroll") for (int n = 0; n < 2; ++n) _Pragma("unroll") for (int k = 0; k < 2; ++k) dst[n][k] = *(const PG8_LAS bf16x8*)(lds + PG8_SB(b, h) + boff + n * 2048 + k * 1024); } while (0)
#define PG8_MMA(ai, bj, At, Bt) do { __builtin_amdgcn_s_setprio(1); _Pragma("unroll") for (int m = 0; m < 4; ++m) _Pragma("unroll") for (int n = 0; n < 2; ++n) _Pragma("unroll") for (int k = 0; k < 2; ++k) \
        acc[ai][bj][m][n] = __builtin_amdgcn_mfma_f32_16x16x32_bf16(Bt[n][k], At[m][k], acc[ai][bj][m][n], 0, 0, 0); __builtin_amdgcn_s_setprio(0); } while (0)
#define PG8_WAIT_V(n) asm volatile("s_waitcnt vmcnt(" #n ")" ::: "memory")
#define PG8_WAIT_L(n) asm volatile("s_waitcnt lgkmcnt(" #n ")" ::: "memory")
#define PG8_BAR __builtin_amdgcn_s_barrier()
#define PG8_SCHED __builtin_amdgcn_sched_barrier(0)
    Unit cur, nxt; int ui = 0;
    if (!S.next(0, cur)) return;
    f32x4 acc[2][2][4][2];
#pragma unroll
    for (int a = 0; a < 2; ++a)
#pragma unroll
        for (int b = 0; b < 2; ++b)
#pragma unroll
            for (int m = 0; m < 4; ++m)
#pragma unroll
                for (int n = 0; n < 2; ++n) acc[a][b][m][n] = (f32x4){0.f, 0.f, 0.f, 0.f};
    bf16x8 At[4][2], B0[2][2], B1[2][2];
    const char* cA = (const char*)g.A + (size_t)cur.pm * tstep; const char* cB = (const char*)g.Bt + (size_t)cur.pn * tstep;
    S.a_ready(cur);
    if constexpr (SP2) {
        PG8_STAGE(PG8_SB(0, 0), cB, voffB); PG8_STAGE(PG8_SB(0, 1), cB + hstep, voffB); PG8_STAGE(PG8_SA(0, 0), cA, voffA); PG8_STAGE(PG8_SA(0, 1), cA + hstep, voffA);
        if (wr == 1) PG8_BAR;
        PG8_WAIT_V(2); PG8_BAR;
        PG8_STAGE(PG8_SB(1, 0), cB + kstep, voffB); PG8_STAGE(PG8_SA(1, 0), cA + kstep, voffA); PG8_STAGE(PG8_SB(1, 1), cB + hstep + kstep, voffB);
        PG8_WAIT_V(6); PG8_BAR;
    } else {
        PG8_STAGE(PG8_SB(0, 0), cB, voffB); PG8_STAGE(PG8_SA(0, 0), cA, voffA); PG8_STAGE(PG8_SB(0, 1), cB + hstep, voffB); PG8_STAGE(PG8_SA(0, 1), cA + hstep, voffA);
        if (wr == 1) PG8_BAR;
        PG8_WAIT_V(4); PG8_BAR;
        PG8_STAGE(PG8_SB(1, 0), cB + kstep, voffB); PG8_STAGE(PG8_SA(1, 0), cA + kstep, voffA); PG8_STAGE(PG8_SB(1, 1), cB + hstep + kstep, voffB);
        PG8_WAIT_V(6); PG8_BAR;
    }
    for (;;) {
        const bool has_next = S.next(ui + 1, nxt);
        const char* nA = has_next ? (const char*)g.A + (size_t)nxt.pm * tstep : cA; const char* nB = has_next ? (const char*)g.Bt + (size_t)nxt.pn * tstep : cB;
        for (int t = 0; t < nt; t += 2) {
            const bool last = (t == nt - 2);
            const char* a1 = cA + (size_t)(t + 1) * kstep;
            const char* a2 = last ? nA : cA + (size_t)(t + 2) * kstep; const char* b2 = last ? nB : cB + (size_t)(t + 2) * kstep;
            const char* a3 = a2 + kstep; const char* b3 = b2 + kstep;
            if (last && has_next) S.a_ready(nxt);
            if constexpr (SP2) {
            PG8_LDB(B0, 0, 0); PG8_LDB(B1, 0, 1); PG8_SCHED; PG8_LDA(At, 0, 0); PG8_STAGE(PG8_SA(1, 1), a1 + hstep, voffA);
            PG8_WAIT_V(8); PG8_WAIT_L(0); PG8_BAR; PG8_MMA(0, 0, At, B0); PG8_MMA(0, 1, At, B1); PG8_BAR; PG8_SCHED;
            PG8_LDA(At, 0, 1); PG8_STAGE(PG8_SB(0, 0), b2, voffB); PG8_STAGE(PG8_SB(0, 1), b2 + hstep, voffB); PG8_STAGE(PG8_SA(0, 0), a2, voffA);
            PG8_WAIT_V(8); PG8_WAIT_L(0); PG8_BAR; PG8_MMA(1, 0, At, B0); PG8_MMA(1, 1, At, B1); PG8_BAR; PG8_SCHED;
            PG8_LDB(B0, 1, 0); PG8_LDB(B1, 1, 1); PG8_SCHED; PG8_LDA(At, 1, 0); PG8_STAGE(PG8_SA(0, 1), a2 + hstep, voffA);
            PG8_WAIT_V(8); PG8_WAIT_L(0); PG8_BAR; PG8_MMA(0, 0, At, B0); PG8_MMA(0, 1, At, B1); PG8_BAR; PG8_SCHED;
            PG8_LDA(At, 1, 1); PG8_STAGE(PG8_SB(1, 0), b3, voffB); PG8_STAGE(PG8_SB(1, 1), b3 + hstep, voffB); PG8_STAGE(PG8_SA(1, 0), a3, voffA);
            PG8_WAIT_V(8); PG8_WAIT_L(0); PG8_BAR; PG8_MMA(1, 0, At, B0); PG8_MMA(1, 1, At, B1); PG8_BAR; PG8_SCHED;
            } else {
            PG8_LDB(B0, 0, 0); PG8_SCHED; PG8_LDA(At, 0, 0); PG8_STAGE(PG8_SA(1, 1), a1 + hstep, voffA);
            PG8_WAIT_L(8); PG8_BAR; PG8_WAIT_L(0); PG8_MMA(0, 0, At, B0); PG8_BAR; PG8_SCHED;
            PG8_LDB(B1, 0, 1); PG8_STAGE(PG8_SB(0, 0), b2, voffB);
            PG8_BAR; PG8_WAIT_L(0); PG8_MMA(0, 1, At, B1); PG8_BAR;
            PG8_LDA(At, 0, 1); PG8_STAGE(PG8_SA(0, 0), a2, voffA);
            PG8_BAR; PG8_WAIT_L(0); PG8_MMA(1, 0, At, B0); PG8_BAR; PG8_SCHED;
            PG8_STAGE(PG8_SB(0, 1), b2 + hstep, voffB);
            PG8_WAIT_V(6); PG8_BAR; PG8_MMA(1, 1, At, B1); PG8_BAR;
            PG8_LDB(B0, 1, 0); PG8_SCHED; PG8_LDA(At, 1, 0); PG8_STAGE(PG8_SA(0, 1), a2 + hstep, voffA);
            PG8_WAIT_L(8); PG8_BAR; PG8_WAIT_L(0); PG8_MMA(0, 0, At, B0); PG8_BAR; PG8_SCHED;
            PG8_LDB(B1, 1, 1); PG8_STAGE(PG8_SB(1, 0), b3, voffB);
            PG8_BAR; PG8_WAIT_L(0); PG8_MMA(0, 1, At, B1); PG8_BAR;
            PG8_LDA(At, 1, 1); PG8_STAGE(PG8_SA(1, 0), a3, voffA);
            PG8_BAR; PG8_WAIT_L(0); PG8_MMA(1, 0, At, B0); PG8_BAR; PG8_SCHED;
            PG8_STAGE(PG8_SB(1, 1), b3 + hstep, voffB);
            PG8_WAIT_V(6); PG8_BAR; PG8_MMA(1, 1, At, B1); PG8_BAR;
            }
        }
        if constexpr (ALIGN_EPI) { if (wr == 0) PG8_BAR; }
        if constexpr (!Epi::AFTER_DRAIN) { E(acc, cur, wr, wc, fr, fq); S.done(cur); }
        if (!has_next) break;
#pragma unroll
        for (int a = 0; a < 2; ++a)
#pragma unroll
            for (int b = 0; b < 2; ++b)
#pragma unroll
                for (int m = 0; m < 4; ++m)
#pragma unroll
                    for (int n = 0; n < 2; ++n) acc[a][b][m][n] = (f32x4){0.f, 0.f, 0.f, 0.f};
        cur = nxt; cA = nA; cB = nB; ++ui;
        if constexpr (ALIGN_EPI) { if (wr == 1) PG8_BAR; }
    }
    PG8_WAIT_V(0);
    if constexpr (!ALIGN_EPI) { if (wr == 0) PG8_BAR; }
    PG8_BAR;
    if constexpr (Epi::AFTER_DRAIN) { E.fused(acc, cur, wr, wc, fr, fq, lds, wid, lane); S.done(cur); }
#undef PG8_SA
#undef PG8_SB
#undef PG8_STAGE
#undef PG8_LDA
#undef PG8_LDB
#undef PG8_MMA
#undef PG8_WAIT_V
#undef PG8_WAIT_L
#undef PG8_BAR
#undef PG8_SCHED
}
}
#define XB_TMO      128
#define XB_XCNT(j)  (256  + 64 * (j))
#define XB_XSUB(j)  (1280 + 64 * (j))
#define XB_XGEN(j)  (2304 + 64 * (j))
#define XB_TOP      3328
#define XB_TOPGEN   3392
#define XCD_BAR_WORDS 3456
#define XB_SPIN_CAP (1u << 22)
#define LAS __attribute__((address_space(3)))

__device__ __forceinline__ unsigned xb_ld(unsigned* p)              { return __hip_atomic_load(p, __ATOMIC_RELAXED, __HIP_MEMORY_SCOPE_AGENT); }
__device__ __forceinline__ unsigned xb_add(unsigned* p, unsigned v) { return __hip_atomic_fetch_add(p, v, __ATOMIC_RELAXED, __HIP_MEMORY_SCOPE_AGENT); }
__device__ __forceinline__ unsigned xb_xcc_id() { return (unsigned)__builtin_amdgcn_s_getreg((3 << 11) | 20) & 0xFu; }
#define XB_SPIN(cond, bar) do { unsigned _sp = 0; while (cond) { __builtin_amdgcn_s_sleep(1); \
    if ((++_sp & 255u) == 0u) { if (xb_ld(&(bar)[XB_TMO])) break; if (_sp > XB_SPIN_CAP) { atomicAdd(&(bar)[XB_TMO], 1u); break; } } } } while (0)

struct XcdBarrier {
    unsigned* bar; unsigned x;
    volatile LAS unsigned* st;
};

__device__ __forceinline__ XcdBarrier xcd_barrier_post(unsigned* bar, volatile LAS unsigned* st) {
    XcdBarrier b; b.bar = bar; b.x = xb_xcc_id(); b.st = st;
    if (threadIdx.x == 0) (void)xb_add(&bar[XB_XCNT(b.x)], 1u);
    return b;
}
__device__ __forceinline__ void xcd_barrier_complete(unsigned* bar, unsigned x, unsigned& nloc, unsigned& nx) {
    const unsigned G = gridDim.x * gridDim.y * gridDim.z;
    unsigned sum, cnt, mine, sp = 0u;
    for (;;) {
        sum = 0u; cnt = 0u; mine = 0u;
#pragma unroll
        for (unsigned j = 0; j < 16; ++j) { const unsigned c = xb_ld(&bar[XB_XCNT(j)]); sum += c; cnt += (c > 0u) ? 1u : 0u; mine = (j == x) ? c : mine; }
        if (sum == G) break;
        __builtin_amdgcn_s_sleep(1);
        if ((++sp & 255u) == 0u) { if (xb_ld(&bar[XB_TMO])) break; if (sp > XB_SPIN_CAP) { atomicAdd(&bar[XB_TMO], 1u); break; } }
    }
    nloc = mine > 0u ? mine : 1u; nx = cnt > 0u ? cnt : 1u;
}

__device__ __forceinline__ void xcd_barrier(const XcdBarrier& b) {
    asm volatile("s_waitcnt vmcnt(0)" ::: "memory");
    __syncthreads();
    if (threadIdx.x == 0) {
        unsigned* bar = b.bar;
        __builtin_amdgcn_s_waitcnt(0);
        unsigned nloc = b.st[0], nx = b.st[1];
        if (nloc == 0u) { xcd_barrier_complete(bar, b.x, nloc, nx); b.st[0] = nloc; b.st[1] = nx; }
        const unsigned old = xb_add(&bar[XB_XSUB(b.x)], 1u);
        const unsigned gen = old / nloc;
        if (old + 1u == (gen + 1u) * nloc) {
            __builtin_amdgcn_fence(__ATOMIC_RELEASE, "agent");
            asm volatile("s_waitcnt vmcnt(0)" ::: "memory");
            const unsigned og = xb_add(&bar[XB_TOP], 1u);
            const unsigned tg = og / nx;
            if (og + 1u == (tg + 1u) * nx) xb_add(&bar[XB_TOPGEN], 1u);
            else XB_SPIN(xb_ld(&bar[XB_TOPGEN]) == tg, bar);
            __builtin_amdgcn_fence(__ATOMIC_ACQUIRE, "agent");
            xb_add(&bar[XB_XGEN(b.x)], 1u);
            asm volatile("s_waitcnt vmcnt(0)" ::: "memory");
        } else {
            XB_SPIN(xb_ld(&bar[XB_XGEN(b.x)]) == gen, bar);
            __builtin_amdgcn_fence(__ATOMIC_ACQUIRE, "agent");
            asm volatile("s_waitcnt vmcnt(0)" ::: "memory");
        }
    }
    __syncthreads();
}

namespace mk {
using pg8::bf16_t; using pg8::f32x4; using pg8::u32x4; using pg8::u32x2; using pg8::cvt_pk_bf16; using pg8::bflo; using pg8::bfhi; using pg8::fsigmoid;
#define MK_LAS __attribute__((address_space(3)))
__device__ __forceinline__ int otid() { int t = threadIdx.x; asm volatile("" : "+v"(t)); return t; }
#define MK_TID otid()

constexpr int NB = 2, T = 16384, D = 2048, NTOK = NB * T;
constexpr int AB_COLS = 7616, AB_LD = 7680, RWO = 4096;
constexpr int CD_COLS = 4104, CD_LD = 4096;
constexpr int NEXP = 32, FF = 512, ROWS_MAX = 2 * NTOK + NEXP * 256;
constexpr float NORM_EPS = 1e-6f;

constexpr size_t MiB = 1u << 20;
constexpr size_t WS_CTL = 0, CTL_ZERO = 1 * MiB;
constexpr size_t WS_HIST = 1 * MiB, WS_TILEE = 1 * MiB + 64 * 1024, WS_NT = 1 * MiB + 96 * 1024;
constexpr size_t WS_RE = 2 * MiB, WS_RWT = 3 * MiB, WS_POS = 4 * MiB, WS_LOGF = 5 * MiB, WS_CUM = 6 * MiB;
constexpr size_t WS_ABIN = 16 * MiB, WS_ABOUT = 46 * MiB, WS_CDIN = 54 * MiB, WS_CDOUT = 70 * MiB, WS_GLU = 78 * MiB;
constexpr size_t WS_GU = 80 * MiB, WS_DN = 208 * MiB;
constexpr size_t WS_H = 272 * MiB, WS_O = 400 * MiB, WS_P = 528 * MiB, WS_SCR = 1008 * MiB, WS_END = 1136 * MiB;
constexpr size_t WS_HID = WS_P + 288 * MiB;

constexpr int LDS_RING = 128 * 1024, LDS_MISC = 144 * 1024, LDS_BYTES = LDS_MISC + 4096;

struct Args { const float* in[39]; float* out; unsigned char* ws; int ph_lo, ph_hi; };
enum { I_X = 0, I_MIXW, I_FFNW, I_FINW, I_ABIN, I_ABOUT, I_HGLB, I_HGNW, I_RWMU, I_RWW0, I_RWW2, I_RWA0, I_RWA2, I_RWG2, I_RWKK, I_RWKA, I_RWRK, I_RWLNW, I_RWLNB,
       I_CDIN, I_CDOUT, I_S5LR, I_S5LI, I_S5DT, I_S5BR, I_S5BI, I_S5CR, I_S5CI, I_S5D, I_S5GLU, I_S5BG, I_FOXB, I_MWG, I_MBG, I_MWR, I_MBR, I_MGATE, I_MUP, I_MDOWN };

__device__ __forceinline__ float bf2f(bf16_t v) { return __uint_as_float((unsigned)v << 16); }
__device__ __forceinline__ float wave_sum(float v) {
#pragma unroll
    for (int o = 32; o > 0; o >>= 1) v += __shfl_xor(v, o); return v; }
__device__ __forceinline__ float wave_max(float v) {
#pragma unroll
    for (int o = 32; o > 0; o >>= 1) v = fmaxf(v, __shfl_xor(v, o)); return v; }
__device__ __forceinline__ float softplusf(float x) { return fmaxf(x, 0.f) + log1pf(__expf(-fabsf(x))); }
__device__ __forceinline__ float siluf(float x) { return x * fsigmoid(x); }
__device__ __forceinline__ float gelu_tanh(float y) { const float u = 0.7978845608028654f * (y + 0.044715f * y * y * y); return 0.5f * y * (1.0f + tanhf(u)); }

struct TileDesc { const float* src; bf16_t* dst; int ldn, k0, n0, nvalid, K, row0; };
__device__ __forceinline__ void tile_load(const TileDesc& d, f32x4 (&v)[2]) {
    const int tid = MK_TID;
#pragma unroll
    for (int i = 0; i < 2; ++i) { const int k = (tid >> 4) + 32 * i, n4 = (tid & 15) * 4;
        v[i] = (f32x4){0.f, 0.f, 0.f, 0.f}; if (d.n0 + n4 < d.nvalid) v[i] = *(const f32x4*)(d.src + (size_t)(d.k0 + k) * d.ldn + d.n0 + n4); }
}
__device__ __forceinline__ void tile_store(const TileDesc& d, const f32x4 (&v)[2], MK_LAS float* scr) {
    const int tid = MK_TID;
#pragma unroll
    for (int i = 0; i < 2; ++i) { const int k = (tid >> 4) + 32 * i, n4 = (tid & 15) * 4;
        scr[(n4 + 0) * 65 + k] = v[i][0]; scr[(n4 + 1) * 65 + k] = v[i][1]; scr[(n4 + 2) * 65 + k] = v[i][2]; scr[(n4 + 3) * 65 + k] = v[i][3]; }
    __syncthreads();
    { const int n = tid >> 3, k8 = (tid & 7) * 8; const MK_LAS float* s = scr + n * 65 + k8;
      u32x4 w; w.x = cvt_pk_bf16(s[0], s[1]); w.y = cvt_pk_bf16(s[2], s[3]); w.z = cvt_pk_bf16(s[4], s[5]); w.w = cvt_pk_bf16(s[6], s[7]);
      *(u32x4*)(d.dst + (size_t)(d.row0 + n) * d.K + d.k0 + k8) = w; }
    __syncthreads();
}
constexpr int IT_ABIN = 32 * 120, IT_ABOUT = 32 * 32, IT_CDIN = 32 * 64, IT_CDOUT = 32 * 32, IT_GLU = 16 * 16, IT_PROJ = IT_ABIN + IT_ABOUT + IT_CDIN + IT_CDOUT + IT_GLU;
constexpr int IT_GU = 32 * 32 * 16, IT_DN = 32 * 8 * 32, IT_MOE = IT_GU + IT_DN;
__device__ __forceinline__ TileDesc proj_item(const Args& a, int r) {
    unsigned char* ws = a.ws;
    if (r < IT_ABIN) return TileDesc{a.in[I_ABIN], (bf16_t*)(ws + WS_ABIN), AB_COLS, (r / 120) * 64, (r % 120) * 64, AB_COLS, D, (r % 120) * 64}; r -= IT_ABIN;
    if (r < IT_ABOUT) return TileDesc{a.in[I_ABOUT], (bf16_t*)(ws + WS_ABOUT), D, (r / 32) * 64, (r % 32) * 64, D, D, (r % 32) * 64}; r -= IT_ABOUT;
    if (r < IT_CDIN) return TileDesc{a.in[I_CDIN], (bf16_t*)(ws + WS_CDIN), CD_COLS, (r / 64) * 64, (r % 64) * 64, CD_COLS, D, (r % 64) * 64}; r -= IT_CDIN;
    if (r < IT_CDOUT) return TileDesc{a.in[I_CDOUT], (bf16_t*)(ws + WS_CDOUT), D, (r / 32) * 64, (r % 32) * 64, D, D, (r % 32) * 64}; r -= IT_CDOUT;
    return TileDesc{a.in[I_S5GLU], (bf16_t*)(ws + WS_GLU), 1024, (r / 16) * 64, (r % 16) * 64, 1024, 1024, (r % 16) * 64};
}
__device__ __forceinline__ TileDesc moe_item(const Args& a, int layer, int r) {
    unsigned char* ws = a.ws;
    if (r < IT_GU) { const int e = r / 512, rem = r % 512, kt = rem / 16, q = rem % 16, j = q >> 2, half = (q >> 1) & 1, sub = q & 1;
        const float* src = (half ? a.in[I_MUP] : a.in[I_MGATE]) + (size_t)(layer * NEXP + e) * D * FF;
        return TileDesc{src, (bf16_t*)(ws + WS_GU), FF, kt * 64, 128 * j + 64 * sub, FF, D, e * 1024 + 256 * j + 128 * half + 64 * sub}; }
    r -= IT_GU;
    { const int e = r / 256, rem = r % 256, kt = rem / 32, nt = rem % 32;
      const float* src = a.in[I_MDOWN] + (size_t)(layer * NEXP + e) * FF * D;
      return TileDesc{src, (bf16_t*)(ws + WS_DN), D, kt * 64, nt * 64, D, FF, e * D + nt * 64}; }
}
template <int KIND> __device__ __forceinline__ void convert_items(const Args& a, MK_LAS float* scr) {
    constexpr int NIT = (KIND == 0) ? IT_PROJ : IT_MOE; const int G = (int)gridDim.x;
    int it = (int)blockIdx.x; if (it >= NIT) return;
    f32x4 v0[2], v1[2], v2[2]; TileDesc d0 = (KIND == 0) ? proj_item(a, it) : moe_item(a, KIND - 1, it), d1 = d0, d2 = d0;
    tile_load(d0, v0);
    const bool has1 = it + G < NIT; if (has1) { d1 = (KIND == 0) ? proj_item(a, it + G) : moe_item(a, KIND - 1, it + G); tile_load(d1, v1); }
    for (;;) { const int n2 = it + 2 * G; const bool more2 = n2 < NIT, more1 = it + G < NIT;
        if (more2) { d2 = (KIND == 0) ? proj_item(a, n2) : moe_item(a, KIND - 1, n2); tile_load(d2, v2); }
        tile_store(d0, v0, scr);
        if (!more1) break;
        v0[0] = v1[0]; v0[1] = v1[1]; d0 = d1; v1[0] = v2[0]; v1[1] = v2[1]; d1 = d2; it += G; }
}

__device__ __forceinline__ float row_rstd(const f32x4 (&v)[8]) {
    float s = 0.f;
#pragma unroll
    for (int j = 0; j < 8; ++j) s += (v[j][0] * v[j][0] + v[j][1] * v[j][1]) + (v[j][2] * v[j][2] + v[j][3] * v[j][3]);
    return rsqrtf(wave_sum(s) * (1.0f / D) + NORM_EPS);
}
__device__ __forceinline__ void norm_scale(f32x4 (&v)[8], float rstd, const float* w, int lane) {
#pragma unroll
    for (int j = 0; j < 8; ++j) { const f32x4 g = *(const f32x4*)(w + 4 * (lane + 64 * j)); v[j] = v[j] * rstd * g; }
}
__device__ __forceinline__ void store_row_bf16(const f32x4 (&v)[8], bf16_t* orow, int lane) {
#pragma unroll
    for (int j = 0; j < 8; ++j) { u32x2 w; w.x = cvt_pk_bf16(v[j][0], v[j][1]); w.y = cvt_pk_bf16(v[j][2], v[j][3]); *(u32x2*)(orow + 4 * (lane + 64 * j)) = w; }
}

__device__ __forceinline__ void ph_prologue(const Args& a, MK_LAS unsigned char* lds) {
    MK_LAS float* scr = (MK_LAS float*)lds;
    convert_items<0>(a, scr); convert_items<1>(a, scr);
    const int lane = MK_TID & 63, gw = blockIdx.x * 8 + (MK_TID >> 6), NGW = gridDim.x * 8;
    bf16_t* H = (bf16_t*)(a.ws + WS_H);
    for (int m = gw; m < NTOK; m += NGW) {
        const float* xr = a.in[I_X] + (size_t)m * D; f32x4 v[8];
#pragma unroll
        for (int j = 0; j < 8; ++j) v[j] = *(const f32x4*)(xr + 4 * (lane + 64 * j));
        const float rstd = row_rstd(v); norm_scale(v, rstd, a.in[I_MIXW], lane); store_row_bf16(v, H + (size_t)m * D, lane);
    }
}

__device__ __forceinline__ void ph_hgrn2_naive(const Args& a, MK_LAS unsigned char* lds) {
    constexpr int TS = 8;
    const int tid = MK_TID, grp = tid >> 7, v = tid & 127, s = blockIdx.x * 4 + grp, b = s >> 3, hh = s & 7;
    const bf16_t* P = (const bf16_t*)(a.ws + WS_P); float* raw = (float*)(a.ws + WS_H);
    MK_LAS float* Lq = (MK_LAS float*)lds + grp * (3 * TS * 128); MK_LAS float* Lf = Lq + TS * 128; MK_LAS float* Lk = Lf + TS * 128;
    const int c = hh * 128 + v;
    const float l0 = a.in[I_HGLB][c], l1 = a.in[I_HGLB][1024 + c]; const float mx = fmaxf(l0, l1), e0 = __expf(l0 - mx), e1 = __expf(l1 - mx), lb = e0 / (e0 + e1);
    float S[128];
#pragma unroll
    for (int k = 0; k < 128; ++k) S[k] = 0.f;
    for (int t0 = 0; t0 < T; t0 += TS) {
#pragma unroll
        for (int tt = 0; tt < TS; ++tt) { const size_t row = (size_t)b * T + t0 + tt;
            const float q = bf2f(P[row * AB_LD + c]), fl = bf2f(P[row * AB_LD + 1024 + c]);
            const float f = lb + (1.0f - lb) * fsigmoid(fl);
            Lq[tt * 128 + v] = siluf(q); Lf[tt * 128 + v] = f; Lk[tt * 128 + v] = 1.0f - f; }
        __syncthreads();
        for (int tt = 0; tt < TS; ++tt) { const size_t row = (size_t)b * T + t0 + tt;
            const float vi = bf2f(P[row * AB_LD + 2048 + c]); float o = 0.f;
#pragma unroll
            for (int k4 = 0; k4 < 32; ++k4) { const f32x4 q = *(const MK_LAS f32x4*)(Lq + tt * 128 + 4 * k4), f = *(const MK_LAS f32x4*)(Lf + tt * 128 + 4 * k4), kd = *(const MK_LAS f32x4*)(Lk + tt * 128 + 4 * k4);
#pragma unroll
                for (int i = 0; i < 4; ++i) { S[4 * k4 + i] = f[i] * S[4 * k4 + i] + kd[i] * vi; o += S[4 * k4 + i] * q[i]; } }
            raw[row * 1024 + c] = o; }
        __syncthreads();
    }
}

__device__ __forceinline__ float rw_pf(const bf16_t* P, const float* mu, size_t row, int t, int col) {
    const float cur = bf2f(P[row * AB_LD + RWO + col]); const float prv = (t == 0) ? 0.f : bf2f(P[(row - 1) * AB_LD + RWO + col]);
    return cur + (prv - cur) * mu[col];
}
__device__ __forceinline__ void ph_rwkv_naive(const Args& a, MK_LAS unsigned char* lds) {
    constexpr int TS = 16;
    const int tid = MK_TID, s = blockIdx.x - 4, b = s >> 4, hh = s & 15;
    const bf16_t* P = (const bf16_t*)(a.ws + WS_P); float* yraw = (float*)(a.ws + WS_SCR);
    const float* mu = a.in[I_RWMU];
    MK_LAS float* Lr = (MK_LAS float*)lds; MK_LAS float* Lw = Lr + TS * 64; MK_LAS float* Lk = Lw + TS * 64; MK_LAS float* Lv = Lk + TS * 64; MK_LAS float* La = Lv + TS * 64; MK_LAS float* Lb = La + TS * 64;
    MK_LAS float* Lkk = Lb + TS * 64; MK_LAS float* Ltw = Lkk + TS * 64; MK_LAS float* Lpa = Ltw + TS * 96;
    float S[64];
#pragma unroll
    for (int j = 0; j < 64; ++j) S[j] = 0.f;
    for (int t0 = 0; t0 < T; t0 += TS) {
        for (int i = tid; i < TS * 96; i += 512) { const int tt = i / 96, m = i % 96; const size_t row = (size_t)b * T + t0 + tt;
            Ltw[i] = tanhf(rw_pf(P, mu, row, t0 + tt, 3072 + m)); Lpa[i] = rw_pf(P, mu, row, t0 + tt, 3168 + m); }
        __syncthreads();
        float kreg[2], agreg[2];
#pragma unroll
        for (int q = 0; q < 2; ++q) { const int i = tid + 512 * q, tt = i >> 6, ch = i & 63, c = hh * 64 + ch; const size_t row = (size_t)b * T + t0 + tt;
            const float r = rw_pf(P, mu, row, t0 + tt, c), k = rw_pf(P, mu, row, t0 + tt, 1024 + c), v = rw_pf(P, mu, row, t0 + tt, 2048 + c);
            float lw = a.in[I_RWW0][c], la = a.in[I_RWA0][c];

_Pragma("unroll 8")
            for (int m = 0; m < 96; ++m) { lw += Ltw[tt * 96 + m] * a.in[I_RWW2][m * 1024 + c]; la += Lpa[tt * 96 + m] * a.in[I_RWA2][m * 1024 + c]; }
            const float wlog = -softplusf(-lw) - 0.5f, decay = __expf(-__expf(wlog)), ag = fsigmoid(la);
            Lr[i] = r; Lw[i] = decay; Lv[i] = v; Lkk[i] = k * a.in[I_RWKK][c]; kreg[q] = k; agreg[q] = ag; }
        __syncthreads();
#pragma unroll
        for (int q = 0; q < 2; ++q) { const int i = tid + 512 * q, tt = i >> 6, ch = i & 63, c = hh * 64 + ch;
            float ss = 0.f;
_Pragma("unroll 8")
            for (int j = 0; j < 64; ++j) { const float x = Lkk[tt * 64 + j]; ss += x * x; }
            const float kk = Lkk[i] / fmaxf(sqrtf(ss), 1e-12f);
            Lk[i] = kreg[q] * (1.0f + (agreg[q] - 1.0f) * a.in[I_RWKA][c]); La[i] = -kk; Lb[i] = kk * agreg[q]; }
        __syncthreads();
        if (tid < 64) {
            for (int tt = 0; tt < TS; ++tt) { const size_t row = (size_t)b * T + t0 + tt;
                float sa = 0.f;
#pragma unroll
                for (int j = 0; j < 64; ++j) sa += S[j] * La[tt * 64 + j];
                const float vi = Lv[tt * 64 + tid]; float y = 0.f;
#pragma unroll
                for (int j = 0; j < 64; ++j) { S[j] = S[j] * Lw[tt * 64 + j] + sa * Lb[tt * 64 + j] + vi * Lk[tt * 64 + j]; y += S[j] * Lr[tt * 64 + j]; }
                yraw[row * 1024 + hh * 64 + tid] = y; }
        }
        __syncthreads();
    }
}

__device__ __forceinline__ void ph_post0_naive(const Args& a, MK_LAS unsigned char* lds) {
    const int tid = MK_TID, lane = tid & 63;
    const bf16_t* P = (const bf16_t*)(a.ws + WS_P); const float* hraw = (const float*)(a.ws + WS_H); const float* yraw = (const float*)(a.ws + WS_SCR);
    bf16_t* O = (bf16_t*)(a.ws + WS_O); const float* mu = a.in[I_RWMU];
    MK_LAS float* Lpa = (MK_LAS float*)lds; MK_LAS float* Lsg = Lpa + 96;
    for (int m = blockIdx.x; m < NTOK; m += gridDim.x) { const size_t row = (size_t)m; const int t = m & (T - 1);
        for (int i = tid; i < 96 + 256; i += 512) { if (i < 96) Lpa[i] = rw_pf(P, mu, row, t, 3168 + i); else Lsg[i - 96] = fsigmoid(rw_pf(P, mu, row, t, 3264 + (i - 96))); }
        __syncthreads();
        {
            const int c = tid * 2; const float o0 = hraw[row * 1024 + c], o1 = hraw[row * 1024 + c + 1];
            const float rstd = rsqrtf(wave_sum(o0 * o0 + o1 * o1) * (1.0f / 128.0f) + NORM_EPS);
            const float g0 = bf2f(P[row * AB_LD + 3072 + c]), g1 = bf2f(P[row * AB_LD + 3072 + c + 1]);
            *(unsigned*)(O + row * D + c) = cvt_pk_bf16(o0 * rstd * a.in[I_HGNW][c] * siluf(g0), o1 * rstd * a.in[I_HGNW][c + 1] * siluf(g1)); }
        {
            const int c = tid * 2; float y[2], r[2], k[2], v[2], g[2];
#pragma unroll
            for (int q = 0; q < 2; ++q) { const int cc = c + q; y[q] = yraw[row * 1024 + cc];
                r[q] = rw_pf(P, mu, row, t, cc); const float kx = rw_pf(P, mu, row, t, 1024 + cc); v[q] = rw_pf(P, mu, row, t, 2048 + cc);
                float la = a.in[I_RWA0][cc];
_Pragma("unroll 8")
                for (int i = 0; i < 96; ++i) la += Lpa[i] * a.in[I_RWA2][i * 1024 + cc];
                k[q] = kx * (1.0f + (fsigmoid(la) - 1.0f) * a.in[I_RWKA][cc]);
                float gg = 0.f;
_Pragma("unroll 8")
                for (int i = 0; i < 256; ++i) gg += Lsg[i] * a.in[I_RWG2][i * 1024 + cc];
                g[q] = gg; }
            float sm = y[0] + y[1], sb = r[0] * k[0] * a.in[I_RWRK][c] + r[1] * k[1] * a.in[I_RWRK][c + 1];
#pragma unroll
            for (int o = 16; o > 0; o >>= 1) { sm += __shfl_xor(sm, o); sb += __shfl_xor(sb, o); }
            const float mean = sm * (1.0f / 64.0f); const float d0 = y[0] - mean, d1 = y[1] - mean; float sv = d0 * d0 + d1 * d1;
#pragma unroll
            for (int o = 16; o > 0; o >>= 1) sv += __shfl_xor(sv, o);
            const float rstd = rsqrtf(sv * (1.0f / 64.0f) + 64e-5f);
            const float z0 = (d0 * rstd * a.in[I_RWLNW][c] + a.in[I_RWLNB][c] + sb * v[0]) * g[0], z1 = (d1 * rstd * a.in[I_RWLNW][c + 1] + a.in[I_RWLNB][c + 1] + sb * v[1]) * g[1];
            *(unsigned*)(O + row * D + 1024 + c) = cvt_pk_bf16(z0, z1); }
        __syncthreads();
    }
    (void)lane;
}
typedef short bf16x8 __attribute__((ext_vector_type(8)));
typedef short bf16x4 __attribute__((ext_vector_type(4)));
typedef float f32x16 __attribute__((ext_vector_type(16)));
typedef float f32x2_t __attribute__((ext_vector_type(2))); typedef __bf16 bf16x2_t __attribute__((ext_vector_type(2)));
__device__ __forceinline__ unsigned cvtpk(float lo, float hi) { f32x2_t v = {lo, hi}; bf16x2_t b = __builtin_convertvector(v, bf16x2_t); return __builtin_bit_cast(unsigned, b); }
#define MFMA32(a, b, c) __builtin_amdgcn_mfma_f32_32x32x16_bf16((a), (b), (c), 0, 0, 0)
constexpr int FX_KS = 272, FX_VS = 136, FX_KB = 64 * FX_KS, FX_VB = 128 * FX_VS;
constexpr int FX_OFF_K = 0, FX_OFF_V = 2 * FX_KB, FX_OFF_C = FX_OFF_V + 2 * FX_VB, FX_LDS = FX_OFF_C + 2 * 256;
constexpr float FX_L2E = 1.4426950408889634f;
constexpr size_t WS_KMAX = 65536, WS_FOXQ = 65536 + 256;
constexpr float FX_THR2 = 30.0f * FX_L2E;
__device__ __forceinline__ void ph_fox_kmax(const Args& a) {
    const int lane = MK_TID & 63, gw = blockIdx.x * 8 + (MK_TID >> 6), NGW = gridDim.x * 8;
    const bf16_t* P = (const bf16_t*)(a.ws + WS_P); unsigned* KM = (unsigned*)(a.ws + WS_KMAX);
    for (int bb = 0; bb < NB; ++bb) { float mx = 0.f;
        for (int t = gw; t < T; t += NGW) { const u32x4* kp = (const u32x4*)(P + ((size_t)bb * T + t) * CD_LD + 2048 + 16 * lane); const u32x4 k0 = kp[0], k1 = kp[1];
            float s = bflo(k0.x) * bflo(k0.x) + bfhi(k0.x) * bfhi(k0.x) + bflo(k0.y) * bflo(k0.y) + bfhi(k0.y) * bfhi(k0.y) + bflo(k0.z) * bflo(k0.z) + bfhi(k0.z) * bfhi(k0.z) + bflo(k0.w) * bflo(k0.w) + bfhi(k0.w) * bfhi(k0.w)
                    + bflo(k1.x) * bflo(k1.x) + bfhi(k1.x) * bfhi(k1.x) + bflo(k1.y) * bflo(k1.y) + bfhi(k1.y) * bfhi(k1.y) + bflo(k1.z) * bflo(k1.z) + bfhi(k1.z) * bfhi(k1.z) + bflo(k1.w) * bflo(k1.w) + bfhi(k1.w) * bfhi(k1.w);
            s += __shfl_xor(s, 1); s += __shfl_xor(s, 2); s += __shfl_xor(s, 4); mx = fmaxf(mx, s); }
        if ((lane & 7) == 0) atomicMax(KM + bb * 8 + (lane >> 3), __float_as_uint(mx)); }
}

__device__ __forceinline__ void ph_fox(const Args& a, MK_LAS unsigned char* lds) {
    const int tid = MK_TID, lane = tid & 63, wave = tid >> 6, r = lane & 31, h = lane >> 5;
    const bf16_t* P = (const bf16_t*)(a.ws + WS_P); bf16_t* O = (bf16_t*)(a.ws + WS_O); const float* cum = (const float*)(a.ws + WS_CUM);
    const int G = (int)gridDim.x, c = (int)blockIdx.x;
    const float sc2 = 0.08838834764831845f * FX_L2E;
    unsigned* qhead = (unsigned*)(a.ws + WS_FOXQ);
    (void)G; (void)c;
    for (;;) {
        if (tid == 0) *(MK_LAS unsigned*)(lds + FX_LDS) = __hip_atomic_fetch_add(qhead, 1u, __ATOMIC_RELAXED, __HIP_MEMORY_SCOPE_AGENT);
        __syncthreads();
        const int L = (int)*(const MK_LAS unsigned*)(lds + FX_LDS);
        __syncthreads();
        if (L >= 1024) break;
        const int qt = 63 - (L >> 4), bh = L & 15, b = bh >> 3, hd = bh & 7, q0 = qt * 256, qw = q0 + 32 * wave, nt = 4 * (qt + 1);
        const size_t qrow = (size_t)b * T + qw + r;
        bf16x8 qf[8];
#pragma unroll
        for (int ks = 0; ks < 8; ++ks) qf[ks] = *(const bf16x8*)(P + qrow * CD_LD + 1024 + hd * 128 + 16 * ks + 8 * h);
        const float cq = cum[qrow * 8 + hd] * FX_L2E;
        float qb;
        {   float qn = 0.f;
#pragma unroll
            for (int ks = 0; ks < 8; ++ks) { const u32x4 w = __builtin_bit_cast(u32x4, qf[ks]);
                qn += bflo(w.x) * bflo(w.x) + bfhi(w.x) * bfhi(w.x) + bflo(w.y) * bflo(w.y) + bfhi(w.y) * bfhi(w.y) + bflo(w.z) * bflo(w.z) + bfhi(w.z) * bfhi(w.z) + bflo(w.w) * bflo(w.w) + bfhi(w.w) * bfhi(w.w); }
            qn += __shfl_xor(qn, 32);
            qb = sqrtf(qn * __uint_as_float(((const unsigned*)(a.ws + WS_KMAX))[bh])) * sc2 * 1.01f + 0.01f; }
        bool wdone = false;
        f32x16 o[4];
#pragma unroll
        for (int dt = 0; dt < 4; ++dt)
#pragma unroll
            for (int i = 0; i < 16; ++i) o[dt][i] = 0.f;
        float mrun = -3.0e38f, lrun = 0.f;
        const bf16_t* Kg = P + (size_t)b * T * CD_LD + 2048 + hd * 128; const bf16_t* Vg = P + (size_t)b * T * CD_LD + 3072 + hd * 128;
        u32x4 kreg[2], vreg[2]; float creg = 0.f;
#pragma unroll
        for (int i = 0; i < 2; ++i) { const int ch = tid + 512 * i; kreg[i] = *(const u32x4*)(Kg + (size_t)(64 * (nt - 1) + (ch >> 4)) * CD_LD + 8 * (ch & 15)); vreg[i] = *(const u32x4*)(Vg + (size_t)(64 * (nt - 1) + (ch & 63)) * CD_LD + 8 * (ch >> 6)); }
        if (tid < 64) creg = cum[((size_t)b * T + 64 * (nt - 1) + tid) * 8 + hd] * FX_L2E;
#define FX_WRITE(buf) do { _Pragma("unroll") for (int i = 0; i < 2; ++i) { const int ch = tid + 512 * i; \
            *(MK_LAS u32x4*)(lds + FX_OFF_K + (buf) * FX_KB + (ch >> 4) * FX_KS + (ch & 15) * 16) = kreg[i]; \
            MK_LAS unsigned short* vp = (MK_LAS unsigned short*)(lds + FX_OFF_V + (buf) * FX_VB + (8 * (ch >> 6)) * FX_VS + (ch & 63) * 2); \
            vp[0 * (FX_VS / 2)] = (unsigned short)(vreg[i].x & 0xffffu); vp[1 * (FX_VS / 2)] = (unsigned short)(vreg[i].x >> 16); vp[2 * (FX_VS / 2)] = (unsigned short)(vreg[i].y & 0xffffu); vp[3 * (FX_VS / 2)] = (unsigned short)(vreg[i].y >> 16); \
            vp[4 * (FX_VS / 2)] = (unsigned short)(vreg[i].z & 0xffffu); vp[5 * (FX_VS / 2)] = (unsigned short)(vreg[i].z >> 16); vp[6 * (FX_VS / 2)] = (unsigned short)(vreg[i].w & 0xffffu); vp[7 * (FX_VS / 2)] = (unsigned short)(vreg[i].w >> 16); } \
            if (tid < 64) *(MK_LAS float*)(lds + FX_OFF_C + (buf) * 256 + tid * 4) = creg; } while (0)
        FX_WRITE(0);
        __syncthreads();
        for (int jj = 0; jj < nt; ++jj) {
            const int j = nt - 1 - jj, buf = jj & 1, k0 = 64 * j;
            if (j > 0) {
#pragma unroll
                for (int i = 0; i < 2; ++i) { const int ch = tid + 512 * i; kreg[i] = *(const u32x4*)(Kg + (size_t)(k0 - 64 + (ch >> 4)) * CD_LD + 8 * (ch & 15)); vreg[i] = *(const u32x4*)(Vg + (size_t)(k0 - 64 + (ch & 63)) * CD_LD + 8 * (ch >> 6)); }
                if (tid < 64) creg = cum[((size_t)b * T + k0 - 64 + tid) * 8 + hd] * FX_L2E;
            }
            const MK_LAS float* Cb = (const MK_LAS float*)(lds + FX_OFF_C + buf * 256);
            if (!wdone) wdone = __all(qb + (cq - Cb[63]) <= mrun - FX_THR2);
            if (!wdone && k0 <= qw + 31) {
                const MK_LAS unsigned char* Kb = lds + FX_OFF_K + buf * FX_KB; const MK_LAS unsigned char* Vb = lds + FX_OFF_V + buf * FX_VB;
                f32x16 st[2];
#pragma unroll
                for (int kt = 0; kt < 2; ++kt) {
#pragma unroll
                    for (int i = 0; i < 16; ++i) st[kt][i] = 0.f;
#pragma unroll
                    for (int ks = 0; ks < 8; ++ks) { const bf16x8 kf = *(const MK_LAS bf16x8*)(Kb + (32 * kt + r) * FX_KS + ks * 32 + h * 16); st[kt] = MFMA32(kf, qf[ks], st[kt]); } }
                const bool diag = (k0 + 63 > qw);
                float mx = -3.0e38f;
#pragma unroll
                for (int kt = 0; kt < 2; ++kt)
#pragma unroll
                    for (int g = 0; g < 4; ++g) { const f32x4 ck = *(const MK_LAS f32x4*)(Cb + 32 * kt + 8 * g + 4 * h);
#pragma unroll
                        for (int i = 0; i < 4; ++i) { float s = st[kt][4 * g + i] * sc2 + (cq - ck[i]);
                            if (diag) { const int key = k0 + 32 * kt + 8 * g + 4 * h + i; if (key > qw + r) s = -3.0e38f; }
                            st[kt][4 * g + i] = s; mx = fmaxf(mx, s); } }
                mx = fmaxf(mx, __shfl_xor(mx, 32));
                const float mnew = fmaxf(mrun, mx), corr = __builtin_amdgcn_exp2f(mrun - mnew); mrun = mnew;
                float ls = 0.f;
#pragma unroll
                for (int kt = 0; kt < 2; ++kt)
#pragma unroll
                    for (int i = 0; i < 16; ++i) { const float p = __builtin_amdgcn_exp2f(st[kt][i] - mnew); st[kt][i] = p; ls += p; }
                lrun = lrun * corr + ls;
#pragma unroll
                for (int dt = 0; dt < 4; ++dt)
#pragma unroll
                    for (int i = 0; i < 16; ++i) o[dt][i] *= corr;
                bf16x8 pf[2][2];
#pragma unroll
                for (int kt = 0; kt < 2; ++kt)
#pragma unroll
                    for (int s = 0; s < 2; ++s) { u32x4 w; w.x = cvtpk(st[kt][8 * s + 0], st[kt][8 * s + 1]); w.y = cvtpk(st[kt][8 * s + 2], st[kt][8 * s + 3]); w.z = cvtpk(st[kt][8 * s + 4], st[kt][8 * s + 5]); w.w = cvtpk(st[kt][8 * s + 6], st[kt][8 * s + 7]);
                        pf[kt][s] = __builtin_bit_cast(bf16x8, w); }
#pragma unroll
                for (int dt = 0; dt < 4; ++dt)
#pragma unroll
                    for (int kt = 0; kt < 2; ++kt)
#pragma unroll
                        for (int s = 0; s < 2; ++s) { const MK_LAS unsigned char* vp = Vb + (32 * dt + r) * FX_VS + (32 * kt + 16 * s + 4 * h) * 2;
                            const u32x2 lo = *(const MK_LAS u32x2*)vp, hi = *(const MK_LAS u32x2*)(vp + 16); u32x4 w; w.x = lo.x; w.y = lo.y; w.z = hi.x; w.w = hi.y;
                            o[dt] = MFMA32(__builtin_bit_cast(bf16x8, w), pf[kt][s], o[dt]); }
            }
            if (j > 0) FX_WRITE(buf ^ 1);
            if (__syncthreads_and(wdone ? 1 : 0)) break;
        }
#undef FX_WRITE
        const float ltot = lrun + __shfl_xor(lrun, 32), inv = 1.0f / ltot;
        bf16_t* orow = O + qrow * D + 1024 + hd * 128;
#pragma unroll
        for (int dt = 0; dt < 4; ++dt)
#pragma unroll
            for (int g = 0; g < 4; ++g) { u32x2 w; w.x = cvtpk(o[dt][4 * g] * inv, o[dt][4 * g + 1] * inv); w.y = cvtpk(o[dt][4 * g + 2] * inv, o[dt][4 * g + 3] * inv);
                *(u32x2*)(orow + 32 * dt + 8 * g + 4 * h) = w; }
    }
}
#ifndef MK_RWKV_WP
#define MK_RWKV_WP 1
#endif
#define MFMA16(a, b, c) __builtin_amdgcn_mfma_f32_16x16x32_bf16((a), (b), (c), 0, 0, 0)
constexpr size_t WS_W2T = 8 * MiB, WS_A2T = 8 * MiB + 256 * 1024, WS_G2T = 9 * MiB;
constexpr size_t WS_HGS = WS_H, WS_RWQ = WS_H + 64 * MiB, WS_RWM = WS_H + 96 * MiB;
constexpr size_t WS_HGD = 10 * MiB;
constexpr size_t WS_RWLD = WS_SCR, WS_RWAG = WS_SCR + 64 * MiB;
constexpr int RW_AT = 0, RW_RT = RW_AT + 2304, RW_BH = RW_RT + 2304, RW_KH = RW_BH + 2304, RW_BCT = RW_KH + 2304, RW_KCT = RW_BCT + 2560, RW_VT = RW_KCT + 2560,
              RW_AM = RW_VT + 2560, RW_TM = RW_AM + 3072, RW_NF = RW_TM + 768, RW_WC = RW_NF + 1024, RW_RED = RW_WC + 256, RW_RAWX = RW_RED + 1024, RW_RAWL = RW_RAWX + 6528, RW_OUT = RW_RAWL + 6144, RW_GRP = RW_OUT + 2048;
constexpr int RW_SEG = 512, RW_NSEG = T / RW_SEG, RW_NCH = RW_SEG / 16;
constexpr int RP_RAW = 0, RP_TW = 58240, RP_PA = RP_TW + 13312, RP_SG = RP_PA + 13312, RP_MU = RP_SG + 33792, RP_END = RP_MU + 1792;
static_assert(RP_END <= LDS_RING, "rwkv pre lds");
static_assert(RW_GRP * 2 <= LDS_RING, "rwkv lds");
__device__ __forceinline__ bf16x8 mk8(u32x2 lo, u32x2 hi) { u32x4 w; w.x = lo.x; w.y = lo.y; w.z = hi.x; w.w = hi.y; return __builtin_bit_cast(bf16x8, w); }
__device__ __forceinline__ bf16x8 mk8z(u32x2 lo) { u32x4 w; w.x = lo.x; w.y = lo.y; w.z = 0u; w.w = 0u; return __builtin_bit_cast(bf16x8, w); }
__device__ __forceinline__ u32x2 pk4(const f32x4& v) { u32x2 w; w.x = cvtpk(v[0], v[1]); w.y = cvtpk(v[2], v[3]); return w; }
template <int CTRL> __device__ __forceinline__ float dpp_mov(float x) { return __builtin_bit_cast(float, __builtin_amdgcn_mov_dpp(__builtin_bit_cast(int, x), CTRL, 0xf, 0xf, true)); }
__device__ __forceinline__ float red16(float v) { v += dpp_mov<0xB1>(v); v += dpp_mov<0x4E>(v); v += dpp_mov<0x141>(v); v += dpp_mov<0x128>(v); return v; }

__device__ __forceinline__ void rwkv_convert_small(const Args& a) {
    const int gid = blockIdx.x * 512 + MK_TID, NG = gridDim.x * 512;
    bf16_t* w2t = (bf16_t*)(a.ws + WS_W2T); bf16_t* a2t = (bf16_t*)(a.ws + WS_A2T); bf16_t* g2t = (bf16_t*)(a.ws + WS_G2T);
    for (int i = gid; i < 1024 * 96; i += NG) { const int n = i / 96, m = i % 96; w2t[i] = (bf16_t)(cvtpk(a.in[I_RWW2][m * 1024 + n], 0.f) & 0xffffu); a2t[i] = (bf16_t)(cvtpk(a.in[I_RWA2][m * 1024 + n], 0.f) & 0xffffu); }
    for (int i = gid; i < 1024 * 256; i += NG) { const int n = i >> 8, m = i & 255; g2t[i] = (bf16_t)(cvtpk(a.in[I_RWG2][m * 1024 + n], 0.f) & 0xffffu); }
}

template <int ARR> __device__ __forceinline__ void rp_array(const Args& a, MK_LAS unsigned char* lds, size_t row0, int wave, int m, int q) {
    constexpr int NS = (ARR == 2) ? 8 : 3, KW = (ARR == 2) ? 256 : 96, AO = (ARR == 0) ? RP_TW : ((ARR == 1) ? RP_PA : RP_SG), AS = (ARR == 2) ? 528 : 208;
    const bf16_t* wt = (const bf16_t*)(a.ws + ((ARR == 0) ? WS_W2T : ((ARR == 1) ? WS_A2T : WS_G2T)));
    const int ch0 = 128 * wave + 8 * m;
#pragma unroll 1
    for (int rh = 0; rh < 2; ++rh) {
    f32x4 acc[8][2];
    bf16x8 af[2][NS];
#pragma unroll
    for (int rt = 0; rt < 2; ++rt)
#pragma unroll
        for (int s = 0; s < NS; ++s) af[rt][s] = *(const MK_LAS bf16x8*)(lds + AO + (32 * rh + 16 * rt + m) * AS + (32 * s + 8 * q) * 2);
    bf16x8 wn[NS], wn2[NS];
    constexpr bool TILED = (MK_RWKV_WP != 0) && (ARR < 2);
#define RP_CH(ct_) (TILED ? (128 * wave + 16 * (ct_) + m) : (128 * wave + 8 * m + (ct_)))
#pragma unroll
    for (int s = 0; s < NS; ++s) { wn[s] = *(const bf16x8*)(wt + RP_CH(0) * KW + 32 * s + 8 * q); wn2[s] = *(const bf16x8*)(wt + RP_CH(1) * KW + 32 * s + 8 * q); }
#pragma unroll
    for (int ct = 0; ct < 8; ++ct) { bf16x8 wf[NS];
#pragma unroll
        for (int s = 0; s < NS; ++s) { wf[s] = wn[s]; wn[s] = wn2[s]; }
        if (ct < 6) {
#pragma unroll
            for (int s = 0; s < NS; ++s) wn2[s] = *(const bf16x8*)(wt + RP_CH(ct + 2) * KW + 32 * s + 8 * q); }
#pragma unroll
        for (int rt = 0; rt < 2; ++rt) { f32x4 x = (f32x4){0.f, 0.f, 0.f, 0.f};
#pragma unroll
            for (int s = 0; s < NS; ++s) x = MFMA16(af[rt][s], wf[s], x);
            acc[ct][rt] = x; } }
    f32x4 b0 = (f32x4){0.f, 0.f, 0.f, 0.f}, b1 = b0;
    if (ARR == 0) { b0 = *(const f32x4*)(a.in[I_RWW0] + ch0); b1 = *(const f32x4*)(a.in[I_RWW0] + ch0 + 4); }
    if (ARR == 1) { b0 = *(const f32x4*)(a.in[I_RWA0] + ch0); b1 = *(const f32x4*)(a.in[I_RWA0] + ch0 + 4); }
    bf16_t* base = (ARR == 0) ? (bf16_t*)(a.ws + WS_RWLD) + ch0 : ((ARR == 1) ? (bf16_t*)(a.ws + WS_RWAG) + ch0 : (bf16_t*)(a.ws + WS_O) + 1024 + ch0);
    constexpr int LDO = (ARR == 2) ? D : 1024;
    if (TILED) {
#pragma unroll
        for (int ct = 0; ct < 8; ++ct) { const int ch = 128 * wave + 16 * ct + m; const float bias = (ARR == 0) ? a.in[I_RWW0][ch] : a.in[I_RWA0][ch];
#pragma unroll
            for (int rt = 0; rt < 2; ++rt) { f32x4 v;
#pragma unroll
                for (int e = 0; e < 4; ++e) { const float x = acc[ct][rt][e] + bias; v[e] = (ARR == 0) ? -0.6065306597f * fsigmoid(x) : fsigmoid(x); }
                const size_t cidx = (row0 + 32 * rh + 16 * rt) >> 4;
                *(u32x2*)((bf16_t*)(a.ws + WS_RWLD) + ((cidx * 16 + (ch >> 6)) * 2 + ARR) * 1024 + (ch & 63) * 16 + 4 * q) = pk4(v); } }
    } else
#pragma unroll
    for (int rt = 0; rt < 2; ++rt)
#pragma unroll
        for (int e = 0; e < 4; ++e) { const size_t row = row0 + 32 * rh + 16 * rt + 4 * q + e; float v[8];
#pragma unroll
            for (int ct = 0; ct < 8; ++ct) { const float x = acc[ct][rt][e] + (ct < 4 ? b0[ct & 3] : b1[ct & 3]);
                v[ct] = (ARR == 0) ? -0.6065306597f * fsigmoid(x) : ((ARR == 1) ? fsigmoid(x) : x); }
            u32x4 w; w.x = cvtpk(v[0], v[1]); w.y = cvtpk(v[2], v[3]); w.z = cvtpk(v[4], v[5]); w.w = cvtpk(v[6], v[7]);
            *(u32x4*)(base + row * LDO) = w; }
    }
#undef RP_CH
}
template <int ABL = 0> __device__ __forceinline__ void ph_rwkv_pre(const Args& a, MK_LAS unsigned char* lds) {
    const int tid = MK_TID, lane = tid & 63, wave = tid >> 6, m = lane & 15, q = lane >> 4;
    const bf16_t* P = (const bf16_t*)(a.ws + WS_P); bf16_t* O = (bf16_t*)(a.ws + WS_O); bf16_t* LD = (bf16_t*)(a.ws + WS_RWLD); bf16_t* AG = (bf16_t*)(a.ws + WS_RWAG);
    const bf16_t* w2t = (const bf16_t*)(a.ws + WS_W2T); const bf16_t* a2t = (const bf16_t*)(a.ws + WS_A2T); const bf16_t* g2t = (const bf16_t*)(a.ws + WS_G2T);
    if (tid < 448) *(MK_LAS float*)(lds + RP_MU + tid * 4) = a.in[I_RWMU][3072 + tid];
    const int G = (int)gridDim.x, nit = (NTOK / 64 + G - 1) / G;
    for (int it = 0; it < nit; ++it) {
        int u = it * G + (int)blockIdx.x; const bool valid = u < NTOK / 64; if (!valid) u = NTOK / 64 - 1;
        const size_t row0 = (size_t)u * 64; const bool first = ((u * 64) & (T - 1)) == 0;
#pragma unroll 4
        for (int i = 0; i < ((ABL & 4) ? 0 : 8); ++i) { const int j = tid + 512 * i; if (j < 65 * 56) { const int rw = j / 56, cc = j - rw * 56;
                const u32x4 v = (first && rw == 0) ? (u32x4){0u, 0u, 0u, 0u} : *(const u32x4*)(P + (row0 + rw - 1) * AB_LD + RWO + 3072 + 8 * cc);
                *(MK_LAS u32x4*)(lds + RP_RAW + rw * 896 + cc * 16) = v; } }
        __syncthreads();
#pragma unroll 2
        for (int i = 0; i < ((ABL & 2) ? 0 : 56); ++i) { const int idx = tid + 512 * i, tt = idx / 448, col = idx - tt * 448;
            const float cur = bf2f(*(const MK_LAS bf16_t*)(lds + RP_RAW + (tt + 1) * 896 + col * 2)), prv = bf2f(*(const MK_LAS bf16_t*)(lds + RP_RAW + tt * 896 + col * 2));
            const float x = cur + (prv - cur) * *(const MK_LAS float*)(lds + RP_MU + col * 4);
            if (col < 96) *(MK_LAS bf16_t*)(lds + RP_TW + tt * 208 + col * 2) = (bf16_t)(cvtpk(1.0f - 2.0f / (__expf(2.0f * x) + 1.0f), 0.f) & 0xffffu);
            else if (col < 192) *(MK_LAS bf16_t*)(lds + RP_PA + tt * 208 + (col - 96) * 2) = (bf16_t)(cvtpk(x, 0.f) & 0xffffu);
            else *(MK_LAS bf16_t*)(lds + RP_SG + tt * 528 + (col - 192) * 2) = (bf16_t)(cvtpk(fsigmoid(x), 0.f) & 0xffffu); }
        __syncthreads();
        if (valid && !(ABL & 1)) { rp_array<0>(a, lds, row0, wave, m, q); rp_array<1>(a, lds, row0, wave, m, q); rp_array<2>(a, lds, row0, wave, m, q); }
        __syncthreads();
    }
}
template <int MODE, int ABL = 0>
__device__ __forceinline__ void ph_rwkv(const Args& a, MK_LAS unsigned char* lds, unsigned* qhead = nullptr) {
    const int tid = MK_TID, lane = tid & 63, wave = tid >> 6, grp = wave >> 2, wq = wave & 3, m = lane & 15, q = lane >> 4, gtid = tid & 255;
    MK_LAS unsigned char* gl = lds + grp * RW_GRP;
    const bf16_t* P = (const bf16_t*)(a.ws + WS_P); bf16_t* O = (bf16_t*)(a.ws + WS_O); const float* mu = a.in[I_RWMU];
    const bf16_t* LD = (const bf16_t*)(a.ws + WS_RWLD); const bf16_t* AG = (const bf16_t*)(a.ws + WS_RWAG);
    float* RWQ = (float*)(a.ws + WS_RWQ); float* RWM = (float*)(a.ws + WS_RWM);
    constexpr int NU = 32 * RW_NSEG, NCT = (MODE == 0) ? 2 : 1, NLP = (MODE == 0) ? 256 : 384;
    const int G = (int)gridDim.x, nit = (NU / 2 + G - 1) / G;
    for (int it = 0; qhead != nullptr || it < nit; ++it) {
        int ub = it * G + (int)blockIdx.x;
        if (qhead != nullptr) { MK_LAS unsigned* slot = (MK_LAS unsigned*)(lds + LDS_MISC + 1024); __syncthreads(); if (tid == 0) *slot = __hip_atomic_fetch_add(qhead, 1u, __ATOMIC_RELAXED, __HIP_MEMORY_SCOPE_AGENT); __syncthreads(); ub = (int)*slot; if (ub >= NU / 2) break; }
        const bool valid = ub < NU / 2; if (!valid) ub = NU / 2 - 1;
        const int u = ub * 2 + grp;
        const int stream = u / RW_NSEG, seg = u - stream * RW_NSEG, b = stream >> 4, hh = stream & 15, ch = hh * 64 + 16 * wq + m;
        const float mu_r = mu[ch], mu_k = mu[1024 + ch], mu_v = mu[2048 + ch];
        const float k_k = a.in[I_RWKK][ch], k_a = a.in[I_RWKA][ch], r_k = a.in[I_RWRK][ch], ln_w = a.in[I_RWLNW][ch], ln_b = a.in[I_RWLNB][ch];
        f32x4 zt[NCT][4];
        if (MODE == 0) {
#pragma unroll
            for (int jt = 0; jt < 4; ++jt)
#pragma unroll
                for (int e = 0; e < 4; ++e) { zt[NCT - 1][jt][e] = ((16 * jt + 4 * q + e) == (16 * wq + m)) ? 1.0f : 0.0f; zt[0][jt][e] = 0.0f; }
        } else {
            const float* zs = RWQ + (size_t)u * 4096;
#pragma unroll
            for (int jt = 0; jt < 4; ++jt)
#pragma unroll
                for (int e = 0; e < 4; ++e) zt[0][jt][e] = zs[(16 * jt + 4 * q + e) * 64 + 16 * wq + m];
        }
        u32x4 pfX[2], pfL[2];
        const size_t rseg = (size_t)b * T + seg * RW_SEG;
#define RW_FETCH(t0c) do { const bool first = (seg == 0 && (t0c) == 0); \
            _Pragma("unroll") for (int i = 0; i < 2; ++i) { const int j = gtid + 256 * i; const int rw = j / 24, cc = j - rw * 24; const bool ok = (j < 408) && !(first && rw == 0); \
                pfX[i] = ok ? *(const u32x4*)(P + (rseg + (t0c) + rw - 1) * AB_LD + RWO + (cc >> 3) * 1024 + hh * 64 + 8 * (cc & 7)) : (u32x4){0u, 0u, 0u, 0u}; } \
            _Pragma("unroll") for (int i = 0; i < 2; ++i) { const int j = gtid + 256 * i; if (j < NLP) { const int arr = j >> 7, rem = j & 127, tt = rem >> 3, c8 = rem & 7; \
                const bf16_t* src = (arr == 0) ? LD + (rseg + (t0c) + tt) * 1024 + hh * 64 + 8 * c8 : ((arr == 1) ? AG + (rseg + (t0c) + tt) * 1024 + hh * 64 + 8 * c8 : O + (rseg + (t0c) + tt) * D + 1024 + hh * 64 + 8 * c8); \
                pfL[i] = *(const u32x4*)src; } } } while (0)
        RW_FETCH(0);
        for (int chunk = 0; chunk < RW_NCH; ++chunk) {
            const int t0 = seg * RW_SEG + chunk * 16; const size_t row0 = (size_t)b * T + t0;
#pragma unroll
            for (int i = 0; i < 2; ++i) { const int j = gtid + 256 * i; if (j < 408) *(MK_LAS u32x4*)(gl + RW_RAWX + j * 16) = pfX[i]; if (j < NLP) *(MK_LAS u32x4*)(gl + RW_RAWL + j * 16) = pfL[i]; }
            if (chunk < RW_NCH - 1) RW_FETCH((chunk + 1) * 16);
            __syncthreads();
            if (MODE == 1 && chunk > 0 && valid && gtid < 128) *(u32x4*)(O + (row0 - 16 + (gtid >> 3)) * D + 1024 + hh * 64 + 8 * (gtid & 7)) = *(const MK_LAS u32x4*)(gl + RW_OUT + gtid * 16);
            float rr[4], km[4], vv[4], ld[4], ag[4], kkr[4], ga[4];
            {   const MK_LAS unsigned char* rx = gl + RW_RAWX + (4 * q) * 384 + (16 * wq + m) * 2;
                float pr = bf2f(*(const MK_LAS bf16_t*)(rx)), pk = bf2f(*(const MK_LAS bf16_t*)(rx + 128)), pv = bf2f(*(const MK_LAS bf16_t*)(rx + 256));
#pragma unroll
                for (int e = 0; e < 4; ++e) { const MK_LAS unsigned char* rc = rx + (e + 1) * 384; const MK_LAS unsigned char* rl = gl + RW_RAWL + (4 * q + e) * 128 + (16 * wq + m) * 2;
                    const float cr = bf2f(*(const MK_LAS bf16_t*)(rc)), ck = bf2f(*(const MK_LAS bf16_t*)(rc + 128)), cv = bf2f(*(const MK_LAS bf16_t*)(rc + 256));
                    rr[e] = cr + (pr - cr) * mu_r; const float kx = ck + (pk - ck) * mu_k; vv[e] = cv + (pv - cv) * mu_v; pr = cr; pk = ck; pv = cv;
                    ld[e] = bf2f(*(const MK_LAS bf16_t*)(rl)); ag[e] = bf2f(*(const MK_LAS bf16_t*)(rl + 2048)); ga[e] = (MODE == 1) ? bf2f(*(const MK_LAS bf16_t*)(rl + 4096)) : 0.f;
                    kkr[e] = kx * k_k; km[e] = kx * (1.0f + (ag[e] - 1.0f) * k_a); }
            }
            if (!(ABL & 16)) {   MK_LAS float* red = (MK_LAS float*)(gl + RW_RED);
#pragma unroll
                for (int e = 0; e < 4; ++e) { const float ss = red16(kkr[e] * kkr[e]); const float sb = red16(rr[e] * km[e] * r_k);
                    if (m == 0) { red[wq * 16 + 4 * q + e] = ss; red[64 + wq * 16 + 4 * q + e] = sb; } } }
            __syncthreads();
            float bon[4] = {0.f, 0.f, 0.f, 0.f};
            if (!(ABL & 8)) {   const MK_LAS float* red = (const MK_LAS float*)(gl + RW_RED);
                float cl[4], run = 0.f;
#pragma unroll
                for (int e = 0; e < 4; ++e) { run += ld[e]; cl[e] = run; }
                { float pre = 0.f; const float x1 = __shfl_up(run, 16), x2 = __shfl_up(run, 32), x3 = __shfl_up(run, 48); if (q >= 1) pre += x1; if (q >= 2) pre += x2; if (q >= 3) pre += x3;
#pragma unroll
                  for (int e = 0; e < 4; ++e) cl[e] += pre; }
                const float CL = __shfl(cl[3], 48 + m);
                f32x4 bc4, kc4, v4;
#pragma unroll
                for (int e = 0; e < 4; ++e) { const int tt = 4 * q + e;
                    const float ssum = red[tt] + red[16 + tt] + red[32 + tt] + red[48 + tt]; bon[e] = red[64 + tt] + red[80 + tt] + red[96 + tt] + red[112 + tt];
                    const float kk = kkr[e] / fmaxf(sqrtf(ssum), 1e-12f), av = -kk, bv = kk * ag[e];
                    const float eW = __expf(cl[e]), eWp = __expf(cl[e] - ld[e]), eInv = __expf(-cl[e]), eC = __expf(CL - cl[e]);
                    const int off = tt * 144 + (16 * wq + m) * 2;
                    *(MK_LAS bf16_t*)(gl + RW_AT + off) = (bf16_t)(cvtpk(av * eWp, 0.f) & 0xffffu); *(MK_LAS bf16_t*)(gl + RW_RT + off) = (bf16_t)(cvtpk(rr[e] * eW, 0.f) & 0xffffu);
                    *(MK_LAS bf16_t*)(gl + RW_BH + off) = (bf16_t)(cvtpk(bv * eInv, 0.f) & 0xffffu); *(MK_LAS bf16_t*)(gl + RW_KH + off) = (bf16_t)(cvtpk(km[e] * eInv, 0.f) & 0xffffu);
                    bc4[e] = bv * eC; kc4[e] = km[e] * eC; v4[e] = vv[e]; }
                const int offT = (16 * wq + m) * 40 + 4 * q * 2;
                *(MK_LAS u32x2*)(gl + RW_BCT + offT) = pk4(bc4); *(MK_LAS u32x2*)(gl + RW_KCT + offT) = pk4(kc4); *(MK_LAS u32x2*)(gl + RW_VT + offT) = pk4(v4);
                if (q == 3) *(MK_LAS float*)(gl + RW_WC + (16 * wq + m) * 4) = __expf(CL);
            }
            __syncthreads();
            if (!(ABL & 4)) {   const int xo = (wq < 2) ? RW_AT : RW_RT, yo = (wq & 1) ? RW_KH : RW_BH; f32x4 acc = (f32x4){0.f, 0.f, 0.f, 0.f};
#pragma unroll
                for (int s = 0; s < 2; ++s) acc = MFMA16(*(const MK_LAS bf16x8*)(gl + xo + m * 144 + (32 * s + 8 * q) * 2), *(const MK_LAS bf16x8*)(gl + yo + m * 144 + (32 * s + 8 * q) * 2), acc);
#pragma unroll
                for (int e = 0; e < 4; ++e) { const int tt = 4 * q + e; const bool keep = (wq < 2) ? (m < tt) : (m <= tt); const float x = keep ? acc[e] : 0.f;
                    *(MK_LAS bf16_t*)(gl + RW_AM + wq * 768 + tt * 48 + m * 2) = (bf16_t)(cvtpk(x, 0.f) & 0xffffu);
                    if (wq == 0) *(MK_LAS float*)(gl + RW_NF + (tt * 16 + m) * 4) = x; } }
            __syncthreads();
#define RW_APERM(base, s) mk8(*(const MK_LAS u32x2*)(gl + (base) + m * 144 + (32 * (s) + 4 * q) * 2), *(const MK_LAS u32x2*)(gl + (base) + m * 144 + (32 * (s) + 16 + 4 * q) * 2))
#define RW_A16(base) mk8z(*(const MK_LAS u32x2*)(gl + (base) + m * 48 + 4 * q * 2))
            f32x4 y = (f32x4){0.f, 0.f, 0.f, 0.f}; f32x4 rhs[NCT];
            if (!(ABL & 2)) {
                const bf16x8 vf = mk8z(*(const MK_LAS u32x2*)(gl + RW_VT + (16 * wq + m) * 40 + 4 * q * 2));
                const bf16x8 at0 = RW_APERM(RW_AT, 0), at1 = RW_APERM(RW_AT, 1);
#pragma unroll
                for (int ct = 0; ct < NCT; ++ct) { const bool hasv = (MODE == 1) || (ct == 0);
                    const bf16x8 zp0 = mk8(pk4(zt[ct][0]), pk4(zt[ct][1])), zp1 = mk8(pk4(zt[ct][2]), pk4(zt[ct][3]));
                    f32x4 r4 = (f32x4){0.f, 0.f, 0.f, 0.f};
                    r4 = MFMA16(at0, zp0, r4); r4 = MFMA16(at1, zp1, r4);
                    if (hasv) r4 = MFMA16(RW_A16(RW_AM + 768), vf, r4);
                    rhs[ct] = r4;
                    if (MODE == 1) { y = MFMA16(RW_APERM(RW_RT, 0), zp0, y); y = MFMA16(RW_APERM(RW_RT, 1), zp1, y); y = MFMA16(RW_A16(RW_AM + 3 * 768), vf, y); }
#pragma unroll
                    for (int jt = 0; jt < 4; ++jt) { const f32x4 wc4 = *(const MK_LAS f32x4*)(gl + RW_WC + (16 * jt + 4 * q) * 4); f32x4 z = zt[ct][jt] * wc4;
                        if (hasv) z = MFMA16(mk8z(*(const MK_LAS u32x2*)(gl + RW_KCT + (16 * jt + m) * 40 + 4 * q * 2)), vf, z);
                        zt[ct][jt] = z; } }
            }
            if (!(ABL & 1) && wq == 0 && q == 0) {
                float tc[16];
                if (MODE == 0) { tc[0] = (m == 0) ? 1.f : 0.f;
#pragma unroll
                    for (int t = 1; t < 16; ++t) { float acc = 0.f;
#pragma unroll
                        for (int j = 0; j < t; ++j) acc += *(const MK_LAS float*)(gl + RW_NF + (t * 16 + j) * 4) * tc[j];
                        tc[t] = (m < t) ? acc : ((m == t) ? 1.f : 0.f); }
                } else {
                float ac[16];
#pragma unroll
                for (int t = 0; t < 16; ++t) ac[t] = 0.f;
                tc[0] = (m == 0) ? 1.f : 0.f;
#pragma unroll
                for (int j = 0; j < 15; ++j) {
#pragma unroll
                    for (int t = j + 1; t < 16; ++t) ac[t] += *(const MK_LAS float*)(gl + RW_NF + (t * 16 + j) * 4) * tc[j];
                    tc[j + 1] = (m < j + 1) ? ac[j + 1] : ((m == j + 1) ? 1.f : 0.f); }
                }
#pragma unroll
                for (int t = 0; t < 16; ++t) *(MK_LAS bf16_t*)(gl + RW_TM + t * 48 + m * 2) = (bf16_t)(cvtpk(tc[t], 0.f) & 0xffffu);
            }
            __syncthreads();
            if (!(ABL & 2)) {
                const bf16x8 tmf = RW_A16(RW_TM);
#pragma unroll
                for (int ct = 0; ct < NCT; ++ct) {
                    f32x4 uu = (f32x4){0.f, 0.f, 0.f, 0.f};
                    uu = MFMA16(tmf, mk8z(pk4(rhs[ct])), uu);
                    const bf16x8 ub8 = mk8z(pk4(uu));
                    if (MODE == 1) y = MFMA16(RW_A16(RW_AM + 2 * 768), ub8, y);
#pragma unroll
                    for (int jt = 0; jt < 4; ++jt) zt[ct][jt] = MFMA16(mk8z(*(const MK_LAS u32x2*)(gl + RW_BCT + (16 * jt + m) * 40 + 4 * q * 2)), ub8, zt[ct][jt]); }
            }
#undef RW_APERM
#undef RW_A16
            if (MODE == 1 && !(ABL & 32)) {
                MK_LAS float* red = (MK_LAS float*)(gl + RW_RED);
#pragma unroll
                for (int e = 0; e < 4; ++e) { const float s1 = red16(y[e]), s2 = red16(y[e] * y[e]); if (m == 0) { red[128 + wq * 16 + 4 * q + e] = s1; red[192 + wq * 16 + 4 * q + e] = s2; } }
                __syncthreads();
#pragma unroll
                for (int e = 0; e < 4; ++e) { const int tt = 4 * q + e;
                    const float s1 = red[128 + tt] + red[144 + tt] + red[160 + tt] + red[176 + tt], s2 = red[192 + tt] + red[208 + tt] + red[224 + tt] + red[240 + tt];
                    const float mean = s1 * (1.0f / 64.0f), var = fmaxf(s2 * (1.0f / 64.0f) - mean * mean, 0.f), rstd = rsqrtf(var + 64e-5f);
                    const float outv = ((y[e] - mean) * rstd * ln_w + ln_b + bon[e] * vv[e]) * ga[e];
                    *(MK_LAS bf16_t*)(gl + RW_OUT + tt * 128 + (16 * wq + m) * 2) = (bf16_t)(cvtpk(outv, 0.f) & 0xffffu); }
            }
        }
#undef RW_FETCH
        if (MODE == 1) { __syncthreads();
            if (valid && gtid < 128) *(u32x4*)(O + ((size_t)b * T + seg * RW_SEG + (RW_SEG - 16) + (gtid >> 3)) * D + 1024 + hh * 64 + 8 * (gtid & 7)) = *(const MK_LAS u32x4*)(gl + RW_OUT + gtid * 16); }
        if (MODE == 0 && valid) {
#pragma unroll
            for (int ct = 0; ct < NCT; ++ct) { float* dst = (ct == 0 ? RWQ : RWM) + (size_t)u * 4096;
#pragma unroll
                for (int jt = 0; jt < 4; ++jt)
#pragma unroll
                    for (int e = 0; e < 4; ++e) dst[(16 * jt + 4 * q + e) * 64 + 16 * wq + m] = zt[ct][jt][e]; } }
        __syncthreads();
    }
}

__device__ __forceinline__ void ph_rwkv_chain(const Args& a) {
    const int tid = MK_TID, lane = tid & 63, wave = tid >> 6, grp = wave >> 2, wq = wave & 3, m = lane & 15, q = lane >> 4;
    const int stream = (int)blockIdx.x * 2 + grp; if (stream >= 32) return;
    float* RWQ = (float*)(a.ws + WS_RWQ); const float* RWM = (const float*)(a.ws + WS_RWM);
    f32x4 zt[4];
#pragma unroll
    for (int jt = 0; jt < 4; ++jt) zt[jt] = (f32x4){0.f, 0.f, 0.f, 0.f};
    f32x4 mx[4][2][2], qn[4];
#define RB_LOAD(sg) do { const size_t u_ = (size_t)stream * RW_NSEG + (sg); const float* ms_ = RWM + u_ * 4096; const float* qs_ = RWQ + u_ * 4096; \
        _Pragma("unroll") for (int jt = 0; jt < 4; ++jt) { _Pragma("unroll") for (int s = 0; s < 2; ++s) { const float* mr = ms_ + (16 * jt + m) * 64 + 32 * s + 4 * q; mx[jt][s][0] = *(const f32x4*)mr; mx[jt][s][1] = *(const f32x4*)(mr + 16); } \
            _Pragma("unroll") for (int e = 0; e < 4; ++e) qn[jt][e] = qs_[(16 * jt + 4 * q + e) * 64 + 16 * wq + m]; } } while (0)
    RB_LOAD(0);
    for (int seg = 0; seg < RW_NSEG; ++seg) { const size_t u = (size_t)stream * RW_NSEG + seg; float* qs = RWQ + u * 4096;
        f32x4 zn[4]; bf16x8 mh[4][2], ml[4][2];
#pragma unroll
        for (int jt = 0; jt < 4; ++jt) { zn[jt] = qn[jt];
#pragma unroll
            for (int s = 0; s < 2; ++s) { const f32x4 x0 = mx[jt][s][0], x1 = mx[jt][s][1]; const u32x2 a0 = pk4(x0), a1 = pk4(x1); f32x4 h0, h1;
                h0[0] = bflo(a0.x); h0[1] = bfhi(a0.x); h0[2] = bflo(a0.y); h0[3] = bfhi(a0.y); h1[0] = bflo(a1.x); h1[1] = bfhi(a1.x); h1[2] = bflo(a1.y); h1[3] = bfhi(a1.y);
                mh[jt][s] = mk8(a0, a1); ml[jt][s] = mk8(pk4(x0 - h0), pk4(x1 - h1)); } }
#pragma unroll
        for (int jt = 0; jt < 4; ++jt)
#pragma unroll
            for (int e = 0; e < 4; ++e) qs[(16 * jt + 4 * q + e) * 64 + 16 * wq + m] = zt[jt][e];
        if (seg == RW_NSEG - 1) break;
        if (seg < RW_NSEG - 2) RB_LOAD(seg + 1);
        bf16x8 zh[2], zl[2];
#pragma unroll
        for (int s = 0; s < 2; ++s) { f32x4 h0, h1; const u32x2 a0 = pk4(zt[2 * s]), a1 = pk4(zt[2 * s + 1]);
            h0[0] = bflo(a0.x); h0[1] = bfhi(a0.x); h0[2] = bflo(a0.y); h0[3] = bfhi(a0.y); h1[0] = bflo(a1.x); h1[1] = bfhi(a1.x); h1[2] = bflo(a1.y); h1[3] = bfhi(a1.y);
            zh[s] = mk8(a0, a1); zl[s] = mk8(pk4(zt[2 * s] - h0), pk4(zt[2 * s + 1] - h1)); }
#pragma unroll
        for (int jt = 0; jt < 4; ++jt)
#pragma unroll
            for (int s = 0; s < 2; ++s) { zn[jt] = MFMA16(mh[jt][s], zh[s], zn[jt]); zn[jt] = MFMA16(mh[jt][s], zl[s], zn[jt]); zn[jt] = MFMA16(ml[jt][s], zh[s], zn[jt]); }
#pragma unroll
        for (int jt = 0; jt < 4; ++jt) zt[jt] = zn[jt];
    }
#undef RB_LOAD
}
constexpr int HG_Q1 = 0, HG_Q3 = 17408, HG_K3 = 34816, HG_K2T = 78336, HG_VT = 96768, HG_ATT = 115200, HG_TOT = 124416, HG_STAT = 126464, HG_DEC = 128512, HG_END = 129024;
static_assert(HG_END <= LDS_RING, "hgrn2 lds");
constexpr int HG_RAW = HG_Q3;
static_assert(HG_RAW + 64 * 768 <= HG_K2T, "hgrn2 raw staging");
template <int MODE>
__device__ __forceinline__ void ph_hgrn2(const Args& a, MK_LAS unsigned char* lds, int first_block = 0, unsigned* qhead = nullptr) {
    const int tid = MK_TID, lane = tid & 63, wave = tid >> 6, m = lane & 15, q = lane >> 4, chn = tid & 127, part = tid >> 7;
    const bf16_t* P = (const bf16_t*)(a.ws + WS_P); bf16_t* O = (bf16_t*)(a.ws + WS_O);
    float* HGS = (float*)(a.ws + WS_HGS); float* HGD = (float*)(a.ws + WS_HGD);
    if ((int)blockIdx.x < first_block) return;
    constexpr int NU = 1024; const int G = (int)gridDim.x - first_block, nit = (NU + G - 1) / G;
    for (int it = 0; qhead != nullptr || it < nit; ++it) {
        int u = it * G + (int)blockIdx.x - first_block;
        if (qhead != nullptr) { MK_LAS unsigned* slot = (MK_LAS unsigned*)(lds + LDS_MISC + 1024); __syncthreads(); if (tid == 0) *slot = __hip_atomic_fetch_add(qhead, 1u, __ATOMIC_RELAXED, __HIP_MEMORY_SCOPE_AGENT); __syncthreads(); u = (int)*slot; if (u >= NU) break; }
        const bool valid = u < NU; if (!valid) u = NU - 1;
        const int stream = u >> 6, seg = u & 63, b = stream >> 3, hh = stream & 7, cg = hh * 128 + chn;
        float lb; { const float l0 = a.in[I_HGLB][cg], l1 = a.in[I_HGLB][1024 + cg], mx = fmaxf(l0, l1), e0 = __expf(l0 - mx), e1 = __expf(l1 - mx); lb = e0 / (e0 + e1); }
        const int dvc = hh * 128 + 16 * wave + m;
        const float nw = a.in[I_HGNW][dvc];
        f32x4 st[8];
        if (MODE == 0) {
#pragma unroll
            for (int kt = 0; kt < 8; ++kt) st[kt] = (f32x4){0.f, 0.f, 0.f, 0.f};
        } else { int lofs = (4 * q) * 128 + 16 * wave + m; asm volatile("" : "+v"(lofs));
            const float* ss = HGS + (size_t)u * 16384 + lofs;
#pragma unroll
            for (int kt = 0; kt < 8; ++kt)
#pragma unroll
                for (int e = 0; e < 4; ++e) st[kt][e] = ss[(16 * kt + e) * 128]; }
        float segsum = 0.f;
        constexpr int NPT = (MODE == 1) ? 48 : 32, NPF = 64 * NPT / 512; u32x4 pf[NPF];
        const bf16_t* Pseg = P + ((size_t)b * T + seg * 256) * AB_LD + hh * 128;
#define HG_FETCH(t0c) do { int tq_ = tid; asm volatile("" : "+v"(tq_)); _Pragma("unroll") for (int i = 0; i < NPF; ++i) { const int j = tq_ + 512 * i, tt = j / NPT, rem = j - tt * NPT, arr = (rem >> 4) + ((MODE == 1) ? 0 : 1), c16 = rem & 15; \
            pf[i] = *(const u32x4*)(Pseg + (size_t)((t0c) + tt) * AB_LD + arr * 1024 + 8 * c16); } } while (0)
        HG_FETCH(0);
        for (int chunk = 0; chunk < 4; ++chunk) {
            const int t0 = seg * 256 + chunk * 64; const size_t row0 = (size_t)b * T + t0;
            { int tq_ = tid; asm volatile("" : "+v"(tq_));
#pragma unroll
            for (int i = 0; i < NPF; ++i) { const int j = tq_ + 512 * i, tt = j / NPT, rem = j - tt * NPT, arr = (rem >> 4) + ((MODE == 1) ? 0 : 1), c16 = rem & 15;
                *(MK_LAS u32x4*)(lds + HG_RAW + tt * 768 + arr * 256 + c16 * 16) = pf[i]; } }
            __syncthreads();
            float cl[16], kd[16], qs[16];
            {   float run = 0.f;
#pragma unroll
                for (int x = 0; x < 16; ++x) { const MK_LAS unsigned char* rw = lds + HG_RAW + (16 * part + x) * 768 + chn * 2; const float fl = bf2f(*(const MK_LAS bf16_t*)(rw + 256));
                    const float f = lb + (1.0f - lb) * fsigmoid(fl); run += __logf(f); cl[x] = run; kd[x] = 1.0f - f;
                    if (MODE == 1) qs[x] = siluf(bf2f(*(const MK_LAS bf16_t*)rw)); }
                *(MK_LAS float*)(lds + HG_TOT + (part * 128 + chn) * 4) = run; }
            u32x4 vw[2];
            {   float vv[16];
#pragma unroll
                for (int x = 0; x < 16; ++x) vv[x] = bf2f(*(const MK_LAS bf16_t*)(lds + HG_RAW + (16 * part + x) * 768 + 512 + chn * 2));
                vw[0].x = cvtpk(vv[0], vv[1]); vw[0].y = cvtpk(vv[2], vv[3]); vw[0].z = cvtpk(vv[4], vv[5]); vw[0].w = cvtpk(vv[6], vv[7]);
                vw[1].x = cvtpk(vv[8], vv[9]); vw[1].y = cvtpk(vv[10], vv[11]); vw[1].z = cvtpk(vv[12], vv[13]); vw[1].w = cvtpk(vv[14], vv[15]); }
            __syncthreads();
            {   const float t0s = *(const MK_LAS float*)(lds + HG_TOT + (0 * 128 + chn) * 4), t1s = *(const MK_LAS float*)(lds + HG_TOT + (1 * 128 + chn) * 4), t2s = *(const MK_LAS float*)(lds + HG_TOT + (2 * 128 + chn) * 4), t3s = *(const MK_LAS float*)(lds + HG_TOT + (3 * 128 + chn) * 4);
                const float r1 = t0s, r2 = t0s + t1s, r3 = r2 + t2s, Bc = r3 + t3s;
                const float rp = (part == 0) ? 0.f : (part == 1 ? r1 : (part == 2 ? r2 : r3));
                if (part == 0) { *(MK_LAS float*)(lds + HG_DEC + chn * 4) = __expf(Bc); segsum += Bc; }
                float k2[16], kb[16];
                if (MODE == 1) { const float eB = __expf(Bc - rp);
#pragma unroll
                    for (int x = 0; x < 16; ++x) { kb[x] = kd[x] * __expf(-cl[x]); k2[x] = kb[x] * eB; }
                } else {
#pragma unroll
                    for (int x = 0; x < 16; ++x) k2[x] = kd[x] * __expf(Bc - (rp + cl[x])); }
                u32x4 kw[2];
                kw[0].x = cvtpk(k2[0], k2[1]); kw[0].y = cvtpk(k2[2], k2[3]); kw[0].z = cvtpk(k2[4], k2[5]); kw[0].w = cvtpk(k2[6], k2[7]);
                kw[1].x = cvtpk(k2[8], k2[9]); kw[1].y = cvtpk(k2[10], k2[11]); kw[1].z = cvtpk(k2[12], k2[13]); kw[1].w = cvtpk(k2[14], k2[15]);
                *(MK_LAS u32x4*)(lds + HG_K2T + chn * 144 + part * 32) = kw[0]; *(MK_LAS u32x4*)(lds + HG_K2T + chn * 144 + part * 32 + 16) = kw[1];
                *(MK_LAS u32x4*)(lds + HG_VT + chn * 144 + part * 32) = vw[0]; *(MK_LAS u32x4*)(lds + HG_VT + chn * 144 + part * 32 + 16) = vw[1];
                if (MODE == 1) {
                    const float eR = __expf(rp);
#pragma unroll
                    for (int x = 0; x < 16; ++x) { const int tt = 16 * part + x; const float q3 = qs[x] * __expf(cl[x]);
                        *(MK_LAS bf16_t*)(lds + HG_Q1 + tt * 272 + chn * 2) = (bf16_t)(cvtpk(q3 * eR, 0.f) & 0xffffu);
                        *(MK_LAS bf16_t*)(lds + HG_Q3 + tt * 272 + chn * 2) = (bf16_t)(cvtpk(q3, 0.f) & 0xffffu);
                        if ((x & 3) == 3) __builtin_amdgcn_sched_barrier(0); }
                    for (int i2 = part; i2 < 4; ++i2) { const float ri = (i2 == 0) ? 0.f : (i2 == 1 ? r1 : (i2 == 2 ? r2 : r3)); const int off = (i2 == 0) ? 0 : (i2 == 1 ? 16 : (i2 == 2 ? 48 : 96));
                        const float eV = __expf(ri - rp);
#pragma unroll
                        for (int x = 0; x < 16; ++x) { *(MK_LAS bf16_t*)(lds + HG_K3 + (off + 16 * part + x) * 272 + chn * 2) = (bf16_t)(cvtpk(kb[x] * eV, 0.f) & 0xffffu);
                            if ((x & 3) == 3) __builtin_amdgcn_sched_barrier(0); } }
                }
            }
            __syncthreads();
            if (chunk < 3) HG_FETCH((chunk + 1) * 64);
            f32x4 o[4];
            if (MODE == 1) {
#pragma unroll
                for (int x = 0; x < 2; ++x) { const int blk = wave * 2 + x, bi = blk >> 2, bj = blk & 3; f32x4 acc = (f32x4){0.f, 0.f, 0.f, 0.f};
                    if (bj <= bi) { const int off = (bi == 0) ? 0 : (bi == 1 ? 16 : (bi == 2 ? 48 : 96));
#pragma unroll
                        for (int ks = 0; ks < 4; ++ks) acc = MFMA16(*(const MK_LAS bf16x8*)(lds + HG_Q3 + (16 * bi + m) * 272 + (32 * ks + 8 * q) * 2), *(const MK_LAS bf16x8*)(lds + HG_K3 + (off + 16 * bj + m) * 272 + (32 * ks + 8 * q) * 2), acc); }
#pragma unroll
                    for (int e = 0; e < 4; ++e) { const bool keep = (bj < bi) || (bj == bi && m <= 4 * q + e);
                        *(MK_LAS bf16_t*)(lds + HG_ATT + (16 * bi + 4 * q + e) * 144 + (16 * bj + m) * 2) = (bf16_t)(cvtpk(keep ? acc[e] : 0.f, 0.f) & 0xffffu); } }
                __syncthreads();
                bf16x8 sp[4];
#pragma unroll
                for (int s = 0; s < 4; ++s) sp[s] = mk8(pk4(st[2 * s]), pk4(st[2 * s + 1]));
#pragma unroll
                for (int ti = 0; ti < 4; ++ti) { f32x4 acc = (f32x4){0.f, 0.f, 0.f, 0.f};
#pragma unroll
                    for (int s = 0; s < 4; ++s) acc = MFMA16(mk8(*(const MK_LAS u32x2*)(lds + HG_Q1 + (16 * ti + m) * 272 + (32 * s + 4 * q) * 2), *(const MK_LAS u32x2*)(lds + HG_Q1 + (16 * ti + m) * 272 + (32 * s + 16 + 4 * q) * 2)), sp[s], acc);
#pragma unroll
                    for (int ks = 0; ks < 2; ++ks) if (ks <= (ti >> 1)) acc = MFMA16(*(const MK_LAS bf16x8*)(lds + HG_ATT + (16 * ti + m) * 144 + (32 * ks + 8 * q) * 2), *(const MK_LAS bf16x8*)(lds + HG_VT + (16 * wave + m) * 144 + (32 * ks + 8 * q) * 2), acc);
                    o[ti] = acc; }
            }
            {   const bf16x8 vf0 = *(const MK_LAS bf16x8*)(lds + HG_VT + (16 * wave + m) * 144 + (8 * q) * 2), vf1 = *(const MK_LAS bf16x8*)(lds + HG_VT + (16 * wave + m) * 144 + (32 + 8 * q) * 2);
#pragma unroll
                for (int kt = 0; kt < 8; ++kt) { const f32x4 d4 = *(const MK_LAS f32x4*)(lds + HG_DEC + (16 * kt + 4 * q) * 4); f32x4 z = st[kt] * d4;
                    z = MFMA16(*(const MK_LAS bf16x8*)(lds + HG_K2T + (16 * kt + m) * 144 + (8 * q) * 2), vf0, z);
                    z = MFMA16(*(const MK_LAS bf16x8*)(lds + HG_K2T + (16 * kt + m) * 144 + (32 + 8 * q) * 2), vf1, z); st[kt] = z; } }
            if (MODE == 1) {
#pragma unroll
                for (int ti = 0; ti < 4; ++ti)
#pragma unroll
                    for (int e = 0; e < 4; ++e) { const float s2 = red16(o[ti][e] * o[ti][e]); if (m == 0) *(MK_LAS float*)(lds + HG_STAT + (wave * 64 + 16 * ti + 4 * q + e) * 4) = s2; }
                __syncthreads();
#pragma unroll
                for (int ti = 0; ti < 4; ++ti)
#pragma unroll
                    for (int e = 0; e < 4; ++e) { const int tt = 16 * ti + 4 * q + e; float s2 = 0.f;
#pragma unroll
                        for (int w2 = 0; w2 < 8; ++w2) s2 += *(const MK_LAS float*)(lds + HG_STAT + (w2 * 64 + tt) * 4);
                        const float rstd = rsqrtf(s2 * (1.0f / 128.0f) + NORM_EPS);
                        *(MK_LAS bf16_t*)(lds + HG_Q1 + tt * 256 + (16 * wave + m) * 2) = (bf16_t)(cvtpk(o[ti][e] * rstd * nw, 0.f) & 0xffffu); }
                __syncthreads();
#pragma unroll
                for (int i = 0; i < 2; ++i) { const int pc = tid + 512 * i, tt = pc >> 4, c8 = pc & 15; const size_t row = row0 + tt;
                    const u32x4 ov = *(const MK_LAS u32x4*)(lds + HG_Q1 + tt * 256 + c8 * 16), gv = *(const u32x4*)(P + row * AB_LD + 3072 + hh * 128 + 8 * c8);
                    u32x4 w; w.x = cvtpk(bflo(ov.x) * siluf(bflo(gv.x)), bfhi(ov.x) * siluf(bfhi(gv.x))); w.y = cvtpk(bflo(ov.y) * siluf(bflo(gv.y)), bfhi(ov.y) * siluf(bfhi(gv.y)));
                    w.z = cvtpk(bflo(ov.z) * siluf(bflo(gv.z)), bfhi(ov.z) * siluf(bfhi(gv.z))); w.w = cvtpk(bflo(ov.w) * siluf(bflo(gv.w)), bfhi(ov.w) * siluf(bfhi(gv.w)));
                    if (valid) *(u32x4*)(O + row * D + hh * 128 + 8 * c8) = w; }
            }
            __syncthreads();
        }
#undef HG_FETCH
        if (MODE == 0 && valid) { int lofs = (4 * q) * 128 + 16 * wave + m; asm volatile("" : "+v"(lofs)); float* ss = HGS + (size_t)u * 16384 + lofs;
#pragma unroll
            for (int kt = 0; kt < 8; ++kt)
#pragma unroll
                for (int e = 0; e < 4; ++e) ss[(16 * kt + e) * 128] = st[kt][e];
            if (part == 0) HGD[(size_t)u * 128 + chn] = __expf(segsum); }
    }
}
__device__ __forceinline__ void ph_hgrn2_chain(const Args& a, int first_block) {
    float* HGS = (float*)(a.ws + WS_HGS); const float* HGD = (const float*)(a.ws + WS_HGD);
    const int gid = ((int)blockIdx.x - first_block) * 512 + MK_TID, NG = ((int)gridDim.x - first_block) * 512;
    for (int idx = gid; idx < 16 * 16384; idx += NG) { const int stream = idx >> 14, el = idx & 16383, dk = el >> 7; float run = 0.f;
        for (int c0 = 0; c0 < 64; c0 += 16) { float tv[16], dv[16];
#pragma unroll
            for (int i = 0; i < 16; ++i) { const size_t u = (size_t)stream * 64 + c0 + i; tv[i] = HGS[u * 16384 + el]; dv[i] = HGD[u * 128 + dk]; }
#pragma unroll
            for (int i = 0; i < 16; ++i) { const size_t u = (size_t)stream * 64 + c0 + i; HGS[u * 16384 + el] = run; run = dv[i] * run + tv[i]; } } }
}
constexpr size_t WS_S5BBT = 11 * MiB, WS_S5CP = 11 * MiB + 512 * 1024, WS_S5AB = 12 * MiB, WS_S5AL = 12 * MiB + 64 * 1024, WS_S5X = WS_SCR; constexpr size_t WS_S5Q = 65536 + 512;
__device__ __forceinline__ void s5_param_prep(const Args& a) {
    const int gid = blockIdx.x * 512 + MK_TID;
    if (gid >= 64 * 64) return;
    const int g = gid >> 6, p = gid & 63;
    const float lr = fminf(a.in[I_S5LR][gid], -1e-4f), li = a.in[I_S5LI][gid], dt = expf(a.in[I_S5DT][g]);
    const float mag = expf(lr * dt), abr = mag * cosf(li * dt), abi = mag * sinf(li * dt);
    const float nr = abr - 1.0f, ni = abi, den = lr * lr + li * li, zr = (nr * lr + ni * li) / den, zi = (ni * lr - nr * li) / den;
    float* AB = (float*)(a.ws + WS_S5AB); float* AL = (float*)(a.ws + WS_S5AL); bf16_t* BBT = (bf16_t*)(a.ws + WS_S5BBT); bf16_t* CP = (bf16_t*)(a.ws + WS_S5CP);
    AB[gid * 2] = abr; AB[gid * 2 + 1] = abi;
    float pr = abr, pi = abi;
#pragma unroll
    for (int i = 0; i < 8; ++i) { const float nr2 = pr * pr - pi * pi, ni2 = 2.0f * pr * pi; pr = nr2; pi = ni2; }
    AL[gid * 2] = pr; AL[gid * 2 + 1] = pi;
    for (int c = 0; c < 16; ++c) { const float br = a.in[I_S5BR][gid * 16 + c], bi = a.in[I_S5BI][gid * 16 + c];
        BBT[(g * 128 + p) * 16 + c] = (bf16_t)(cvtpk(zr * br - zi * bi, 0.f) & 0xffffu); BBT[(g * 128 + 64 + p) * 16 + c] = (bf16_t)(cvtpk(zr * bi + zi * br, 0.f) & 0xffffu);
        CP[(g * 16 + c) * 128 + p] = (bf16_t)(cvtpk(a.in[I_S5CR][(g * 16 + c) * 64 + p], 0.f) & 0xffffu); CP[(g * 16 + c) * 128 + 64 + p] = (bf16_t)(cvtpk(-a.in[I_S5CI][(g * 16 + c) * 64 + p], 0.f) & 0xffffu); }
}
template <int MODE_>
__device__ __forceinline__ void ph_s5(const Args& a, MK_LAS unsigned char* lds) {
    constexpr int MODE = (MODE_ >= 1) ? 1 : 0;
    const int tid = MK_TID, lane = tid & 63, wave = tid >> 6, m = lane & 15, q = lane >> 4, gw = blockIdx.x * 8 + wave, NGW = gridDim.x * 8;
    const bf16_t* P = (const bf16_t*)(a.ws + WS_P); bf16_t* Z = (bf16_t*)(a.ws + ((MODE_ >= 2) ? (WS_P + 360 * MiB) : WS_H)); float* SX = (float*)(a.ws + WS_S5X);
    const bf16_t* BBT = (const bf16_t*)(a.ws + WS_S5BBT); const bf16_t* CP = (const bf16_t*)(a.ws + WS_S5CP); const float* AB = (const float*)(a.ws + WS_S5AB);
    MK_LAS float* Lbu = (MK_LAS float*)(lds + wave * 12800); MK_LAS unsigned char* Lx = lds + wave * 12800 + 8448;
    const bf16x8 zero8 = (bf16x8){0, 0, 0, 0, 0, 0, 0, 0};
    unsigned* qhead = (unsigned*)(a.ws + WS_S5Q + ((MODE_ >= 2) ? 64 : 0));
    for (int u0 = gw;; u0 += NGW) {
        int u = u0;
        if (MODE == 1 && MK_S5_DYN) { unsigned c_ = 0u; if (lane == 0) c_ = __hip_atomic_fetch_add(qhead, 1u, __ATOMIC_RELAXED, __HIP_MEMORY_SCOPE_AGENT); u = __builtin_amdgcn_readfirstlane((int)c_); }
        if (u >= 8192) break;
        const int seg = u & 63, s = u >> 6, b = s >> 6, g = s & 63;
        bf16x8 bbf[8], cpf[4];
#pragma unroll
        for (int ct = 0; ct < 8; ++ct) bbf[ct] = (q < 2) ? *(const bf16x8*)(BBT + (g * 128 + 16 * ct + m) * 16 + 8 * q) : zero8;
        if (MODE == 1) {
#pragma unroll
            for (int ks = 0; ks < 4; ++ks) cpf[ks] = *(const bf16x8*)(CP + (g * 16 + m) * 128 + 32 * ks + 8 * q); }
        const float abr = AB[(g * 64 + lane) * 2], abi = AB[(g * 64 + lane) * 2 + 1], dch = a.in[I_S5D][g * 16 + m];
        float xr = 0.f, xi = 0.f;
        if (MODE == 1) {
            const float alr = ((const float*)(a.ws + WS_S5AL))[(g * 64 + lane) * 2], ali = ((const float*)(a.ws + WS_S5AL))[(g * 64 + lane) * 2 + 1];
            for (int c0 = 0; c0 < ((MODE_ == 2) ? 0 : seg); c0 += 16) { float tr[16], ti[16]; const int n = (seg - c0) < 16 ? (seg - c0) : 16;
#pragma unroll
                for (int i = 0; i < 16; ++i) { const size_t uu = (size_t)s * 64 + c0 + (i < n ? i : 0); if (MODE_ == 4 || MK_S5_SC1) { tr[i] = __hip_atomic_load(SX + uu * 128 + lane, __ATOMIC_RELAXED, MK_S5_SCOPE); ti[i] = __hip_atomic_load(SX + uu * 128 + 64 + lane, __ATOMIC_RELAXED, MK_S5_SCOPE); } else { tr[i] = SX[uu * 128 + lane]; ti[i] = SX[uu * 128 + 64 + lane]; } }
#pragma unroll
                for (int i = 0; i < 16; ++i) if (i < n) { const float nxr = alr * xr - ali * xi + tr[i], nxi = alr * xi + ali * xr + ti[i]; xr = nxr; xi = nxi; } } }
        const size_t rowu = (size_t)b * T + seg * 256;
        bf16x8 ufn = zero8; if (q < 2) ufn = (MODE == 1 && MK_S5_NT) ? __builtin_nontemporal_load((const bf16x8*)(P + (rowu + m) * CD_LD + g * 16 + 8 * q)) : *(const bf16x8*)(P + (rowu + m) * CD_LD + g * 16 + 8 * q);
        for (int tile = 0; tile < 16; ++tile) {
            const size_t row0 = rowu + tile * 16;
            const bf16x8 uf = ufn;
            if (tile < 15 && q < 2) ufn = (MODE == 1 && MK_S5_NT) ? __builtin_nontemporal_load((const bf16x8*)(P + (row0 + 16 + m) * CD_LD + g * 16 + 8 * q)) : *(const bf16x8*)(P + (row0 + 16 + m) * CD_LD + g * 16 + 8 * q);
            float uvv[4];
            if (MODE == 1) {
#pragma unroll
                for (int e = 0; e < 4; ++e) uvv[e] = bf2f(MK_S5_NT ? __builtin_nontemporal_load(P + (row0 + 4 * q + e) * CD_LD + g * 16 + m) : P[(row0 + 4 * q + e) * CD_LD + g * 16 + m]); }
#pragma unroll
            for (int ct = 0; ct < 8; ++ct) { f32x4 acc = (f32x4){0.f, 0.f, 0.f, 0.f}; acc = MFMA16(uf, bbf[ct], acc);
#pragma unroll
                for (int e = 0; e < 4; ++e) Lbu[(4 * q + e) * 132 + 16 * ct + m] = acc[e]; }
            asm volatile("s_waitcnt lgkmcnt(0)" ::: "memory");
#pragma unroll
            for (int tt = 0; tt < 16; ++tt) { const float br = Lbu[tt * 132 + lane], bi = Lbu[tt * 132 + 64 + lane];
                const float nxr = abr * xr - abi * xi + br, nxi = abr * xi + abi * xr + bi; xr = nxr; xi = nxi;
                if (MODE == 1) { *(MK_LAS bf16_t*)(Lx + tt * 272 + lane * 2) = (bf16_t)(cvtpk(xr, 0.f) & 0xffffu); *(MK_LAS bf16_t*)(Lx + tt * 272 + (64 + lane) * 2) = (bf16_t)(cvtpk(xi, 0.f) & 0xffffu); } }
            asm volatile("s_waitcnt lgkmcnt(0)" ::: "memory");
            if (MODE == 1) { f32x4 y = (f32x4){0.f, 0.f, 0.f, 0.f};
#pragma unroll
                for (int ks = 0; ks < 4; ++ks) y = MFMA16(*(const MK_LAS bf16x8*)(Lx + m * 272 + (32 * ks + 8 * q) * 2), cpf[ks], y);
#pragma unroll
                for (int e = 0; e < 4; ++e) { const size_t row = row0 + 4 * q + e;
                    Z[row * 1024 + g * 16 + m] = (bf16_t)(cvtpk(gelu_tanh(y[e] + dch * uvv[e]), 0.f) & 0xffffu); }
                asm volatile("s_waitcnt lgkmcnt(0)" ::: "memory"); }
        }
        if (MODE == 0) { SX[(size_t)u * 128 + lane] = xr; SX[(size_t)u * 128 + 64 + lane] = xi; }
    }
}
__device__ __forceinline__ void ph_s5_chain(const Args& a) {
    const int idx = blockIdx.x * 64 + (MK_TID & 63); if (idx >= 8192) return;
    const int s = idx >> 6, p = idx & 63, g = s & 63; float* SX = (float*)(a.ws + WS_S5X); const float* AL = (const float*)(a.ws + WS_S5AL);
    const float alr = AL[(g * 64 + p) * 2], ali = AL[(g * 64 + p) * 2 + 1]; float xr = 0.f, xi = 0.f;
    for (int s0 = 0; s0 < 64; s0 += 16) { float tr[16], ti[16];
#pragma unroll
        for (int i = 0; i < 16; ++i) { const size_t u = (size_t)s * 64 + s0 + i; tr[i] = SX[u * 128 + p]; ti[i] = SX[u * 128 + 64 + p]; }
#pragma unroll
        for (int i = 0; i < 16; ++i) { const size_t u = (size_t)s * 64 + s0 + i; SX[u * 128 + p] = xr; SX[u * 128 + 64 + p] = xi; const float nxr = alr * xr - ali * xi + tr[i], nxi = alr * xi + ali * xr + ti[i]; xr = nxr; xi = nxi; } }
}
__device__ __forceinline__ void ph_fox_cumsum(const Args& a, MK_LAS unsigned char* lds) {
    const int lane = MK_TID & 63, wave = MK_TID >> 6, s = blockIdx.x, b = s >> 3, hd = s & 7;
    const float* logf = (const float*)(a.ws + WS_LOGF); float* cum = (float*)(a.ws + WS_CUM);
    MK_LAS double* tot = (MK_LAS double*)(lds + 8 * 12800);
    float v[32]; double sum = 0.0;
#pragma unroll
    for (int i = 0; i < 32; ++i) { v[i] = logf[((size_t)b * T + 2048 * wave + 64 * i + lane) * 8 + hd]; sum += (double)v[i]; }
#pragma unroll
    for (int o = 32; o > 0; o >>= 1) sum += __shfl_xor(sum, o);
    if (lane == 0) tot[wave] = sum;
    __syncthreads();
    double carry = 0.0;
    for (int w2 = 0; w2 < wave; ++w2) carry += tot[w2];
#pragma unroll
    for (int i = 0; i < 32; ++i) { double x = (double)v[i];
#pragma unroll
        for (int o = 1; o < 64; o <<= 1) { const double w = __shfl_up(x, o); if (lane >= o) x += w; }
        cum[((size_t)b * T + 2048 * wave + 64 * i + lane) * 8 + hd] = (float)(carry + x); carry += __shfl(x, 63); }
    __syncthreads();
}
constexpr size_t WS_WRH = 13 * MiB, WS_WRL = 13 * MiB + 512 * 1024, WS_RSTOK = 14 * MiB, WS_RSP = 14 * MiB + 512 * 1024;
constexpr int NRT = 1;
constexpr int RT_RED = 0, RT_SS = 8 * 32 * 48 * 4, RT_LOG = RT_SS + 8 * 32 * 4, RT_RSTD = RT_LOG + 32 * 36 * 4, RT_END = RT_RSTD + 128;
__device__ __forceinline__ void router_weight_prep(const Args& a) {
    const int gid = blockIdx.x * 512 + MK_TID, NG = gridDim.x * 512;
    bf16_t* WH = (bf16_t*)(a.ws + WS_WRH); bf16_t* WL = (bf16_t*)(a.ws + WS_WRL);
    for (int i = gid; i < 2 * 48 * 2048; i += NG) { const int layer = i / (48 * 2048), rem = i - layer * 48 * 2048, c = rem >> 11, k = rem & 2047;
        float w = 0.f; if (c < 4) w = a.in[I_MWG][((size_t)layer * D + k) * 4 + c]; else if (c < 36) w = a.in[I_MWR][((size_t)layer * D + k) * 32 + (c - 4)];
        w *= a.in[I_FFNW][layer * D + k];
        const unsigned hb = cvtpk(w, 0.f) & 0xffffu; const float hf = __uint_as_float(hb << 16);
        WH[i] = (bf16_t)hb; WL[i] = (bf16_t)(cvtpk(w - hf, 0.f) & 0xffffu); }
}
constexpr int RT_WROW = 272, RT_WARR = 48 * RT_WROW, RT_WBUF = 2 * RT_WARR, RT_LOGO = 2 * RT_WBUF, RT_END2 = RT_LOGO + 8 * 16 * 48 * 4;
static_assert(RT_END2 <= LDS_RING, "router lds");
template <int ABL = 0> __device__ __forceinline__ void ph_router(const Args& a, int layer, MK_LAS unsigned char* lds) {
    const int tid = MK_TID, lane = tid & 63, wave = tid >> 6, m = lane & 15, q = lane >> 4;
    MK_LAS int* Lh = (MK_LAS int*)(lds + LDS_MISC + 64);
    if (tid < 32) Lh[tid] = 0;
    __syncthreads();
    const float* x = a.out; bf16_t* H = (bf16_t*)(a.ws + WS_H);
    const float* wn = a.in[I_FFNW] + layer * D; const float* bg = a.in[I_MBG] + layer * 4; const float* br = a.in[I_MBR] + layer * 32;
    const bf16_t* WH = (const bf16_t*)(a.ws + WS_WRH) + (size_t)layer * 48 * 2048; const bf16_t* WL = (const bf16_t*)(a.ws + WS_WRL) + (size_t)layer * 48 * 2048;
    int* re = (int*)(a.ws + WS_RE); float* rwt = (float*)(a.ws + WS_RWT);
    MK_LAS float* LOGW = (MK_LAS float*)(lds + RT_LOGO + wave * 16 * 48 * 4);
    for (int blk = blockIdx.x; blk < NTOK / 128; blk += gridDim.x) {
        const float* xrow = x + (size_t)(blk * 128 + 16 * wave + m) * D + 8 * q;
        f32x4 acc[3], xs[4][2], xn[4][2]; u32x4 wreg[3]; float ss = 0.f;
#pragma unroll
        for (int ct = 0; ct < 3; ++ct) acc[ct] = (f32x4){0.f, 0.f, 0.f, 0.f};
#define RT_WLOAD(c) do { _Pragma("unroll") for (int i = 0; i < 3; ++i) { const int j = tid + 512 * i, arr = j / 768, rem = j - arr * 768, r = rem >> 4, p16 = rem & 15; \
            wreg[i] = *(const u32x4*)((arr ? WL : WH) + (size_t)r * 2048 + 128 * (c) + 8 * p16); } } while (0)
#define RT_WSTORE(buf) do { _Pragma("unroll") for (int i = 0; i < 3; ++i) { const int j = tid + 512 * i, arr = j / 768, rem = j - arr * 768, r = rem >> 4, p16 = rem & 15; \
            *(MK_LAS u32x4*)(lds + (buf) * RT_WBUF + arr * RT_WARR + r * RT_WROW + p16 * 16) = wreg[i]; } } while (0)
#define RT_XLOAD(dst, c) do { _Pragma("unroll") for (int s = 0; s < 4; ++s) { const float* xp = xrow + 128 * (c) + 32 * s; dst[s][0] = *(const f32x4*)xp; dst[s][1] = *(const f32x4*)(xp + 4); } } while (0)
        RT_WLOAD(0); RT_XLOAD(xs, 0);
        for (int c = 0; c < 16; ++c) { const int buf = c & 1;
            RT_WSTORE(buf);
            if (c < 15) { RT_WLOAD(c + 1); RT_XLOAD(xn, c + 1); }
            __syncthreads();
            if (!(ABL & 1)) {
#pragma unroll
            for (int s = 0; s < 4; ++s) { const f32x4 v0 = xs[s][0], v1 = xs[s][1];
                ss += (v0[0] * v0[0] + v0[1] * v0[1]) + (v0[2] * v0[2] + v0[3] * v0[3]) + (v1[0] * v1[0] + v1[1] * v1[1]) + (v1[2] * v1[2] + v1[3] * v1[3]);
                const u32x2 h0 = pk4(v0), h1 = pk4(v1); f32x4 f0, f1;
                f0[0] = bflo(h0.x); f0[1] = bfhi(h0.x); f0[2] = bflo(h0.y); f0[3] = bfhi(h0.y); f1[0] = bflo(h1.x); f1[1] = bfhi(h1.x); f1[2] = bflo(h1.y); f1[3] = bfhi(h1.y);
                const bf16x8 xh = mk8(h0, h1), xl = mk8(pk4(v0 - f0), pk4(v1 - f1));
                if (!(ABL & 2)) { const int k = 128 * c + 32 * s + 8 * q; const f32x4 g0 = *(const f32x4*)(wn + k), g1 = *(const f32x4*)(wn + k + 4);
                    const u32x2 p0 = pk4(v0 * g0), p1 = pk4(v1 * g1); u32x4 w; w.x = p0.x; w.y = p0.y; w.z = p1.x; w.w = p1.y;
                    *(u32x4*)(H + (size_t)(blk * 128 + 16 * wave + m) * D + k) = w; }
#pragma unroll
                for (int ct = 0; ct < 3; ++ct) { const MK_LAS unsigned char* wp = lds + buf * RT_WBUF + (16 * ct + m) * RT_WROW + (32 * s + 8 * q) * 2;
                    const bf16x8 wh = *(const MK_LAS bf16x8*)wp, wl = *(const MK_LAS bf16x8*)(wp + RT_WARR);
                    acc[ct] = MFMA16(xh, wh, acc[ct]); acc[ct] = MFMA16(xl, wh, acc[ct]); acc[ct] = MFMA16(xh, wl, acc[ct]); } } }
#pragma unroll
            for (int s = 0; s < 4; ++s) { xs[s][0] = xn[s][0]; xs[s][1] = xn[s][1]; }
        }
#undef RT_WLOAD
#undef RT_WSTORE
#undef RT_XLOAD
        ss += __shfl_xor(ss, 16); ss += __shfl_xor(ss, 32);
        const float rstd = rsqrtf(ss * (1.0f / D) + NORM_EPS);
#pragma unroll
        for (int e = 0; e < 4; ++e) { const float rs = __shfl(rstd, 4 * q + e);
#pragma unroll
            for (int ct = 0; ct < 3; ++ct) LOGW[(4 * q + e) * 48 + 16 * ct + m] = acc[ct][e] * rs; }
        asm volatile("s_waitcnt lgkmcnt(0)" ::: "memory");
        if (!(ABL & 4) && q == 0) { const MK_LAS float* lg = LOGW + m * 48; const int tok = blk * 128 + 16 * wave + m;
            float gl4[4];
#pragma unroll
            for (int c2 = 0; c2 < 4; ++c2) gl4[c2] = lg[c2] + bg[c2];
            int gi = 0; float gm = gl4[0];
#pragma unroll
            for (int c2 = 1; c2 < 4; ++c2) if (gl4[c2] > gm) { gm = gl4[c2]; gi = c2; }
            float gs = 0.f;
#pragma unroll
            for (int c2 = 0; c2 < 4; ++c2) gs += __expf(gl4[c2] - gm);
            const float gw = 1.0f / gs; const MK_LAS float* el = lg + 4 + gi * 8; const float* bre = br + gi * 8;
            float ev[8];
#pragma unroll
            for (int c2 = 0; c2 < 8; ++c2) ev[c2] = el[c2] + bre[c2];
            int i0 = 0; float v0 = ev[0];
#pragma unroll
            for (int c2 = 1; c2 < 8; ++c2) if (ev[c2] > v0) { v0 = ev[c2]; i0 = c2; }
            int i1 = -1; float v1 = -3.0e38f;
#pragma unroll
            for (int c2 = 0; c2 < 8; ++c2) if (c2 != i0 && ev[c2] > v1) { v1 = ev[c2]; i1 = c2; }
            const float ex = __expf(v1 - v0), w0 = gw / (1.0f + ex), w1 = gw * ex / (1.0f + ex);
            const int e0 = gi * 8 + i0, e1 = gi * 8 + i1; re[2 * tok] = e0; re[2 * tok + 1] = e1; rwt[2 * tok] = w0; rwt[2 * tok + 1] = w1;
            atomicAdd((int*)(Lh + e0), 1); atomicAdd((int*)(Lh + e1), 1); }
        if (q == 0) ((float*)(a.ws + WS_RSTOK))[blk * 128 + 16 * wave + m] = rstd;
        __syncthreads();
        if (tid < 32) { ((int*)(a.ws + WS_HIST))[blk * 32 + tid] = Lh[tid]; Lh[tid] = 0; }
        __syncthreads();
    }
}
__device__ __forceinline__ void ph_scatter(const Args& a, MK_LAS unsigned char* lds) {
    const int tid = MK_TID, lane = tid & 63, wave = tid >> 6;
    MK_LAS int* Lbase = (MK_LAS int*)(lds + LDS_MISC + 64); MK_LAS int* Lcur = Lbase + 32; MK_LAS int* Ltot = Lcur + 32; MK_LAS int* Loff = Ltot + 32;
    const int* hist = (const int*)(a.ws + WS_HIST); const int* re = (const int*)(a.ws + WS_RE); int* pos = (int*)(a.ws + WS_POS);
    const bf16_t* H = (const bf16_t*)(a.ws + WS_H); bf16_t* HP = (bf16_t*)(a.ws + WS_P);
    for (int blk = blockIdx.x; blk < NTOK / 128; blk += gridDim.x) {
        if (tid < 32) { Ltot[tid] = 0; Lbase[tid] = 0; Lcur[tid] = 0; }
        __syncthreads();
        {   const int e = tid & 31; int hv[16], tot = 0, bef = 0;
#pragma unroll
            for (int j = 0; j < 16; ++j) hv[j] = hist[((tid >> 5) + 16 * j) * 32 + e];
#pragma unroll
            for (int j = 0; j < 16; ++j) { tot += hv[j]; bef += (((tid >> 5) + 16 * j) < blk) ? hv[j] : 0; }
            atomicAdd((int*)(Ltot + e), tot); atomicAdd((int*)(Lbase + e), bef); }
        __syncthreads();
        if (tid == 0) { int off = 0; for (int e = 0; e < 32; ++e) { Loff[e] = off; off += ((Ltot[e] + 255) >> 8) << 8; }
            if (blk == 0) { int* te = (int*)(a.ws + WS_TILEE); for (int e = 0; e < 32; ++e) { const int t0 = Loff[e] >> 8, nt = (Ltot[e] + 255) >> 8; for (int q = 0; q < nt; ++q) te[t0 + q] = e; }
                *(int*)(a.ws + WS_NT) = off >> 8; } }
        __syncthreads();
        {
            const int mb = blk * 128 + 16 * wave; int p0 = 0, p1 = 0;
            if (lane < 16) { const int m = mb + lane; const int e0 = re[2 * m], e1 = re[2 * m + 1];
                p0 = Loff[e0] + Lbase[e0] + atomicAdd((int*)(Lcur + e0), 1); p1 = Loff[e1] + Lbase[e1] + atomicAdd((int*)(Lcur + e1), 1);
                pos[2 * m] = p0; pos[2 * m + 1] = p1; const float rs = ((const float*)(a.ws + WS_RSTOK))[m]; float* rsp = (float*)(a.ws + WS_RSP); rsp[p0] = rs; rsp[p1] = rs; }
#pragma unroll 1
            for (int t4 = 0; t4 < 16; t4 += 4) { u32x4 w[4][4]; int q0[4], q1[4];
#pragma unroll
                for (int t = 0; t < 4; ++t) { q0[t] = __shfl(p0, t4 + t); q1[t] = __shfl(p1, t4 + t); const u32x4* src = (const u32x4*)(H + (size_t)(mb + t4 + t) * D);
#pragma unroll
                    for (int j = 0; j < 4; ++j) w[t][j] = src[lane + 64 * j]; }
#pragma unroll
                for (int t = 0; t < 4; ++t) { u32x4* d0 = (u32x4*)(HP + (size_t)q0[t] * D); u32x4* d1 = (u32x4*)(HP + (size_t)q1[t] * D);
#pragma unroll
                    for (int j = 0; j < 4; ++j) { d0[lane + 64 * j] = w[t][j]; d1[lane + 64 * j] = w[t][j]; } } }
        }
        __syncthreads();
    }
}
__device__ __forceinline__ void ph_combine(const Args& a, int mode, MK_LAS unsigned char* lds) {
    const int lane = MK_TID & 63, gw = blockIdx.x * 8 + (MK_TID >> 6), NGW = gridDim.x * 8;
    const bf16_t* Y = (const bf16_t*)(a.ws + WS_P); const int* pos = (const int*)(a.ws + WS_POS); const float* rwt = (const float*)(a.ws + WS_RWT);
    bf16_t* H = (bf16_t*)(a.ws + WS_H); float* logf = (float*)(a.ws + WS_LOGF);
    int pp0 = 0, pp1 = 0; float pw0 = 0.f, pw1 = 0.f;
    { const int mm = gw + lane * NGW; if (lane < 16 && mm < NTOK) { pp0 = pos[2 * mm]; pp1 = pos[2 * mm + 1]; pw0 = rwt[2 * mm]; pw1 = rwt[2 * mm + 1]; } }
    int ti = 0;
    for (int m = gw; m < NTOK; m += NGW, ++ti) {
        float* xr = a.out + (size_t)m * D; int p0, p1; float w0, w1;
        if (ti < 16) { p0 = __shfl(pp0, ti); p1 = __shfl(pp1, ti); w0 = __shfl(pw0, ti); w1 = __shfl(pw1, ti); } else { p0 = pos[2 * m]; p1 = pos[2 * m + 1]; w0 = rwt[2 * m]; w1 = rwt[2 * m + 1]; }
        const bf16_t* y0 = Y + (size_t)p0 * D; const bf16_t* y1 = Y + (size_t)p1 * D; f32x4 v[8];
#pragma unroll
        for (int j = 0; j < 8; ++j) { const int k = 4 * (lane + 64 * j); v[j] = *(const f32x4*)(xr + k); const u32x2 a0 = *(const u32x2*)(y0 + k), a1 = *(const u32x2*)(y1 + k);
            v[j][0] += w0 * bflo(a0.x) + w1 * bflo(a1.x); v[j][1] += w0 * bfhi(a0.x) + w1 * bfhi(a1.x); v[j][2] += w0 * bflo(a0.y) + w1 * bflo(a1.y); v[j][3] += w0 * bfhi(a0.y) + w1 * bfhi(a1.y); }
        const float rstd = row_rstd(v);
        if (mode == 0) {
#pragma unroll
            for (int j = 0; j < 8; ++j) *(f32x4*)(xr + 4 * (lane + 64 * j)) = v[j];
            norm_scale(v, rstd, a.in[I_MIXW] + D, lane); store_row_bf16(v, H + (size_t)m * D, lane);
            float fl[8];
#pragma unroll
            for (int q = 0; q < 8; ++q) fl[q] = 0.f;
#pragma unroll
            for (int j = 0; j < 8; ++j)
#pragma unroll
                for (int i4 = 0; i4 < 4; ++i4) { const int k = 4 * (lane + 64 * j) + i4; const float* wrow = a.in[I_CDIN] + (size_t)k * CD_COLS + 4096; const f32x4 wa = *(const f32x4*)wrow, wb = *(const f32x4*)(wrow + 4);
#pragma unroll
                    for (int q = 0; q < 4; ++q) { fl[q] += v[j][i4] * wa[q]; fl[4 + q] += v[j][i4] * wb[q]; } }
#pragma unroll
            for (int q = 0; q < 8; ++q) fl[q] = wave_sum(fl[q]);
            if (lane < 8) { float f = fl[0];
#pragma unroll
                for (int q = 1; q < 8; ++q) f = (lane == q) ? fl[q] : f;
                logf[(size_t)m * 8 + lane] = -softplusf(-(f + a.in[I_FOXB][lane])); }
        } else {
            norm_scale(v, rstd, a.in[I_FINW], lane);
#pragma unroll
            for (int j = 0; j < 8; ++j) *(f32x4*)(xr + 4 * (lane + 64 * j)) = v[j];
        }
    }
    (void)lds;
}
__device__ __forceinline__ void ph_s5_naive(const Args& a, MK_LAS unsigned char* lds) {
    const int tid = MK_TID, lane = tid & 63, wave = tid >> 6;
    if (blockIdx.x < 16) {
        constexpr int TS = 16;
        const int s = blockIdx.x * 8 + wave, b = s >> 6, g = s & 63, p = lane;
        const bf16_t* P = (const bf16_t*)(a.ws + WS_P); bf16_t* Z = (bf16_t*)(a.ws + WS_H);
        MK_LAS float* Lu = (MK_LAS float*)lds + wave * (TS * 16 + 2 * TS * 64); MK_LAS float* Lxr = Lu + TS * 16; MK_LAS float* Lxi = Lxr + TS * 64;
        const float lr = fminf(a.in[I_S5LR][g * 64 + p], -1e-4f), li = a.in[I_S5LI][g * 64 + p], dt = expf(a.in[I_S5DT][g]);
        const float mag = expf(lr * dt), abr = mag * cosf(li * dt), abi = mag * sinf(li * dt);
        const float nr = abr - 1.0f, ni = abi, den = lr * lr + li * li, zr = (nr * lr + ni * li) / den, zi = (ni * lr - nr * li) / den;
        float bbr[16], bbi[16];
#pragma unroll
        for (int c = 0; c < 16; ++c) { const float br = a.in[I_S5BR][(g * 64 + p) * 16 + c], bi = a.in[I_S5BI][(g * 64 + p) * 16 + c]; bbr[c] = zr * br - zi * bi; bbi[c] = zr * bi + zi * br; }
        float xr = 0.f, xi = 0.f;
        for (int t0 = 0; t0 < T; t0 += TS) {
#pragma unroll
            for (int q = 0; q < 4; ++q) { const int i = lane + 64 * q, tt = i >> 4, c = i & 15; Lu[i] = bf2f(P[((size_t)b * T + t0 + tt) * CD_LD + g * 16 + c]); }
            asm volatile("s_waitcnt lgkmcnt(0)" ::: "memory");
            for (int tt = 0; tt < TS; ++tt) { float ur = 0.f, ui = 0.f;
#pragma unroll
                for (int c = 0; c < 16; ++c) { const float u = Lu[tt * 16 + c]; ur += bbr[c] * u; ui += bbi[c] * u; }
                const float nxr = abr * xr - abi * xi + ur, nxi = abr * xi + abi * xr + ui; xr = nxr; xi = nxi;
                Lxr[tt * 64 + p] = xr; Lxi[tt * 64 + p] = xi; }
            asm volatile("s_waitcnt lgkmcnt(0)" ::: "memory");
#pragma unroll
            for (int q = 0; q < 4; ++q) { const int i = lane + 64 * q, tt = i >> 4, c = i & 15; float y = 0.f;
                const float* cr = a.in[I_S5CR] + (g * 16 + c) * 64; const float* ci = a.in[I_S5CI] + (g * 16 + c) * 64;
                for (int pp = 0; pp < 64; ++pp) y += cr[pp] * Lxr[tt * 64 + pp] - ci[pp] * Lxi[tt * 64 + pp];
                y += a.in[I_S5D][g * 16 + c] * Lu[i];
                Z[((size_t)b * T + t0 + tt) * 1024 + g * 16 + c] = (bf16_t)(cvt_pk_bf16(gelu_tanh(y), 0.f) & 0xffffu); }
            asm volatile("s_waitcnt lgkmcnt(0)" ::: "memory");
        }
    } else if (blockIdx.x < 32 && wave == 0) {
        const int s = blockIdx.x - 16, b = s >> 3, hd = s & 7;
        const float* logf = (const float*)(a.ws + WS_LOGF); float* cum = (float*)(a.ws + WS_CUM);
        double carry = 0.0;
        for (int t0 = 0; t0 < T; t0 += 64) { const size_t idx = ((size_t)b * T + t0 + lane) * 8 + hd;
            double v = (double)logf[idx];
#pragma unroll
            for (int o = 1; o < 64; o <<= 1) { const double u = __shfl_up(v, o); if (lane >= o) v += u; }
            cum[idx] = (float)(carry + v); carry += __shfl(v, 63); }
    }
}
__device__ __forceinline__ void ph_fox_naive(const Args& a, MK_LAS unsigned char* lds) {
    const int tid = MK_TID, lane = tid & 63, wave = tid >> 6, gw = blockIdx.x * 8 + wave, NGW = gridDim.x * 8;
    const bf16_t* P = (const bf16_t*)(a.ws + WS_P); bf16_t* O = (bf16_t*)(a.ws + WS_O); const float* cum = (const float*)(a.ws + WS_CUM);
    MK_LAS float* Lq = (MK_LAS float*)lds + wave * 128;
    const float scale = 0.08838834764831845f;
    for (int u = gw; u < NB * 8 * T; u += NGW) { const int bh = u / T, t = u % T, b = bh >> 3, hd = bh & 7; const size_t row = (size_t)b * T + t;
        { const unsigned w = *(const unsigned*)(P + row * CD_LD + 1024 + hd * 128 + 2 * lane); Lq[2 * lane] = bflo(w) * scale; Lq[2 * lane + 1] = bfhi(w) * scale; }
        asm volatile("s_waitcnt lgkmcnt(0)" ::: "memory");
        const float ct = cum[row * 8 + hd]; float mrun = -3.0e38f, lrun = 0.f, o0 = 0.f, o1 = 0.f;
        for (int j0 = 0; j0 <= t; j0 += 64) { const int key = j0 + lane; const bool valid = key <= t; const size_t krow = (size_t)b * T + (valid ? key : t);
            const u32x4* kp = (const u32x4*)(P + krow * CD_LD + 2048 + hd * 128); float dot = 0.f;
#pragma unroll
            for (int i = 0; i < 16; ++i) { const u32x4 kw = kp[i]; const f32x4 qa = *(const MK_LAS f32x4*)(Lq + 8 * i), qb = *(const MK_LAS f32x4*)(Lq + 8 * i + 4);
                dot += bflo(kw.x) * qa[0] + bfhi(kw.x) * qa[1] + bflo(kw.y) * qa[2] + bfhi(kw.y) * qa[3] + bflo(kw.z) * qb[0] + bfhi(kw.z) * qb[1] + bflo(kw.w) * qb[2] + bfhi(kw.w) * qb[3]; }
            const float sc = valid ? dot + (ct - cum[krow * 8 + hd]) : -3.0e38f;
            const float mnew = fmaxf(mrun, wave_max(sc)); const float pj = valid ? __expf(sc - mnew) : 0.f; const float corr = __expf(mrun - mnew);
            lrun = lrun * corr + wave_sum(pj); o0 *= corr; o1 *= corr; mrun = mnew;
            const int nk = (t - j0 + 1) < 64 ? (t - j0 + 1) : 64;
            for (int jj = 0; jj < nk; ++jj) { const float pb = __shfl(pj, jj); const unsigned vw = *(const unsigned*)(P + ((size_t)b * T + j0 + jj) * CD_LD + 3072 + hd * 128 + 2 * lane);
                o0 += pb * bflo(vw); o1 += pb * bfhi(vw); } }
        const float inv = 1.0f / lrun;
        *(unsigned*)(O + row * D + 1024 + hd * 128 + 2 * lane) = cvt_pk_bf16(o0 * inv, o1 * inv);
        asm volatile("s_waitcnt lgkmcnt(0)" ::: "memory");
    }
}
#if MK_RWKV_WP
#define RWKV_RA(b_, l_) ph_rwkv_wp<0>(b_, l_)
#define RWKV_RB(b_) ph_rwkv_wp_chain(b_)
#define RWKV_RC(b_, l_) ph_rwkv_wp<1>(b_, l_)
#else
#define RWKV_RA(b_, l_) ph_rwkv<0>(b_, l_)
#define RWKV_RB(b_) ph_rwkv_chain(b_)
#define RWKV_RC(b_, l_) ph_rwkv<1>(b_, l_)
#endif
enum { PH_PRO = 0, PH_INPROJ0, PH_MIXA0, PH_MIXA1, PH_MIXB0, PH_MIXC0, PH_OUTPROJ0, PH_ROUTE0, PH_SCAT0, PH_GU0, PH_DN0, PH_COMB0, PH_INPROJ1, PH_S5A, PH_FOX, PH_GLU, PH_OUTPROJ1, PH_ROUTE1, PH_SCAT1, PH_GU1, PH_DN1, PH_FINAL, NPH };

#if defined(MK_SELFCHK) || defined(MK_GSTRESS)
constexpr size_t WS_CKS = 128 * 1024, WS_BAD = 130 * 1024;
__device__ __forceinline__ void cks_range(const unsigned char* p, size_t nbytes, unsigned* dst) {
    const u32x4* q = (const u32x4*)p; const size_t n = nbytes / 16; unsigned s = 0u;
    for (size_t i = (size_t)blockIdx.x * 512 + MK_TID; i < n; i += (size_t)gridDim.x * 512) { const u32x4 v = q[i]; s += (v.x + 3u * v.y + 5u * v.z + 7u * v.w) * (unsigned)(2 * i + 1); }
#pragma unroll
    for (int o = 32; o > 0; o >>= 1) s += __shfl_xor(s, o);
    if ((MK_TID & 63) == 0) atomicAdd(dst, s);
}

constexpr size_t WS_TCKS = 132 * 1024;
__device__ __forceinline__ void cks_out_tiles(const Args& a, int slot) {
    unsigned* tc = (unsigned*)(a.ws + WS_TCKS) + slot * 1024;
    for (int t = blockIdx.x; t < 1024; t += gridDim.x) { const int pm = t >> 3, pn = t & 7; unsigned s = 0u;
        for (int i = MK_TID; i < 256 * 64; i += 512) { const int r = i >> 6, c4 = i & 63; const u32x4 v = *(const u32x4*)(a.out + (size_t)(pm * 256 + r) * D + pn * 256 + 4 * c4);
            s += (v.x + 3u * v.y + 5u * v.z + 7u * v.w) * (unsigned)(2 * i + 1); }
#pragma unroll
        for (int o = 32; o > 0; o >>= 1) s += __shfl_xor(s, o);
        if ((MK_TID & 63) == 0) atomicAdd(tc + t, s); }
}

constexpr size_t WS_UCKS = 192 * 1024;
__device__ __forceinline__ void cks_z_units(const Args& a, int slot) {
    unsigned* uc = (unsigned*)(a.ws + WS_UCKS) + slot * 8192;
#ifdef MK_S5_PROBE
    const bf16_t* Z = (const bf16_t*)(a.ws + WS_P + 360 * MiB);
#else
    const bf16_t* Z = (const bf16_t*)(a.ws + WS_H);
#endif
    const int lane = MK_TID & 63, gw = blockIdx.x * 8 + (MK_TID >> 6), NGW = gridDim.x * 8;
    for (int u = gw; u < 8192; u += NGW) { const int seg = u & 63, s2 = u >> 6, b2 = s2 >> 6, g = s2 & 63; unsigned sum = 0u;
        for (int i = 0; i < 32; ++i) { const int idx = i * 64 + lane, r = idx >> 3, d = idx & 7;
            const unsigned v = *(const unsigned*)(Z + ((size_t)b2 * T + seg * 256 + r) * 1024 + g * 16 + 2 * d); sum += v * (unsigned)(2 * idx + 1); }
#pragma unroll
        for (int o = 32; o > 0; o >>= 1) sum += __shfl_xor(sum, o);
        if (lane == 0) uc[u] = sum; }
}
__device__ __forceinline__ void ph_cks(const Args& a, int k, int slot) {
    unsigned* dst = (unsigned*)(a.ws + WS_CKS) + slot * 32 + k; unsigned char* ws = a.ws;
#define CR(lo_, hi_) cks_range(ws + (size_t)((lo_) * 1048576.0), (size_t)(((hi_) - (lo_)) * 1048576.0), dst)
#define COUT cks_range((const unsigned char*)a.out, (size_t)NTOK * D * 4, dst)
    switch (k) {
    case PH_PRO: CR(8, 14); CR(16, 400); break;
    case PH_INPROJ0: CR(528, 1008); break;
    case PH_MIXA0: CR(272, 336); CR(10, 10.5); CR(1008, 1136); CR(400, 528); break;
    case PH_MIXA1: CR(272, 400); break;
    case PH_MIXB0: CR(336, 368); CR(400, 528); break;
    case PH_MIXC0: CR(400, 528); break;
    case PH_OUTPROJ0: COUT; cks_out_tiles(a, slot); break;
    case PH_ROUTE0: case PH_ROUTE1: CR(272, 400); CR(2, 2.25); CR(3, 3.25); CR(1, 1.03125); CR(14, 14.125); break;
    case PH_SCAT0: case PH_SCAT1: CR(1.0625, 1.09375); break;
    case PH_COMB0: COUT; CR(272, 400); CR(5, 6); CR(80, 272); break;
    case PH_INPROJ1: CR(528, 784); break;
    case PH_S5A: CR(6, 7); CR(1008, 1012); CR(0.0625, 0.06256103515625); break;
    case PH_FOX: CR(400, 528); cks_range(ws + 272 * MiB, 64 * MiB, (unsigned*)(a.ws + WS_CKS) + slot * 32 + PH_DN0); break;
    case PH_GLU: CR(400, 528); break;
    case PH_OUTPROJ1: COUT; break;
    case PH_FINAL: COUT; break;
    default: break; }
#undef CR
#undef COUT
}
__device__ __forceinline__ void ph_poison(const Args& a) {
    const u32x4 pz = (u32x4){0xAAAAAAAAu, 0xAAAAAAAAu, 0xAAAAAAAAu, 0xAAAAAAAAu};
    { u32x4* q = (u32x4*)(a.ws + 1 * MiB); const size_t n = (WS_END - 1 * MiB) / 16; for (size_t i = (size_t)blockIdx.x * 512 + MK_TID; i < n; i += (size_t)gridDim.x * 512) q[i] = pz; }
    { u32x4* q = (u32x4*)a.out; const size_t n = (size_t)NTOK * D * 4 / 16; for (size_t i = (size_t)blockIdx.x * 512 + MK_TID; i < n; i += (size_t)gridDim.x * 512) q[i] = pz; }
    if (blockIdx.x == 0 && MK_TID < 256) ((unsigned*)(a.ws + 65536))[MK_TID] = 0u;
}
#endif
__device__ __forceinline__ Args load_args() {
    Args b{};
#if defined(__HIP_DEVICE_COMPILE__)
    typedef __attribute__((address_space(4))) const Args* KArgsPtr;
    unsigned long long v = (unsigned long long)__builtin_amdgcn_kernarg_segment_ptr(); asm volatile("" : "+s"(v)); const KArgsPtr k = (KArgsPtr)v;
#pragma unroll
    for (int i = 0; i < 39; ++i) b.in[i] = k->in[i];
    b.out = k->out; b.ws = k->ws; b.ph_lo = k->ph_lo; b.ph_hi = k->ph_hi;
#endif
    return b;
}
#define PHB const Args b = load_args(); unsigned char* const ws = b.ws; (void)ws;
#ifndef MK_ONE_LAUNCH
#define MK_ONE_LAUNCH 0
#endif
#ifndef MK_DUP
#define MK_DUP -1
#endif
__device__ __forceinline__ int probe_reps(bool dup) { int r = 1; if (dup) { r = 2; asm volatile("" : "+s"(r)); } return r; }
template <int ONLY> __global__ void __launch_bounds__(512, 2) fwd(Args a) {
    extern __shared__ __attribute__((aligned(16))) unsigned char lds_raw[];
    MK_LAS unsigned char* lds = (MK_LAS unsigned char*)lds_raw;
    if (MK_TID < 16) ((MK_LAS unsigned*)(lds + LDS_MISC))[MK_TID] = 0u;
    __syncthreads();
    const int lo = a.ph_lo, hi = a.ph_hi & 255;
    XcdBarrier bar; bar.bar = (unsigned*)(a.ws + WS_CTL); bar.x = 0; bar.st = nullptr;
#ifdef MK_GSTRESS
    const int pass_ = a.ph_hi >> 8;
    bar = xcd_barrier_post((unsigned*)(a.ws + WS_CTL), (volatile LAS unsigned*)(lds + LDS_MISC));
#else
    if (hi - lo > 1) bar = xcd_barrier_post((unsigned*)(a.ws + WS_CTL), (volatile LAS unsigned*)(lds + LDS_MISC));
#endif
#define IN(k) ((ONLY < 0 || (k) == ONLY) && lo <= (k) && (k) < hi)
#define REPS(k) ((MK_DUP == (k)) ? 2 : 1)
#ifdef MK_SELFCHK
#define SEAM(k) do { if (IN(k) && IN((k) + 1)) { xcd_barrier(bar); { PHB ph_cks(b, (k), slot_); } xcd_barrier(bar); if ((k) == PH_FOX) { { PHB cks_z_units(b, slot_); } xcd_barrier(bar); } } } while (0)
#else
#define SEAM(k) do { if (IN(k) && IN((k) + 1)) xcd_barrier(bar); } while (0)
#endif
#define H ((bf16_t*)(ws + WS_H))
#define O ((bf16_t*)(ws + WS_O))
#define P ((bf16_t*)(ws + WS_P))
#define HID ((bf16_t*)(ws + WS_HID))
    const int G = (int)gridDim.x, c = (int)blockIdx.x;
#ifdef MK_SELFCHK
    const int pass_ = a.ph_hi >> 8, slot_ = pass_ ? 1 : 0;
#endif

    if (IN(PH_PRO)) for (int rep_ = 0; rep_ < REPS(PH_PRO); ++rep_) { PHB ph_prologue(b, lds); rwkv_convert_small(b); s5_param_prep(b); router_weight_prep(b); } SEAM(PH_PRO);
    if (IN(PH_INPROJ0)) for (int rep_ = 0; rep_ < REPS(PH_INPROJ0); ++rep_) { PHB pg8::Gemm g{H, (const bf16_t*)(ws + WS_ABIN), NTOK, AB_LD, D}; pg8::StaticOrder S; S.init(NTOK, AB_LD, G, c); pg8::EpiStoreBf16 E{P, AB_LD, 0x7fffffff};
        pg8::gemm_phase<pg8::EpiStoreBf16, pg8::StaticOrder, true, true>(lds, g, S, E); } SEAM(PH_INPROJ0);
#ifdef MK_GSTRESS
    if (hi == 2) { const int slot_ = pass_ ? 1 : 0;
        xcd_barrier(bar); { PHB cks_range(b.ws + WS_P, 480 * MiB, (unsigned*)(b.ws + WS_CKS) + slot_ * 32 + 0); }
        xcd_barrier(bar); { PHB cks_range(b.ws + WS_P, 480 * MiB, (unsigned*)(b.ws + WS_CKS) + slot_ * 32 + 1); }
        xcd_barrier(bar);
        if (blockIdx.x == 0 && MK_TID == 0) { PHB unsigned* ck = (unsigned*)(b.ws + WS_CKS); unsigned* bad = (unsigned*)(b.ws + WS_BAD);
            const unsigned r0 = __hip_atomic_load(ck + 0, __ATOMIC_RELAXED, __HIP_MEMORY_SCOPE_AGENT), a0 = __hip_atomic_load(ck + slot_ * 32 + 0, __ATOMIC_RELAXED, __HIP_MEMORY_SCOPE_AGENT), a1 = __hip_atomic_load(ck + slot_ * 32 + 1, __ATOMIC_RELAXED, __HIP_MEMORY_SCOPE_AGENT);
            unsigned code = 0u; if (a0 != a1) code = 2u; else if (a0 != r0) code = 1u;
            if (code != 0u && __hip_atomic_load(bad, __ATOMIC_RELAXED, __HIP_MEMORY_SCOPE_AGENT) == 0u) __hip_atomic_store(bad, code, __ATOMIC_RELAXED, __HIP_MEMORY_SCOPE_AGENT);
            if (slot_) { __hip_atomic_store(ck + 32, 0u, __ATOMIC_RELAXED, __HIP_MEMORY_SCOPE_AGENT); __hip_atomic_store(ck + 33, 0u, __ATOMIC_RELAXED, __HIP_MEMORY_SCOPE_AGENT); } } }
#endif
    if (IN(PH_MIXA0)) for (int rep_ = 0; rep_ < REPS(PH_MIXA0); ++rep_) { PHB ph_hgrn2<0>(b, lds); ph_rwkv_pre<0>(b, lds); } SEAM(PH_MIXA0);
    if (IN(PH_MIXA1)) for (int rep_ = 0; rep_ < REPS(PH_MIXA1); ++rep_) { PHB RWKV_RA(b, lds); if (rep_ == 0) ph_hgrn2_chain(b, 0); } SEAM(PH_MIXA1);
    if (IN(PH_MIXB0)) for (int rep_ = 0; rep_ < REPS(PH_MIXB0); ++rep_) { PHB if (rep_ == 0 && blockIdx.x < 16) RWKV_RB(b); ph_hgrn2<1>(b, lds, 16); } SEAM(PH_MIXB0);
    if (IN(PH_MIXC0)) for (int rep_ = 0; rep_ < REPS(PH_MIXC0); ++rep_) { PHB RWKV_RC(b, lds); } SEAM(PH_MIXC0);
    if (IN(PH_OUTPROJ0)) for (int rep_ = 0; rep_ < REPS(PH_OUTPROJ0); ++rep_) { PHB pg8::Gemm g{O, (const bf16_t*)(ws + WS_ABOUT), NTOK, D, D}; pg8::StaticOrder S; S.init(NTOK, D, G, c); pg8::EpiResF32 E{b.in[I_X], b.out, D};
        pg8::gemm_phase<pg8::EpiResF32, pg8::StaticOrder, true, true>(lds, g, S, E); } SEAM(PH_OUTPROJ0);
    if (IN(PH_ROUTE0)) for (int rep_ = 0; rep_ < REPS(PH_ROUTE0); ++rep_) { PHB ph_router<0>(b, 0, lds); } SEAM(PH_ROUTE0);
    if (IN(PH_SCAT0)) for (int rep_ = 0; rep_ < REPS(PH_SCAT0); ++rep_) { PHB ph_scatter(b, lds); } SEAM(PH_SCAT0);
    if (IN(PH_GU0)) for (int rep_ = 0; rep_ < REPS(PH_GU0); ++rep_) { PHB const int nt = *(const int*)(ws + WS_NT); pg8::Gemm g{P, (const bf16_t*)(ws + WS_GU), ROWS_MAX, NEXP * 1024, D}; pg8::MoeOrder S{(const int*)(ws + WS_TILEE), nt * 4, 4, G, c}; pg8::EpiSwiGlu E{HID, (const float*)(ws + WS_RSP)};
        pg8::gemm_phase<pg8::EpiSwiGlu, pg8::MoeOrder, true, true>(lds, g, S, E); } SEAM(PH_GU0);
    if (IN(PH_DN0)) for (int rep_ = 0; rep_ < REPS(PH_DN0); ++rep_) { PHB const int nt = *(const int*)(ws + WS_NT); pg8::Gemm g{HID, (const bf16_t*)(ws + WS_DN), ROWS_MAX, NEXP * D, FF}; pg8::MoeOrder S{(const int*)(ws + WS_TILEE), nt * 8, 8, G, c}; pg8::EpiStoreBf16 E{P, D, 7};
        pg8::gemm_phase<pg8::EpiStoreBf16, pg8::MoeOrder, true, true>(lds, g, S, E); } SEAM(PH_DN0);
    if (IN(PH_COMB0)) for (int rep_ = 0; rep_ < REPS(PH_COMB0); ++rep_) { PHB ph_combine(b, 0, lds); convert_items<2>(b, (MK_LAS float*)lds); } SEAM(PH_COMB0);
    if (IN(PH_INPROJ1)) for (int rep_ = 0; rep_ < REPS(PH_INPROJ1); ++rep_) { PHB pg8::Gemm g{H, (const bf16_t*)(ws + WS_CDIN), NTOK, CD_LD, D}; pg8::StaticOrder S; S.init(NTOK, CD_LD, G, c); pg8::EpiStoreBf16 E{P, CD_LD, 0x7fffffff};
        pg8::gemm_phase<pg8::EpiStoreBf16, pg8::StaticOrder, true, true>(lds, g, S, E); } SEAM(PH_INPROJ1);
    if (IN(PH_S5A)) for (int rep_ = 0; rep_ < REPS(PH_S5A); ++rep_) { PHB if (blockIdx.x < 16) ph_fox_cumsum(b, lds); ph_fox_kmax(b); ph_s5<0>(b, lds); } SEAM(PH_S5A);
    if (IN(PH_FOX)) for (int rep_ = 0; rep_ < REPS(PH_FOX); ++rep_) { PHB ph_fox(b, lds); if (MK_S5_SEP) xcd_barrier(bar); ph_s5<1>(b, lds);
#ifdef MK_S5_PROBE
        ph_s5<MK_S5_PROBE>(b, lds);
#endif
 } SEAM(PH_FOX);
    if (IN(PH_GLU)) for (int rep_ = 0; rep_ < REPS(PH_GLU); ++rep_) { PHB pg8::Gemm g{H, (const bf16_t*)(ws + WS_GLU), NTOK, 1024, 1024}; pg8::StaticOrder S; S.init(NTOK, 1024, G, c); pg8::EpiGlu E{H, 1024, b.in[I_S5BG], O, D};
        pg8::gemm_phase<pg8::EpiGlu, pg8::StaticOrder, true, true>(lds, g, S, E); } SEAM(PH_GLU);
    if (IN(PH_OUTPROJ1)) for (int rep_ = 0; rep_ < REPS(PH_OUTPROJ1); ++rep_) { PHB pg8::Gemm g{O, (const bf16_t*)(ws + WS_CDOUT), NTOK, D, D}; pg8::StaticOrder S; S.init(NTOK, D, G, c); pg8::EpiResF32 E{b.out, b.out, D};
        pg8::gemm_phase<pg8::EpiResF32, pg8::StaticOrder, true, true>(lds, g, S, E); } SEAM(PH_OUTPROJ1);
    if (IN(PH_ROUTE1)) for (int rep_ = 0; rep_ < REPS(PH_ROUTE1); ++rep_) { PHB ph_router<0>(b, 1, lds); } SEAM(PH_ROUTE1);
    if (IN(PH_SCAT1)) for (int rep_ = 0; rep_ < REPS(PH_SCAT1); ++rep_) { PHB ph_scatter(b, lds); } SEAM(PH_SCAT1);
    if (IN(PH_GU1)) for (int rep_ = 0; rep_ < REPS(PH_GU1); ++rep_) { PHB const int nt = *(const int*)(ws + WS_NT); pg8::Gemm g{P, (const bf16_t*)(ws + WS_GU), ROWS_MAX, NEXP * 1024, D}; pg8::MoeOrder S{(const int*)(ws + WS_TILEE), nt * 4, 4, G, c}; pg8::EpiSwiGlu E{HID, (const float*)(ws + WS_RSP)};
        pg8::gemm_phase<pg8::EpiSwiGlu, pg8::MoeOrder, true, true>(lds, g, S, E); } SEAM(PH_GU1);
    if (IN(PH_DN1)) for (int rep_ = 0; rep_ < REPS(PH_DN1); ++rep_) { PHB const int nt = *(const int*)(ws + WS_NT); pg8::Gemm g{HID, (const bf16_t*)(ws + WS_DN), ROWS_MAX, NEXP * D, FF}; pg8::MoeOrder S{(const int*)(ws + WS_TILEE), nt * 8, 8, G, c}; pg8::EpiStoreBf16 E{P, D, 7};
        pg8::gemm_phase<pg8::EpiStoreBf16, pg8::MoeOrder, true, true>(lds, g, S, E); } SEAM(PH_DN1);
    if (IN(PH_FINAL)) for (int rep_ = 0; rep_ < REPS(PH_FINAL); ++rep_) { PHB ph_combine(b, 1, lds); }
#ifdef MK_SELFCHK
    xcd_barrier(bar); { PHB ph_cks(b, PH_FINAL, slot_); } xcd_barrier(bar);
    if (pass_ > 0 && blockIdx.x == 0 && MK_TID == 0) { PHB unsigned* ck = (unsigned*)(b.ws + WS_CKS); unsigned* bad = (unsigned*)(b.ws + WS_BAD);
        { const unsigned* uc = (const unsigned*)(b.ws + WS_UCKS); unsigned cnt = 0u, firstu = 0u, nstr = 0u, lasts = 0xffffffffu;
          for (int u = 0; u < 8192; ++u) { const unsigned r0 = __hip_atomic_load(uc + u, __ATOMIC_RELAXED, __HIP_MEMORY_SCOPE_AGENT), r1 = __hip_atomic_load(uc + 8192 + u, __ATOMIC_RELAXED, __HIP_MEMORY_SCOPE_AGENT);
              if (r0 != r1) { if (cnt == 0u) firstu = (unsigned)u; ++cnt; if ((unsigned)(u >> 6) != lasts) { lasts = (unsigned)(u >> 6); ++nstr; } } }
          if (cnt != 0u) { __hip_atomic_store(bad, 0u, __ATOMIC_RELAXED, __HIP_MEMORY_SCOPE_AGENT); __hip_atomic_store(bad + 1, 1000u + firstu, __ATOMIC_RELAXED, __HIP_MEMORY_SCOPE_AGENT); __hip_atomic_store(bad + 2, 1u, __ATOMIC_RELAXED, __HIP_MEMORY_SCOPE_AGENT); } }
        for (int k = 23; k >= 0; --k) { const unsigned r0 = __hip_atomic_load(ck + k, __ATOMIC_RELAXED, __HIP_MEMORY_SCOPE_AGENT), r1 = __hip_atomic_load(ck + 32 + k, __ATOMIC_RELAXED, __HIP_MEMORY_SCOPE_AGENT);
            if (r0 != r1 && __hip_atomic_load(bad + 2, __ATOMIC_RELAXED, __HIP_MEMORY_SCOPE_AGENT) == 0u) { const unsigned cur = __hip_atomic_load(bad, __ATOMIC_RELAXED, __HIP_MEMORY_SCOPE_AGENT); if (cur == 0u || (unsigned)(k + 1) < cur) __hip_atomic_store(bad, (unsigned)(k + 1), __ATOMIC_RELAXED, __HIP_MEMORY_SCOPE_AGENT); }
            __hip_atomic_store(ck + 32 + k, 0u, __ATOMIC_RELAXED, __HIP_MEMORY_SCOPE_AGENT); }
        { unsigned* tc = (unsigned*)(b.ws + WS_TCKS); unsigned rowm[4] = {0u, 0u, 0u, 0u}, colm = 0u;
          for (int t = 0; t < 1024; ++t) { const unsigned r0 = __hip_atomic_load(tc + t, __ATOMIC_RELAXED, __HIP_MEMORY_SCOPE_AGENT), r1 = __hip_atomic_load(tc + 1024 + t, __ATOMIC_RELAXED, __HIP_MEMORY_SCOPE_AGENT);
              if (r0 != r1) { rowm[(t >> 3) >> 5] |= 1u << ((t >> 3) & 31); colm |= 1u << (t & 7); }
              __hip_atomic_store(tc + 1024 + t, 0u, __ATOMIC_RELAXED, __HIP_MEMORY_SCOPE_AGENT); }
          const int nrow = __popc(rowm[0]) + __popc(rowm[1]) + __popc(rowm[2]) + __popc(rowm[3]), ncol = __popc(colm);
          if (nrow > 0 && __hip_atomic_load(bad + 2, __ATOMIC_RELAXED, __HIP_MEMORY_SCOPE_AGENT) == 0u && __hip_atomic_load(bad + 1, __ATOMIC_RELAXED, __HIP_MEMORY_SCOPE_AGENT) == 0u) __hip_atomic_store(bad + 1, (unsigned)(10 * (nrow < 9 ? nrow : 9) + (ncol < 8 ? ncol : 8)), __ATOMIC_RELAXED, __HIP_MEMORY_SCOPE_AGENT); } }
    xcd_barrier(bar);
    if (pass_ == MK_SELFCHK - 1) { PHB const unsigned bad = __hip_atomic_load((unsigned*)(b.ws + WS_BAD), __ATOMIC_RELAXED, __HIP_MEMORY_SCOPE_AGENT);
      const unsigned tcode = __hip_atomic_load((unsigned*)(b.ws + WS_BAD) + 1, __ATOMIC_RELAXED, __HIP_MEMORY_SCOPE_AGENT);
      const unsigned long long ticks = (unsigned long long)bad * 500000ull + (unsigned long long)tcode * 2000ull; const unsigned long long t0 = wall_clock64();
      while (wall_clock64() - t0 < ticks) __builtin_amdgcn_s_sleep(8); }
#endif
#ifdef MK_GSTRESS
    if (hi == NPH) { xcd_barrier(bar); { PHB const unsigned bad = __hip_atomic_load((unsigned*)(b.ws + WS_BAD), __ATOMIC_RELAXED, __HIP_MEMORY_SCOPE_AGENT);
      if (bad != 0u) { const float sc = 1.0f + (float)bad; f32x4* q = (f32x4*)b.out; const size_t n = (size_t)NTOK * D / 4;
          for (size_t i = (size_t)blockIdx.x * 512 + MK_TID; i < n; i += (size_t)gridDim.x * 512) q[i] = q[i] * sc; } } }
#endif
#ifdef MK_TAIL
    if (hi == NPH) { xcd_barrier(bar); { PHB
        if (MK_TAIL == PH_MIXA1) RWKV_RA(b, lds);
        if (MK_TAIL == PH_ROUTE0) ph_router<0>(b, 0, lds);
        if (MK_TAIL == PH_MIXA0) ph_hgrn2<0>(b, lds);
        if (MK_TAIL == PH_MIXB0) ph_hgrn2<1>(b, lds);
        if (MK_TAIL >= 400 && MK_TAIL < 408) ph_rwkv_pre<(MK_TAIL >= 400 && MK_TAIL < 408) ? MK_TAIL - 400 : 0>(b, lds);
        if (MK_TAIL >= 300 && MK_TAIL < 316) ph_router<(MK_TAIL >= 300 && MK_TAIL < 316) ? MK_TAIL - 300 : 0>(b, 0, lds);
        if (MK_TAIL >= 200 && MK_TAIL < 264) ph_rwkv<1, (MK_TAIL >= 200 && MK_TAIL < 264) ? MK_TAIL - 200 : 0>(b, lds);
        if (MK_TAIL == 101) { if (blockIdx.x < 16) RWKV_RB(b); }
        if (MK_TAIL == 102) ph_hgrn2_chain(b, 0);
        if (MK_TAIL == 103) { convert_items<2>(b, (MK_LAS float*)lds); }
        if (MK_TAIL == 104) ph_scatter(b, lds);
        if (MK_TAIL == 105) { ph_fox_kmax(b); }
        if (MK_TAIL == 106) { xcd_barrier(bar); xcd_barrier(bar); xcd_barrier(bar); xcd_barrier(bar); xcd_barrier(bar); xcd_barrier(bar); xcd_barrier(bar); xcd_barrier(bar); xcd_barrier(bar); xcd_barrier(bar); }
    } }
#endif
#undef IN
#undef SEAM
#undef H
#undef O
#undef P
#undef HID
}

#ifdef MK_HB
template <int MIT> __global__ void __launch_bounds__(512, 2) hb_kernel(Args a) {
    extern __shared__ __attribute__((aligned(16))) unsigned char lds_raw[];
    MK_LAS unsigned char* lds = (MK_LAS unsigned char*)lds_raw;
    if (MK_TID < 16) ((MK_LAS unsigned*)(lds + LDS_MISC))[MK_TID] = 0u;
    __syncthreads();
    unsigned* ctl = (unsigned*)(a.ws + 256 * 1024);
    XcdBarrier bar = xcd_barrier_post(ctl, (volatile LAS unsigned*)(lds + LDS_MISC));
    const int c = (int)blockIdx.x, G = (int)gridDim.x, r = (c * 37 + 11) % G;
    unsigned nb = 0u, nb2 = 0u, first = 0xffffffffu;
    for (int it = 0; it < MK_HB; ++it) {
        u32x4* dst = (u32x4*)(a.ws + WS_P + (size_t)c * 262144);
#pragma unroll 8
        for (int i = 0; i < 32; ++i) { const unsigned idx = (unsigned)(MK_TID + 512 * i); const unsigned h = (unsigned)it * 0x9E3779B1u + (unsigned)c * 0x85EBCA77u + idx * 0xC2B2AE3Du;
            u32x4 v; v.x = h; v.y = h ^ 0x5555u; v.z = h + 77u; v.w = ~h;
#if MK_HB_SC1
            __builtin_nontemporal_store(v, dst + idx);
#else
            dst[idx] = v;
#endif
        }
#if MK_HB_FENCE
        asm volatile("s_waitcnt vmcnt(0)" ::: "memory"); __syncthreads();
        if (MK_TID == 0) { __builtin_amdgcn_fence(__ATOMIC_RELEASE, "agent"); asm volatile("s_waitcnt vmcnt(0)" ::: "memory"); }
#endif
        xcd_barrier(bar);
        const u32x4* src = (const u32x4*)(a.ws + WS_P + (size_t)r * 262144);
#pragma unroll 8
        for (int i = 0; i < 32; ++i) { const unsigned idx = (unsigned)(MK_TID + 512 * i); const unsigned h = (unsigned)it * 0x9E3779B1u + (unsigned)r * 0x85EBCA77u + idx * 0xC2B2AE3Du;
            const u32x4 v = src[idx]; if (v.x != h || v.y != (h ^ 0x5555u) || v.z != h + 77u || v.w != ~h) { ++nb; if (first == 0xffffffffu) first = (unsigned)it; } }
        xcd_barrier(bar);
        { unsigned* sc = (unsigned*)(a.ws + WS_P + 64 * MiB);
#pragma unroll
          for (int j = 0; j < 8; ++j) { const unsigned e = (((unsigned)(c * 4096 + MK_TID * 8 + j)) * 2654435761u + (unsigned)it * 40503u) & 0xFFFFFu; sc[e] = (unsigned)it * 0x9E3779B1u + e; }
          xcd_barrier(bar);
          const u32x4 v0 = *(const u32x4*)(sc + c * 4096 + MK_TID * 8), v1 = *(const u32x4*)(sc + c * 4096 + MK_TID * 8 + 4); const unsigned e0 = (unsigned)(c * 4096 + MK_TID * 8), kk = (unsigned)it * 0x9E3779B1u;
          if (v0.x != kk + e0 || v0.y != kk + e0 + 1 || v0.z != kk + e0 + 2 || v0.w != kk + e0 + 3 || v1.x != kk + e0 + 4 || v1.y != kk + e0 + 5 || v1.z != kk + e0 + 6 || v1.w != kk + e0 + 7) ++nb2;
          xcd_barrier(bar); }
    }
    if (nb2) atomicAdd(ctl + 8195, nb2);
    if (nb) { atomicAdd(ctl + 8192, nb); atomicAdd(ctl + 8193, 1u); atomicMin(ctl + 8194, first); }
    xcd_barrier(bar);
    { const unsigned tot = __hip_atomic_load(ctl + 8192, __ATOMIC_RELAXED, __HIP_MEMORY_SCOPE_AGENT);
      const unsigned tot2 = __hip_atomic_load(ctl + 8195, __ATOMIC_RELAXED, __HIP_MEMORY_SCOPE_AGENT);
      if (tot != 0u || tot2 != 0u) { unsigned code = (tot != 0u) ? 1u : 41u, t = (tot != 0u) ? tot : tot2; while (t > 1u) { t >>= 1; ++code; }
          const float sc = 1.0f + (float)code; f32x4* q = (f32x4*)a.out; const size_t n = (size_t)NTOK * D / 4;
          for (size_t i = (size_t)blockIdx.x * 512 + MK_TID; i < n; i += (size_t)gridDim.x * 512) q[i] = q[i] * sc; } }
}
#endif
}

#ifdef MK_PROBE_ONLY
static const void* const fn_table[1] = {(const void*)mk::fwd<MK_PROBE_ONLY>};
constexpr int N_FN = 1;
#elif MK_ONE_LAUNCH
static const void* const fn_table[1] = {(const void*)mk::fwd<-1>};
constexpr int N_FN = 1;
#else
#define FN(k) (const void*)mk::fwd<k>
static const void* const fn_table[mk::NPH] = {FN(0), FN(1), FN(2), FN(3), FN(4), FN(5), FN(6), FN(7), FN(8), FN(9), FN(10), FN(11), FN(12), FN(13), FN(14), FN(15), FN(16), FN(17), FN(18), FN(19), FN(20), FN(21)};
constexpr int N_FN = mk::NPH;
#endif
extern "C" void kernel_launch(void* const* d_in, const int* in_sizes, int n_in, void* d_out, int out_size, void* d_ws, size_t ws_size, hipStream_t stream) {
    static int grid = 0;
    if (grid == 0) {
        if (n_in != 39 || ws_size < mk::WS_END) { fprintf(stderr, "kernel_launch: built for 39 inputs and >= %zu bytes of workspace; got n_in %d, ws %zu; nothing launched\n", (size_t)mk::WS_END, n_in, ws_size); grid = -1; return; }
        int dev = 0, cus = 0, per_cu = 0;
        if (hipGetDevice(&dev) != hipSuccess || hipDeviceGetAttribute(&cus, hipDeviceAttributeMultiprocessorCount, dev) != hipSuccess) { grid = -1; return; }
        for (int ph = 0; ph < N_FN; ++ph) if (hipFuncSetAttribute(fn_table[ph], hipFuncAttributeMaxDynamicSharedMemorySize, mk::LDS_BYTES) != hipSuccess) { fprintf(stderr, "kernel_launch: hipFuncSetAttribute failed\n"); grid = -1; return; }
        if (hipOccupancyMaxActiveBlocksPerMultiprocessor(&per_cu, fn_table[0], 512, mk::LDS_BYTES) != hipSuccess || per_cu < 1) fprintf(stderr, "kernel_launch: note: occupancy query reports %d workgroups per CU\n", per_cu);
        (void)hipGetLastError();
        grid = cus > 0 ? cus : 256;
    }
    if (grid < 0) return;
    (void)in_sizes; (void)out_size;
    if (hipMemsetAsync((char*)d_ws + mk::WS_CTL, 0, mk::CTL_ZERO, stream) != hipSuccess) return;
    mk::Args a{};
    for (int i = 0; i < 39; ++i) a.in[i] = (const float*)d_in[i];
    a.out = (float*)d_out; a.ws = (unsigned char*)d_ws;
    void* kargs[] = {&a};
#if defined(MK_HB)
    a.ph_lo = 0; a.ph_hi = mk::NPH;
    (void)hipLaunchKernel(fn_table[0], dim3(grid), dim3(512), kargs, mk::LDS_BYTES, stream);
    { static bool attr = false; if (!attr) { (void)hipFuncSetAttribute((const void*)mk::hb_kernel<0>, hipFuncAttributeMaxDynamicSharedMemorySize, mk::LDS_BYTES); attr = true; }
      (void)hipLaunchKernel((const void*)mk::hb_kernel<0>, dim3(grid), dim3(512), kargs, mk::LDS_BYTES, stream); }
#elif defined(MK_GSTRESS)
    for (int pass = 0; pass < MK_GSTRESS; ++pass) {
        if (pass > 0) { if (hipMemsetAsync((char*)d_ws, 0, 128 * 1024, stream) != hipSuccess) return; }
        if (pass > 0 && pass < MK_GSTRESS - 1) { if (hipMemsetAsync((char*)d_ws + mk::WS_P, 0xAA, 480 * mk::MiB, stream) != hipSuccess) return; }
        a.ph_lo = (pass == 0) ? 0 : ((pass == MK_GSTRESS - 1) ? 2 : 1); a.ph_hi = ((pass == MK_GSTRESS - 1) ? mk::NPH : 2) | (pass << 8);
        (void)hipLaunchKernel(fn_table[0], dim3(grid), dim3(512), kargs, mk::LDS_BYTES, stream); }
#elif defined(MK_SELFCHK)
    for (int pass = 0; pass < MK_SELFCHK; ++pass) {
        { if (pass > 0 && hipMemsetAsync((char*)d_ws, 0, 128 * 1024, stream) != hipSuccess) return;
            if (hipMemsetAsync((char*)d_ws + mk::MiB, 0xAA, mk::WS_END - mk::MiB, stream) != hipSuccess) return; if (hipMemsetAsync(d_out, 0xAA, (size_t)mk::NTOK * mk::D * 4, stream) != hipSuccess) return; }
        a.ph_lo = 0; a.ph_hi = mk::NPH | (pass << 8);
        (void)hipLaunchKernel(fn_table[0], dim3(grid), dim3(512), kargs, mk::LDS_BYTES, stream); }
#elif MK_ONE_LAUNCH
    a.ph_lo = 0; a.ph_hi = mk::NPH;
    (void)hipLaunchKernel(fn_table[0], dim3(grid), dim3(512), kargs, mk::LDS_BYTES, stream);
#else
    for (int ph = 0; ph < mk::NPH; ++ph) { a.ph_lo = ph; a.ph_hi = ph + 1; (void)hipLaunchKernel(fn_table[ph], dim3(grid), dim3(512), kargs, mk::LDS_BYTES, stream); }
#endif
}
```

```cpp
#include <hip/hip_runtime.h>
#include <cstdio>
#include <cstdint>
#define MK_ONE_LAUNCH 1
#define MK_DUP -1
#define MK_RWKV_WP 0
#define MK_S5_DYN 1
#define MK_S5_SEP 0
#define MK_S5_SC1 1
#define MK_S5_NT 0
#define MK_S5_ACQ 0
#define MK_S5_FIRST 0
#define MK_INPROJ_ALIGN true
#define MK_MOE_BAR 0
#define MK_S5_NTP 0
#define MK_S5_REL 0
#define MK_S5_SC1ST 0
#define MK_UNITCMP 1
#define MK_S5_SCOPE __HIP_MEMORY_SCOPE_AGENT
namespace pg8 {
#define PG8_LAS __attribute__((address_space(3)))
typedef unsigned short bf16_t;
typedef short bf16x8 __attribute__((ext_vector_type(8)));
typedef float f32x4 __attribute__((ext_vector_type(4)));
typedef unsigned u32x4 __attribute__((ext_vector_type(4)));
constexpr int BM = 256, BK = 64, HALF = 128, HTB = HALF * BK * 2  , STAGE_BYTES = 8 * HTB, NXCD = 8, WGM = 4;

__host__ __device__ __forceinline__ int lds_byte(int r, int c) { const int st = (r >> 4) * 2 + (c >> 5), rr = r & 15, cc = c & 31, ob = rr * 64 + cc * 2; return st * 1024 + (ob ^ (((ob >> 9) & 1) << 5)); }
__host__ __device__ __forceinline__ void stage_rc(int b, int& R, int& C) { const int st = b / 1024, sb = b % 1024, swz = sb ^ (((sb >> 9) & 1) << 5); R = (st >> 1) * 16 + swz / 64; C = (st & 1) * 32 + (swz % 64) / 2; }
__host__ __device__ __forceinline__ int perm32(int rho) { const int n = rho >> 4, i = rho & 15; return 8 * (i >> 2) + 4 * n + (i & 3); }

struct Unit { int pm, pn; };
struct Gemm { const bf16_t* A; const bf16_t* Bt; int M, N, K; };

struct StaticOrder {
    int nM, nN, nwg, G, c;
    __host__ __device__ void init(int M, int N, int G_, int c_) { nM = M / BM; nN = N / BM; nwg = nM * nN; G = G_; c = c_; }
    __host__ __device__ bool next(int i, Unit& u) const {
        const long L = (long)i * G + c; if (L >= nwg) return false;
        int wgid = (int)L; { const int q = nwg / NXCD, r = nwg % NXCD, xcd = wgid % NXCD, off = wgid / NXCD; wgid = (xcd < r ? xcd * (q + 1) : r * (q + 1) + (xcd - r) * q) + off; }
        const int nig = WGM * nN, gid = wgid / nig, fm = gid * WGM, gsz = (nM - fm) < WGM ? (nM - fm) : WGM;
        u.pm = fm + ((wgid % nig) % gsz); u.pn = (wgid % nig) / gsz; return true;
    }
    __device__ __forceinline__ void a_ready(const Unit&) const {}
    __device__ __forceinline__ void done(const Unit&) const {}
};

__device__ __forceinline__ unsigned cvt_pk_bf16(float lo, float hi) { unsigned r; asm volatile("v_cvt_pk_bf16_f32 %0, %1, %2" : "=v"(r) : "v"(lo), "v"(hi)); return r; }
typedef float f32x2 __attribute__((ext_vector_type(2)));
typedef unsigned u32x2 __attribute__((ext_vector_type(2)));
__device__ __forceinline__ float fsigmoid(float x) { return 1.0f / (1.0f + __expf(-x)); }
__device__ __forceinline__ float bflo(unsigned w) { return __uint_as_float(w << 16); }
__device__ __forceinline__ float bfhi(unsigned w) { return __uint_as_float(w & 0xffff0000u); }

struct EpiStoreBf16 {
    static constexpr bool PERM = true, AFTER_DRAIN = false;
    bf16_t* O; int ldc; int colmask;
    __device__ __forceinline__ void operator()(const f32x4 (&acc)[2][2][4][2], const Unit& u, int wr, int wc, int fr, int fq) const {
        const int row0 = u.pm * BM + wr * 64 + fr, col0 = (u.pn & colmask) * BM + wc * 32 + 8 * fq;
#pragma unroll
        for (int ai = 0; ai < 2; ++ai)
#pragma unroll
            for (int m = 0; m < 4; ++m) { bf16_t* rowp = O + (size_t)(row0 + ai * HALF + m * 16) * ldc + col0;
#pragma unroll
                for (int bj = 0; bj < 2; ++bj) { const f32x4 v0 = acc[ai][bj][m][0], v1 = acc[ai][bj][m][1];
                    u32x4 w; w.x = cvt_pk_bf16(v0[0], v0[1]); w.y = cvt_pk_bf16(v0[2], v0[3]); w.z = cvt_pk_bf16(v1[0], v1[1]); w.w = cvt_pk_bf16(v1[2], v1[3]);
                    *(u32x4*)(rowp + bj * HALF) = w; } }
    }
};
struct EpiResF32 {
    static constexpr bool PERM = false, AFTER_DRAIN = false;
    const float* base; float* out; int ldc;
    __device__ __forceinline__ void operator()(const f32x4 (&acc)[2][2][4][2], const Unit& u, int wr, int wc, int fr, int fq) const {
        const int row0 = u.pm * BM + wr * 64 + fr, col0 = u.pn * BM + wc * 32 + 4 * fq;
#pragma unroll
        for (int ai = 0; ai < 2; ++ai)
#pragma unroll
            for (int m = 0; m < 4; ++m) { const size_t off = (size_t)(row0 + ai * HALF + m * 16) * ldc + col0;
#pragma unroll
                for (int bj = 0; bj < 2; ++bj)
#pragma unroll
                    for (int n = 0; n < 2; ++n) { const f32x4 b = *(const f32x4*)(base + off + bj * HALF + n * 16); *(f32x4*)(out + off + bj * HALF + n * 16) = b + acc[ai][bj][m][n]; } }
    }
};
struct EpiGlu {
    static constexpr bool PERM = true, AFTER_DRAIN = false;
    const bf16_t* Z; int ldz; const float* bias; bf16_t* O; int ldo;
    __device__ __forceinline__ void operator()(const f32x4 (&acc)[2][2][4][2], const Unit& u, int wr, int wc, int fr, int fq) const {
        const int row0 = u.pm * BM + wr * 64 + fr, col0 = u.pn * BM + wc * 32 + 8 * fq;
#pragma unroll
        for (int ai = 0; ai < 2; ++ai)
#pragma unroll
            for (int m = 0; m < 4; ++m) { const int row = row0 + ai * HALF + m * 16;
#pragma unroll
                for (int bj = 0; bj < 2; ++bj) { const int col = col0 + bj * HALF;
                    const u32x4 z = *(const u32x4*)(Z + (size_t)row * ldz + col); const f32x4 b0 = *(const f32x4*)(bias + col), b1 = *(const f32x4*)(bias + col + 4);
                    const f32x4 v0 = acc[ai][bj][m][0] + b0, v1 = acc[ai][bj][m][1] + b1;
                    u32x4 w; w.x = cvt_pk_bf16(bflo(z.x) * fsigmoid(v0[0]), bfhi(z.x) * fsigmoid(v0[1])); w.y = cvt_pk_bf16(bflo(z.y) * fsigmoid(v0[2]), bfhi(z.y) * fsigmoid(v0[3]));
                    w.z = cvt_pk_bf16(bflo(z.z) * fsigmoid(v1[0]), bfhi(z.z) * fsigmoid(v1[1])); w.w = cvt_pk_bf16(bflo(z.w) * fsigmoid(v1[2]), bfhi(z.w) * fsigmoid(v1[3]));
                    *(u32x4*)(O + (size_t)row * ldo + col) = w; } }
    }
};
struct EpiSwiGlu {
    static constexpr bool PERM = true, AFTER_DRAIN = false;
    bf16_t* HID; const float* rsp;
    __device__ __forceinline__ void operator()(const f32x4 (&acc)[2][2][4][2], const Unit& u, int wr, int wc, int fr, int fq) const {
        const int row0 = u.pm * BM + wr * 64 + fr, col0 = (u.pn & 3) * HALF + wc * 32 + 8 * fq;
#pragma unroll
        for (int ai = 0; ai < 2; ++ai)
#pragma unroll
            for (int m = 0; m < 4; ++m) { const int row = row0 + ai * HALF + m * 16;
                const float rs = rsp[row]; const f32x4 g0 = acc[ai][0][m][0] * rs, g1 = acc[ai][0][m][1] * rs, u0 = acc[ai][1][m][0] * rs, u1 = acc[ai][1][m][1] * rs;
                u32x4 w;
                w.x = cvt_pk_bf16(g0[0] * fsigmoid(g0[0]) * u0[0], g0[1] * fsigmoid(g0[1]) * u0[1]); w.y = cvt_pk_bf16(g0[2] * fsigmoid(g0[2]) * u0[2], g0[3] * fsigmoid(g0[3]) * u0[3]);
                w.z = cvt_pk_bf16(g1[0] * fsigmoid(g1[0]) * u1[0], g1[1] * fsigmoid(g1[1]) * u1[1]); w.w = cvt_pk_bf16(g1[2] * fsigmoid(g1[2]) * u1[2], g1[3] * fsigmoid(g1[3]) * u1[3]);
                *(u32x4*)(HID + (size_t)row * 512 + col0) = w; }
    }
};
struct MoeOrder {
    const int* tile_e; int ntot, NT, G, c;
    __device__ __forceinline__ bool next(int i, Unit& u) const { const long L = (long)i * G + c; if (L >= ntot) return false; const int pm = (int)(L / NT), nt = (int)(L % NT); u.pm = pm; u.pn = tile_e[pm] * NT + nt; return true; }
    __device__ __forceinline__ void a_ready(const Unit&) const {}
    __device__ __forceinline__ void done(const Unit&) const {}
};

struct MoeGatherOrder {
    const int* tile_e; int ntot, NT, G, c; const int* rowtok; int ntok;
    __device__ __forceinline__ bool next(int i, Unit& u) const { const long L = (long)i * G + c; if (L >= ntot) return false; const int pm = (int)(L / NT), nt = (int)(L % NT); u.pm = pm; u.pn = tile_e[pm] * NT + nt; return true; }
    __device__ __forceinline__ void a_ready(const Unit&) const {}
    __device__ __forceinline__ void done(const Unit&) const {}
};

template <class Epi, class Sched, bool ALIGN_EPI = false, bool SP2 = false, bool GATHER = false>
__device__ __forceinline__ void gemm_phase(PG8_LAS unsigned char* lds, const Gemm g, const Sched& S, const Epi& E) {
    int tid_ = threadIdx.x; asm volatile("" : "+v"(tid_));
    const int tid = tid_, wid = __builtin_amdgcn_readfirstlane(tid >> 6), lane = tid & 63, wr = wid >> 2, wc = wid & 3, fr = lane & 15, fq = lane >> 4;
    const int K = g.K, nt = K / BK;
    unsigned voffA[2], voffB[2];
#pragma unroll
    for (int i = 0; i < 2; ++i) { int R, C; stage_rc(tid * 16 + i * 8192, R, C); const int Rb = Epi::PERM ? ((R & ~31) + perm32(R & 31)) : R;
        voffA[i] = (unsigned)(R * K + C) * 2u; voffB[i] = (unsigned)(Rb * K + C) * 2u; }
    static_assert(!GATHER || SP2, "gather needs the SP2 loop");
    unsigned vA[2][2] = {{0u, 0u}, {0u, 0u}}, vN[2][2] = {{0u, 0u}, {0u, 0u}};
#define PG8_GOFF(u_, v_) do { _Pragma("unroll") for (int h_ = 0; h_ < 2; ++h_) _Pragma("unroll") for (int i_ = 0; i_ < 2; ++i_) { int R_, C_; stage_rc(tid * 16 + i_ * 8192, R_, C_); \
        int tok_ = 0; if constexpr (GATHER) { tok_ = S.rowtok[(u_).pm * BM + h_ * HALF + R_]; if ((unsigned)tok_ >= (unsigned)S.ntok) tok_ = 0; } v_[h_][i_] = (unsigned)(tok_ * K + C_) * 2u; } } while (0)
    const size_t kstep = (size_t)(BK * 2);
    const size_t hstep = (size_t)HALF * K * 2;
    const size_t tstep = 2 * hstep;
    const unsigned ldsw = (unsigned)wid * 1024u;
    const int aoff = lds_byte(wr * 64 + fr, fq * 8), boff = lds_byte(wc * 32 + fr, fq * 8);
#define PG8_SA(b, h) (((b) * 2 + (h)) * HTB)
#define PG8_SB(b, h) ((4 + (b) * 2 + (h)) * HTB)
#define PG8_STAGE(bufoff, gbase, voff) do { _Pragma("unroll") for (int _i = 0; _i < 2; ++_i) \
        __builtin_amdgcn_global_load_lds((const unsigned*)((const char*)(gbase) + (voff)[_i]), (PG8_LAS unsigned*)(lds + (bufoff) + ldsw + _i * 8192), 16, 0, 0); } while (0)
#define PG8_STAGE_A(bufoff, kb_, h_, nx_) do { if constexpr (GATHER) { if (nx_) PG8_STAGE(bufoff, (const char*)g.A + (kb_), vN[h_]); else PG8_STAGE(bufoff, (const char*)g.A + (kb_), vA[h_]); } \
        else PG8_STAGE(bufoff, ((nx_) ? nA : cA) + (kb_) + (h_) * hstep, voffA); } while (0)
#define PG8_LDA(dst, b, h) do { _Pragma("unroll") for (int m = 0; m < 4; ++m) _Pragma("unroll") for (int k = 0; k < 2; ++k) dst[m][k] = *(const PG8_LAS bf16x8*)(lds + PG8_SA(b, h) + aoff + m * 2048 + k * 1024); } while (0)
#define PG8_LDB(dst, b, h) do { _Pragma("unroll") for (int n = 0; n < 2; ++n) _Pragma("unroll") for (int k = 0; k < 2; ++k) dst[n][k] = *(const PG8_LAS bf16x8*)(lds + PG8_SB(b, h) + boff + n * 2048 + k * 1024); } while (0)
#define PG8_MMA(ai, bj, At, Bt) do { __builtin_amdgcn_s_setprio(1); _Pragma("unroll") for (int m = 0; m < 4; ++m) _Pragma("unroll") for (int n = 0; n < 2; ++n) _Pragma("unroll") for (int k = 0; k < 2; ++k) \
        acc[ai][bj][m][n] = __builtin_amdgcn_mfma_f32_16x16x32_bf16(Bt[n][k], At[m][k], acc[ai][bj][m][n], 0, 0, 0); __builtin_amdgcn_s_setprio(0); } while (0)
#define PG8_WAIT_V(n) asm volatile("s_waitcnt vmcnt(" #n ")" ::: "memory")
#define PG8_WAIT_L(n) asm volatile("s_waitcnt lgkmcnt(" #n ")" ::: "memory")
#define PG8_BAR __builtin_amdgcn_s_barrier()
#define PG8_SCHED __builtin_amdgcn_sched_barrier(0)
    Unit cur, nxt; int ui = 0;
    if (!S.next(0, cur)) return;
    f32x4 acc[2][2][4][2];
#pragma unroll
    for (int a = 0; a < 2; ++a)
#pragma unroll
        for (int b = 0; b < 2; ++b)
#pragma unroll
            for (int m = 0; m < 4; ++m)
#pragma unroll
                for (int n = 0; n < 2; ++n) acc[a][b][m][n] = (f32x4){0.f, 0.f, 0.f, 0.f};
    bf16x8 At[4][2], B0[2][2], B1[2][2];
    const char* cA = (const char*)g.A + (size_t)cur.pm * tstep; const char* cB = (const char*)g.Bt + (size_t)cur.pn * tstep;
    S.a_ready(cur);
    if constexpr (SP2) {
        const char* nA = cA; (void)nA;
        if constexpr (GATHER) PG8_GOFF(cur, vA);
        PG8_STAGE(PG8_SB(0, 0), cB, voffB); PG8_STAGE(PG8_SB(0, 1), cB + hstep, voffB); PG8_STAGE_A(PG8_SA(0, 0), (size_t)0, 0, false); PG8_STAGE_A(PG8_SA(0, 1), (size_t)0, 1, false);
        if (wr == 1) PG8_BAR;
        PG8_WAIT_V(2); PG8_BAR;
        PG8_STAGE(PG8_SB(1, 0), cB + kstep, voffB); PG8_STAGE_A(PG8_SA(1, 0), kstep, 0, false); PG8_STAGE(PG8_SB(1, 1), cB + hstep + kstep, voffB);
        PG8_WAIT_V(6); PG8_BAR;
    } else {
        PG8_STAGE(PG8_SB(0, 0), cB, voffB); PG8_STAGE(PG8_SA(0, 0), cA, voffA); PG8_STAGE(PG8_SB(0, 1), cB + hstep, voffB); PG8_STAGE(PG8_SA(0, 1), cA + hstep, voffA);
        if (wr == 1) PG8_BAR;
        PG8_WAIT_V(4); PG8_BAR;
        PG8_STAGE(PG8_SB(1, 0), cB + kstep, voffB); PG8_STAGE(PG8_SA(1, 0), cA + kstep, voffA); PG8_STAGE(PG8_SB(1, 1), cB + hstep + kstep, voffB);
        PG8_WAIT_V(6); PG8_BAR;
    }
    for (;;) {
        const bool has_next = S.next(ui + 1, nxt);
        const char* nA = has_next ? (const char*)g.A + (size_t)nxt.pm * tstep : cA; const char* nB = has_next ? (const char*)g.Bt + (size_t)nxt.pn * tstep : cB;
        if constexpr (GATHER) { if (has_next) PG8_GOFF(nxt, vN); else { vN[0][0] = vA[0][0]; vN[0][1] = vA[0][1]; vN[1][0] = vA[1][0]; vN[1][1] = vA[1][1]; } }
        for (int t = 0; t < nt; t += 2) {
            const bool last = (t == nt - 2);
            const char* a1 = cA + (size_t)(t + 1) * kstep;
            const char* a2 = last ? nA : cA + (size_t)(t + 2) * kstep; const char* b2 = last ? nB : cB + (size_t)(t + 2) * kstep;
            const char* a3 = a2 + kstep; const char* b3 = b2 + kstep; (void)a1; (void)a3;
            const size_t k2 = last ? (size_t)0 : (size_t)(t + 2) * kstep;
            if (last && has_next) S.a_ready(nxt);
            if constexpr (SP2) {
            PG8_LDB(B0, 0, 0); PG8_LDB(B1, 0, 1); PG8_SCHED; PG8_LDA(At, 0, 0); PG8_STAGE_A(PG8_SA(1, 1), (size_t)(t + 1) * kstep, 1, false);
            PG8_WAIT_V(8); PG8_WAIT_L(0); PG8_BAR; PG8_MMA(0, 0, At, B0); PG8_MMA(0, 1, At, B1); PG8_BAR; PG8_SCHED;
            PG8_LDA(At, 0, 1); PG8_STAGE(PG8_SB(0, 0), b2, voffB); PG8_STAGE(PG8_SB(0, 1), b2 + hstep, voffB); PG8_STAGE_A(PG8_SA(0, 0), k2, 0, last);
            PG8_WAIT_V(8); PG8_WAIT_L(0); PG8_BAR; PG8_MMA(1, 0, At, B0); PG8_MMA(1, 1, At, B1); PG8_BAR; PG8_SCHED;
            PG8_LDB(B0, 1, 0); PG8_LDB(B1, 1, 1); PG8_SCHED; PG8_LDA(At, 1, 0); PG8_STAGE_A(PG8_SA(0, 1), k2, 1, last);
            PG8_WAIT_V(8); PG8_WAIT_L(0); PG8_BAR; PG8_MMA(0, 0, At, B0); PG8_MMA(0, 1, At, B1); PG8_BAR; PG8_SCHED;
            PG8_LDA(At, 1, 1); PG8_STAGE(PG8_SB(1, 0), b3, voffB); PG8_STAGE(PG8_SB(1, 1), b3 + hstep, voffB); PG8_STAGE_A(PG8_SA(1, 0), k2 + kstep, 0, last);
            PG8_WAIT_V(8); PG8_WAIT_L(0); PG8_BAR; PG8_MMA(1, 0, At, B0); PG8_MMA(1, 1, At, B1); PG8_BAR; PG8_SCHED;
            } else {
            PG8_LDB(B0, 0, 0); PG8_SCHED; PG8_LDA(At, 0, 0); PG8_STAGE(PG8_SA(1, 1), a1 + hstep, voffA);
            PG8_WAIT_L(8); PG8_BAR; PG8_WAIT_L(0); PG8_MMA(0, 0, At, B0); PG8_BAR; PG8_SCHED;
            PG8_LDB(B1, 0, 1); PG8_STAGE(PG8_SB(0, 0), b2, voffB);
            PG8_BAR; PG8_WAIT_L(0); PG8_MMA(0, 1, At, B1); PG8_BAR;
            PG8_LDA(At, 0, 1); PG8_STAGE(PG8_SA(0, 0), a2, voffA);
            PG8_BAR; PG8_WAIT_L(0); PG8_MMA(1, 0, At, B0); PG8_BAR; PG8_SCHED;
            PG8_STAGE(PG8_SB(0, 1), b2 + hstep, voffB);
            PG8_WAIT_V(6); PG8_BAR; PG8_MMA(1, 1, At, B1); PG8_BAR;
            PG8_LDB(B0, 1, 0); PG8_SCHED; PG8_LDA(At, 1, 0); PG8_STAGE(PG8_SA(0, 1), a2 + hstep, voffA);
            PG8_WAIT_L(8); PG8_BAR; PG8_WAIT_L(0); PG8_MMA(0, 0, At, B0); PG8_BAR; PG8_SCHED;
            PG8_LDB(B1, 1, 1); PG8_STAGE(PG8_SB(1, 0), b3, voffB);
            PG8_BAR; PG8_WAIT_L(0); PG8_MMA(0, 1, At, B1); PG8_BAR;
            PG8_LDA(At, 1, 1); PG8_STAGE(PG8_SA(1, 0), a3, voffA);
            PG8_BAR; PG8_WAIT_L(0); PG8_MMA(1, 0, At, B0); PG8_BAR; PG8_SCHED;
            PG8_STAGE(PG8_SB(1, 1), b3 + hstep, voffB);
            PG8_WAIT_V(6); PG8_BAR; PG8_MMA(1, 1, At, B1); PG8_BAR;
            }
        }
        if constexpr (ALIGN_EPI) { if (wr == 0) PG8_BAR; }
        if constexpr (!Epi::AFTER_DRAIN) { E(acc, cur, wr, wc, fr, fq); S.done(cur); }
        if (!has_next) break;
#pragma unroll
        for (int a = 0; a < 2; ++a)
#pragma unroll
            for (int b = 0; b < 2; ++b)
#pragma unroll
                for (int m = 0; m < 4; ++m)
#pragma unroll
                    for (int n = 0; n < 2; ++n) acc[a][b][m][n] = (f32x4){0.f, 0.f, 0.f, 0.f};
        cur = nxt; cA = nA; cB = nB; ++ui;
        if constexpr (GATHER) { vA[0][0] = vN[0][0]; vA[0][1] = vN[0][1]; vA[1][0] = vN[1][0]; vA[1][1] = vN[1][1]; }
        if constexpr (ALIGN_EPI) { if (wr == 1) PG8_BAR; }
    }
    PG8_WAIT_V(0);
    if constexpr (!ALIGN_EPI) { if (wr == 0) PG8_BAR; }
    PG8_BAR;
    if constexpr (Epi::AFTER_DRAIN) { E.fused(acc, cur, wr, wc, fr, fq, lds, wid, lane); S.done(cur); }
#undef PG8_SA
#undef PG8_SB
#undef PG8_STAGE
#undef PG8_STAGE_A
#undef PG8_GOFF
#undef PG8_LDA
#undef PG8_LDB
#undef PG8_MMA
#undef PG8_WAIT_V
#undef PG8_WAIT_L
#undef PG8_BAR
#undef PG8_SCHED
}
}
#define XB_TMO      128
#define XB_XCNT(j)  (256  + 64 * (j))
#define XB_XSUB(j)  (1280 + 64 * (j))
#define XB_XGEN(j)  (2304 + 64 * (j))
#define XB_TOP      3328
#define XB_TOPGEN   3392
#define XCD_BAR_WORDS 3456
#define XB_SPIN_CAP (1u << 22)
#define LAS __attribute__((address_space(3)))

__device__ __forceinline__ unsigned xb_ld(unsigned* p)              { return __hip_atomic_load(p, __ATOMIC_RELAXED, __HIP_MEMORY_SCOPE_AGENT); }
__device__ __forceinline__ unsigned xb_add(unsigned* p, unsigned v) { return __hip_atomic_fetch_add(p, v, __ATOMIC_RELAXED, __HIP_MEMORY_SCOPE_AGENT); }
__device__ __forceinline__ unsigned xb_xcc_id() { return (unsigned)__builtin_amdgcn_s_getreg((3 << 11) | 20) & 0xFu; }
#define XB_SPIN(cond, bar) do { unsigned _sp = 0; while (cond) { __builtin_amdgcn_s_sleep(1); \
    if ((++_sp & 255u) == 0u) { if (xb_ld(&(bar)[XB_TMO])) break; if (_sp > XB_SPIN_CAP) { atomicAdd(&(bar)[XB_TMO], 1u); break; } } } } while (0)

struct XcdBarrier {
    unsigned* bar; unsigned x;
    volatile LAS unsigned* st;
};

__device__ __forceinline__ XcdBarrier xcd_barrier_post(unsigned* bar, volatile LAS unsigned* st) {
    XcdBarrier b; b.bar = bar; b.x = xb_xcc_id(); b.st = st;
    if (threadIdx.x == 0) (void)xb_add(&bar[XB_XCNT(b.x)], 1u);
    return b;
}
__device__ __forceinline__ void xcd_barrier_complete(unsigned* bar, unsigned x, unsigned& nloc, unsigned& nx) {
    const unsigned G = gridDim.x * gridDim.y * gridDim.z;
    unsigned sum, cnt, mine, sp = 0u;
    for (;;) {
        sum = 0u; cnt = 0u; mine = 0u;
#pragma unroll
        for (unsigned j = 0; j < 16; ++j) { const unsigned c = xb_ld(&bar[XB_XCNT(j)]); sum += c; cnt += (c > 0u) ? 1u : 0u; mine = (j == x) ? c : mine; }
        if (sum == G) break;
        __builtin_amdgcn_s_sleep(1);
        if ((++sp & 255u) == 0u) { if (xb_ld(&bar[XB_TMO])) break; if (sp > XB_SPIN_CAP) { atomicAdd(&bar[XB_TMO], 1u); break; } }
    }
    nloc = mine > 0u ? mine : 1u; nx = cnt > 0u ? cnt : 1u;
}

__device__ __forceinline__ void xcd_barrier(const XcdBarrier& b) {
    asm volatile("s_waitcnt vmcnt(0)" ::: "memory");
    __syncthreads();
    if (threadIdx.x == 0) {
        unsigned* bar = b.bar;
        __builtin_amdgcn_s_waitcnt(0);
        unsigned nloc = b.st[0], nx = b.st[1];
        if (nloc == 0u) { xcd_barrier_complete(bar, b.x, nloc, nx); b.st[0] = nloc; b.st[1] = nx; }
        const unsigned old = xb_add(&bar[XB_XSUB(b.x)], 1u);
        const unsigned gen = old / nloc;
        if (old + 1u == (gen + 1u) * nloc) {
            __builtin_amdgcn_fence(__ATOMIC_RELEASE, "agent");
            asm volatile("s_waitcnt vmcnt(0)" ::: "memory");
            const unsigned og = xb_add(&bar[XB_TOP], 1u);
            const unsigned tg = og / nx;
            if (og + 1u == (tg + 1u) * nx) xb_add(&bar[XB_TOPGEN], 1u);
            else XB_SPIN(xb_ld(&bar[XB_TOPGEN]) == tg, bar);
            __builtin_amdgcn_fence(__ATOMIC_ACQUIRE, "agent");
            xb_add(&bar[XB_XGEN(b.x)], 1u);
            asm volatile("s_waitcnt vmcnt(0)" ::: "memory");
        } else {
            XB_SPIN(xb_ld(&bar[XB_XGEN(b.x)]) == gen, bar);
            __builtin_amdgcn_fence(__ATOMIC_ACQUIRE, "agent");
            asm volatile("s_waitcnt vmcnt(0)" ::: "memory");
        }
    }
    __syncthreads();
}

namespace mk {
using pg8::bf16_t; using pg8::f32x4; using pg8::u32x4; using pg8::u32x2; using pg8::cvt_pk_bf16; using pg8::bflo; using pg8::bfhi; using pg8::fsigmoid;
#define MK_LAS __attribute__((address_space(3)))
__device__ __forceinline__ int otid() { int t = threadIdx.x; asm volatile("" : "+v"(t)); return t; }
#define MK_TID otid()

constexpr int NB = 2, T = 16384, D = 2048, NTOK = NB * T;
constexpr int AB_COLS = 7616, AB_LD = 7680, RWO = 4096;
constexpr int CD_COLS = 4104, CD_LD = 4096;
constexpr int NEXP = 32, FF = 512, ROWS_MAX = 2 * NTOK + NEXP * 256;
constexpr float NORM_EPS = 1e-6f;

constexpr size_t MiB = 1u << 20;
constexpr size_t WS_CTL = 0, CTL_ZERO = 1 * MiB;
constexpr size_t WS_HIST = 1 * MiB, WS_TILEE = 1 * MiB + 64 * 1024, WS_NT = 1 * MiB + 96 * 1024;
constexpr size_t WS_RE = 2 * MiB, WS_RWT = 3 * MiB, WS_POS = 4 * MiB, WS_LOGF = 5 * MiB, WS_CUM = 6 * MiB;
constexpr size_t WS_ABIN = 16 * MiB, WS_ABOUT = 46 * MiB, WS_CDIN = 54 * MiB, WS_CDOUT = 70 * MiB, WS_GLU = 78 * MiB;
constexpr size_t WS_GU = 80 * MiB, WS_DN = 208 * MiB;
constexpr size_t WS_H = 272 * MiB, WS_O = 400 * MiB, WS_P = 528 * MiB, WS_SCR = 1008 * MiB, WS_END = 1136 * MiB;
constexpr size_t WS_HID = WS_P + 288 * MiB;

constexpr int LDS_RING = 128 * 1024, LDS_MISC = 144 * 1024, LDS_BYTES = LDS_MISC + 4096;

struct Args { const float* in[39]; float* out; unsigned char* ws; int ph_lo, ph_hi; };
enum { I_X = 0, I_MIXW, I_FFNW, I_FINW, I_ABIN, I_ABOUT, I_HGLB, I_HGNW, I_RWMU, I_RWW0, I_RWW2, I_RWA0, I_RWA2, I_RWG2, I_RWKK, I_RWKA, I_RWRK, I_RWLNW, I_RWLNB,
       I_CDIN, I_CDOUT, I_S5LR, I_S5LI, I_S5DT, I_S5BR, I_S5BI, I_S5CR, I_S5CI, I_S5D, I_S5GLU, I_S5BG, I_FOXB, I_MWG, I_MBG, I_MWR, I_MBR, I_MGATE, I_MUP, I_MDOWN };

__device__ __forceinline__ float bf2f(bf16_t v) { return __uint_as_float((unsigned)v << 16); }
__device__ __forceinline__ float wave_sum(float v) {
#pragma unroll
    for (int o = 32; o > 0; o >>= 1) v += __shfl_xor(v, o); return v; }
__device__ __forceinline__ float wave_max(float v) {
#pragma unroll
    for (int o = 32; o > 0; o >>= 1) v = fmaxf(v, __shfl_xor(v, o)); return v; }
__device__ __forceinline__ float softplusf(float x) { return fmaxf(x, 0.f) + log1pf(__expf(-fabsf(x))); }
__device__ __forceinline__ float siluf(float x) { return x * fsigmoid(x); }
__device__ __forceinline__ float gelu_tanh(float y) { const float u = 0.7978845608028654f * (y + 0.044715f * y * y * y); return 0.5f * y * (1.0f + tanhf(u)); }

struct TileDesc { const float* src; bf16_t* dst; int ldn, k0, n0, nvalid, K, row0; };
__device__ __forceinline__ void tile_load(const TileDesc& d, f32x4 (&v)[2]) {
    const int tid = MK_TID;
#pragma unroll
    for (int i = 0; i < 2; ++i) { const int k = (tid >> 4) + 32 * i, n4 = (tid & 15) * 4;
        v[i] = (f32x4){0.f, 0.f, 0.f, 0.f}; if (d.n0 + n4 < d.nvalid) v[i] = *(const f32x4*)(d.src + (size_t)(d.k0 + k) * d.ldn + d.n0 + n4); }
}
__device__ __forceinline__ void tile_store(const TileDesc& d, const f32x4 (&v)[2], MK_LAS float* scr) {
    const int tid = MK_TID;
#pragma unroll
    for (int i = 0; i < 2; ++i) { const int k = (tid >> 4) + 32 * i, n4 = (tid & 15) * 4;
        scr[(n4 + 0) * 65 + k] = v[i][0]; scr[(n4 + 1) * 65 + k] = v[i][1]; scr[(n4 + 2) * 65 + k] = v[i][2]; scr[(n4 + 3) * 65 + k] = v[i][3]; }
    __syncthreads();
    { const int n = tid >> 3, k8 = (tid & 7) * 8; const MK_LAS float* s = scr + n * 65 + k8;
      u32x4 w; w.x = cvt_pk_bf16(s[0], s[1]); w.y = cvt_pk_bf16(s[2], s[3]); w.z = cvt_pk_bf16(s[4], s[5]); w.w = cvt_pk_bf16(s[6], s[7]);
      *(u32x4*)(d.dst + (size_t)(d.row0 + n) * d.K + d.k0 + k8) = w; }
    __syncthreads();
}
constexpr int IT_ABIN = 32 * 120, IT_ABOUT = 32 * 32, IT_CDIN = 32 * 64, IT_CDOUT = 32 * 32, IT_GLU = 16 * 16, IT_PROJ = IT_ABIN + IT_ABOUT + IT_CDIN + IT_CDOUT + IT_GLU;
constexpr int IT_GU = 32 * 32 * 16, IT_DN = 32 * 8 * 32, IT_MOE = IT_GU + IT_DN;
__device__ __forceinline__ TileDesc proj_item(const Args& a, int r) {
    unsigned char* ws = a.ws;
    if (r < IT_ABIN) return TileDesc{a.in[I_ABIN], (bf16_t*)(ws + WS_ABIN), AB_COLS, (r / 120) * 64, (r % 120) * 64, AB_COLS, D, (r % 120) * 64}; r -= IT_ABIN;
    if (r < IT_ABOUT) return TileDesc{a.in[I_ABOUT], (bf16_t*)(ws + WS_ABOUT), D, (r / 32) * 64, (r % 32) * 64, D, D, (r % 32) * 64}; r -= IT_ABOUT;
    if (r < IT_CDIN) return TileDesc{a.in[I_CDIN], (bf16_t*)(ws + WS_CDIN), CD_COLS, (r / 64) * 64, (r % 64) * 64, CD_COLS, D, (r % 64) * 64}; r -= IT_CDIN;
    if (r < IT_CDOUT) return TileDesc{a.in[I_CDOUT], (bf16_t*)(ws + WS_CDOUT), D, (r / 32) * 64, (r % 32) * 64, D, D, (r % 32) * 64}; r -= IT_CDOUT;
    return TileDesc{a.in[I_S5GLU], (bf16_t*)(ws + WS_GLU), 1024, (r / 16) * 64, (r % 16) * 64, 1024, 1024, (r % 16) * 64};
}
__device__ __forceinline__ TileDesc moe_item(const Args& a, int layer, int r) {
    unsigned char* ws = a.ws;
    if (r < IT_GU) { const int e = r / 512, rem = r % 512, kt = rem / 16, q = rem % 16, j = q >> 2, half = (q >> 1) & 1, sub = q & 1;
        const float* src = (half ? a.in[I_MUP] : a.in[I_MGATE]) + (size_t)(layer * NEXP + e) * D * FF;
        return TileDesc{src, (bf16_t*)(ws + WS_GU), FF, kt * 64, 128 * j + 64 * sub, FF, D, e * 1024 + 256 * j + 128 * half + 64 * sub}; }
    r -= IT_GU;
    { const int e = r / 256, rem = r % 256, kt = rem / 32, nt = rem % 32;
      const float* src = a.in[I_MDOWN] + (size_t)(layer * NEXP + e) * FF * D;
      return TileDesc{src, (bf16_t*)(ws + WS_DN), D, kt * 64, nt * 64, D, FF, e * D + nt * 64}; }
}
template <int KIND> __device__ __forceinline__ void convert_items(const Args& a, MK_LAS float* scr) {
    constexpr int NIT = (KIND == 0) ? IT_PROJ : IT_MOE; const int G = (int)gridDim.x;
    int it = (int)blockIdx.x; if (it >= NIT) return;
    f32x4 v0[2], v1[2], v2[2]; TileDesc d0 = (KIND == 0) ? proj_item(a, it) : moe_item(a, KIND - 1, it), d1 = d0, d2 = d0;
    tile_load(d0, v0);
    const bool has1 = it + G < NIT; if (has1) { d1 = (KIND == 0) ? proj_item(a, it + G) : moe_item(a, KIND - 1, it + G); tile_load(d1, v1); }
    for (;;) { const int n2 = it + 2 * G; const bool more2 = n2 < NIT, more1 = it + G < NIT;
        if (more2) { d2 = (KIND == 0) ? proj_item(a, n2) : moe_item(a, KIND - 1, n2); tile_load(d2, v2); }
        tile_store(d0, v0, scr);
        if (!more1) break;
        v0[0] = v1[0]; v0[1] = v1[1]; d0 = d1; v1[0] = v2[0]; v1[1] = v2[1]; d1 = d2; it += G; }
}

__device__ __forceinline__ float row_rstd(const f32x4 (&v)[8]) {
    float s = 0.f;
#pragma unroll
    for (int j = 0; j < 8; ++j) s += (v[j][0] * v[j][0] + v[j][1] * v[j][1]) + (v[j][2] * v[j][2] + v[j][3] * v[j][3]);
    return rsqrtf(wave_sum(s) * (1.0f / D) + NORM_EPS);
}
__device__ __forceinline__ void norm_scale(f32x4 (&v)[8], float rstd, const float* w, int lane) {
#pragma unroll
    for (int j = 0; j < 8; ++j) { const f32x4 g = *(const f32x4*)(w + 4 * (lane + 64 * j)); v[j] = v[j] * rstd * g; }
}
__device__ __forceinline__ void store_row_bf16(const f32x4 (&v)[8], bf16_t* orow, int lane) {
#pragma unroll
    for (int j = 0; j < 8; ++j) { u32x2 w; w.x = cvt_pk_bf16(v[j][0], v[j][1]); w.y = cvt_pk_bf16(v[j][2], v[j][3]); *(u32x2*)(orow + 4 * (lane + 64 * j)) = w; }
}

__device__ __forceinline__ void ph_prologue(const Args& a, MK_LAS unsigned char* lds) {
    MK_LAS float* scr = (MK_LAS float*)lds;
    convert_items<0>(a, scr); convert_items<1>(a, scr);
    const int lane = MK_TID & 63, gw = blockIdx.x * 8 + (MK_TID >> 6), NGW = gridDim.x * 8;
    bf16_t* H = (bf16_t*)(a.ws + WS_H);
    for (int m = gw; m < NTOK; m += NGW) {
        const float* xr = a.in[I_X] + (size_t)m * D; f32x4 v[8];
#pragma unroll
        for (int j = 0; j < 8; ++j) v[j] = *(const f32x4*)(xr + 4 * (lane + 64 * j));
        const float rstd = row_rstd(v); norm_scale(v, rstd, a.in[I_MIXW], lane); store_row_bf16(v, H + (size_t)m * D, lane);
    }
}

__device__ __forceinline__ void ph_hgrn2_naive(const Args& a, MK_LAS unsigned char* lds) {
    constexpr int TS = 8;
    const int tid = MK_TID, grp = tid >> 7, v = tid & 127, s = blockIdx.x * 4 + grp, b = s >> 3, hh = s & 7;
    const bf16_t* P = (const bf16_t*)(a.ws + WS_P); float* raw = (float*)(a.ws + WS_H);
    MK_LAS float* Lq = (MK_LAS float*)lds + grp * (3 * TS * 128); MK_LAS float* Lf = Lq + TS * 128; MK_LAS float* Lk = Lf + TS * 128;
    const int c = hh * 128 + v;
    const float l0 = a.in[I_HGLB][c], l1 = a.in[I_HGLB][1024 + c]; const float mx = fmaxf(l0, l1), e0 = __expf(l0 - mx), e1 = __expf(l1 - mx), lb = e0 / (e0 + e1);
    float S[128];
#pragma unroll
    for (int k = 0; k < 128; ++k) S[k] = 0.f;
    for (int t0 = 0; t0 < T; t0 += TS) {
#pragma unroll
        for (int tt = 0; tt < TS; ++tt) { const size_t row = (size_t)b * T + t0 + tt;
            const float q = bf2f(P[row * AB_LD + c]), fl = bf2f(P[row * AB_LD + 1024 + c]);
            const float f = lb + (1.0f - lb) * fsigmoid(fl);
            Lq[tt * 128 + v] = siluf(q); Lf[tt * 128 + v] = f; Lk[tt * 128 + v] = 1.0f - f; }
        __syncthreads();
        for (int tt = 0; tt < TS; ++tt) { const size_t row = (size_t)b * T + t0 + tt;
            const float vi = bf2f(P[row * AB_LD + 2048 + c]); float o = 0.f;
#pragma unroll
            for (int k4 = 0; k4 < 32; ++k4) { const f32x4 q = *(const MK_LAS f32x4*)(Lq + tt * 128 + 4 * k4), f = *(const MK_LAS f32x4*)(Lf + tt * 128 + 4 * k4), kd = *(const MK_LAS f32x4*)(Lk + tt * 128 + 4 * k4);
#pragma unroll
                for (int i = 0; i < 4; ++i) { S[4 * k4 + i] = f[i] * S[4 * k4 + i] + kd[i] * vi; o += S[4 * k4 + i] * q[i]; } }
            raw[row * 1024 + c] = o; }
        __syncthreads();
    }
}

__device__ __forceinline__ float rw_pf(const bf16_t* P, const float* mu, size_t row, int t, int col) {
    const float cur = bf2f(P[row * AB_LD + RWO + col]); const float prv = (t == 0) ? 0.f : bf2f(P[(row - 1) * AB_LD + RWO + col]);
    return cur + (prv - cur) * mu[col];
}
__device__ __forceinline__ void ph_rwkv_naive(const Args& a, MK_LAS unsigned char* lds) {
    constexpr int TS = 16;
    const int tid = MK_TID, s = blockIdx.x - 4, b = s >> 4, hh = s & 15;
    const bf16_t* P = (const bf16_t*)(a.ws + WS_P); float* yraw = (float*)(a.ws + WS_SCR);
    const float* mu = a.in[I_RWMU];
    MK_LAS float* Lr = (MK_LAS float*)lds; MK_LAS float* Lw = Lr + TS * 64; MK_LAS float* Lk = Lw + TS * 64; MK_LAS float* Lv = Lk + TS * 64; MK_LAS float* La = Lv + TS * 64; MK_LAS float* Lb = La + TS * 64;
    MK_LAS float* Lkk = Lb + TS * 64; MK_LAS float* Ltw = Lkk + TS * 64; MK_LAS float* Lpa = Ltw + TS * 96;
    float S[64];
#pragma unroll
    for (int j = 0; j < 64; ++j) S[j] = 0.f;
    for (int t0 = 0; t0 < T; t0 += TS) {
        for (int i = tid; i < TS * 96; i += 512) { const int tt = i / 96, m = i % 96; const size_t row = (size_t)b * T + t0 + tt;
            Ltw[i] = tanhf(rw_pf(P, mu, row, t0 + tt, 3072 + m)); Lpa[i] = rw_pf(P, mu, row, t0 + tt, 3168 + m); }
        __syncthreads();
        float kreg[2], agreg[2];
#pragma unroll
        for (int q = 0; q < 2; ++q) { const int i = tid + 512 * q, tt = i >> 6, ch = i & 63, c = hh * 64 + ch; const size_t row = (size_t)b * T + t0 + tt;
            const float r = rw_pf(P, mu, row, t0 + tt, c), k = rw_pf(P, mu, row, t0 + tt, 1024 + c), v = rw_pf(P, mu, row, t0 + tt, 2048 + c);
            float lw = a.in[I_RWW0][c], la = a.in[I_RWA0][c];

_Pragma("unroll 8")
            for (int m = 0; m < 96; ++m) { lw += Ltw[tt * 96 + m] * a.in[I_RWW2][m * 1024 + c]; la += Lpa[tt * 96 + m] * a.in[I_RWA2][m * 1024 + c]; }
            const float wlog = -softplusf(-lw) - 0.5f, decay = __expf(-__expf(wlog)), ag = fsigmoid(la);
            Lr[i] = r; Lw[i] = decay; Lv[i] = v; Lkk[i] = k * a.in[I_RWKK][c]; kreg[q] = k; agreg[q] = ag; }
        __syncthreads();
#pragma unroll
        for (int q = 0; q < 2; ++q) { const int i = tid + 512 * q, tt = i >> 6, ch = i & 63, c = hh * 64 + ch;
            float ss = 0.f;
_Pragma("unroll 8")
            for (int j = 0; j < 64; ++j) { const float x = Lkk[tt * 64 + j]; ss += x * x; }
            const float kk = Lkk[i] / fmaxf(sqrtf(ss), 1e-12f);
            Lk[i] = kreg[q] * (1.0f + (agreg[q] - 1.0f) * a.in[I_RWKA][c]); La[i] = -kk; Lb[i] = kk * agreg[q]; }
        __syncthreads();
        if (tid < 64) {
            for (int tt = 0; tt < TS; ++tt) { const size_t row = (size_t)b * T + t0 + tt;
                float sa = 0.f;
#pragma unroll
                for (int j = 0; j < 64; ++j) sa += S[j] * La[tt * 64 + j];
                const float vi = Lv[tt * 64 + tid]; float y = 0.f;
#pragma unroll
                for (int j = 0; j < 64; ++j) { S[j] = S[j] * Lw[tt * 64 + j] + sa * Lb[tt * 64 + j] + vi * Lk[tt * 64 + j]; y += S[j] * Lr[tt * 64 + j]; }
                yraw[row * 1024 + hh * 64 + tid] = y; }
        }
        __syncthreads();
    }
}

__device__ __forceinline__ void ph_post0_naive(const Args& a, MK_LAS unsigned char* lds) {
    const int tid = MK_TID, lane = tid & 63;
    const bf16_t* P = (const bf16_t*)(a.ws + WS_P); const float* hraw = (const float*)(a.ws + WS_H); const float* yraw = (const float*)(a.ws + WS_SCR);
    bf16_t* O = (bf16_t*)(a.ws + WS_O); const float* mu = a.in[I_RWMU];
    MK_LAS float* Lpa = (MK_LAS float*)lds; MK_LAS float* Lsg = Lpa + 96;
    for (int m = blockIdx.x; m < NTOK; m += gridDim.x) { const size_t row = (size_t)m; const int t = m & (T - 1);
        for (int i = tid; i < 96 + 256; i += 512) { if (i < 96) Lpa[i] = rw_pf(P, mu, row, t, 3168 + i); else Lsg[i - 96] = fsigmoid(rw_pf(P, mu, row, t, 3264 + (i - 96))); }
        __syncthreads();
        {
            const int c = tid * 2; const float o0 = hraw[row * 1024 + c], o1 = hraw[row * 1024 + c + 1];
            const float rstd = rsqrtf(wave_sum(o0 * o0 + o1 * o1) * (1.0f / 128.0f) + NORM_EPS);
            const float g0 = bf2f(P[row * AB_LD + 3072 + c]), g1 = bf2f(P[row * AB_LD + 3072 + c + 1]);
            *(unsigned*)(O + row * D + c) = cvt_pk_bf16(o0 * rstd * a.in[I_HGNW][c] * siluf(g0), o1 * rstd * a.in[I_HGNW][c + 1] * siluf(g1)); }
        {
            const int c = tid * 2; float y[2], r[2], k[2], v[2], g[2];
#pragma unroll
            for (int q = 0; q < 2; ++q) { const int cc = c + q; y[q] = yraw[row * 1024 + cc];
                r[q] = rw_pf(P, mu, row, t, cc); const float kx = rw_pf(P, mu, row, t, 1024 + cc); v[q] = rw_pf(P, mu, row, t, 2048 + cc);
                float la = a.in[I_RWA0][cc];
_Pragma("unroll 8")
                for (int i = 0; i < 96; ++i) la += Lpa[i] * a.in[I_RWA2][i * 1024 + cc];
                k[q] = kx * (1.0f + (fsigmoid(la) - 1.0f) * a.in[I_RWKA][cc]);
                float gg = 0.f;
_Pragma("unroll 8")
                for (int i = 0; i < 256; ++i) gg += Lsg[i] * a.in[I_RWG2][i * 1024 + cc];
                g[q] = gg; }
            float sm = y[0] + y[1], sb = r[0] * k[0] * a.in[I_RWRK][c] + r[1] * k[1] * a.in[I_RWRK][c + 1];
#pragma unroll
            for (int o = 16; o > 0; o >>= 1) { sm += __shfl_xor(sm, o); sb += __shfl_xor(sb, o); }
            const float mean = sm * (1.0f / 64.0f); const float d0 = y[0] - mean, d1 = y[1] - mean; float sv = d0 * d0 + d1 * d1;
#pragma unroll
            for (int o = 16; o > 0; o >>= 1) sv += __shfl_xor(sv, o);
            const float rstd = rsqrtf(sv * (1.0f / 64.0f) + 64e-5f);
            const float z0 = (d0 * rstd * a.in[I_RWLNW][c] + a.in[I_RWLNB][c] + sb * v[0]) * g[0], z1 = (d1 * rstd * a.in[I_RWLNW][c + 1] + a.in[I_RWLNB][c + 1] + sb * v[1]) * g[1];
            *(unsigned*)(O + row * D + 1024 + c) = cvt_pk_bf16(z0, z1); }
        __syncthreads();
    }
    (void)lane;
}
typedef short bf16x8 __attribute__((ext_vector_type(8)));
typedef short bf16x4 __attribute__((ext_vector_type(4)));
typedef float f32x16 __attribute__((ext_vector_type(16)));
typedef float f32x2_t __attribute__((ext_vector_type(2))); typedef __bf16 bf16x2_t __attribute__((ext_vector_type(2)));
__device__ __forceinline__ unsigned cvtpk(float lo, float hi) { f32x2_t v = {lo, hi}; bf16x2_t b = __builtin_convertvector(v, bf16x2_t); return __builtin_bit_cast(unsigned, b); }
#define MFMA32(a, b, c) __builtin_amdgcn_mfma_f32_32x32x16_bf16((a), (b), (c), 0, 0, 0)
constexpr int FX_KS = 272, FX_VS = 136, FX_KB = 64 * FX_KS, FX_VB = 128 * FX_VS;
constexpr int FX_OFF_K = 0, FX_OFF_V = 2 * FX_KB, FX_OFF_C = FX_OFF_V + 2 * FX_VB, FX_LDS = FX_OFF_C + 2 * 256;
constexpr float FX_L2E = 1.4426950408889634f;
constexpr size_t WS_KMAX = 65536, WS_FOXQ = 65536 + 256;
constexpr float FX_THR2 = 30.0f * FX_L2E;
__device__ __forceinline__ void ph_fox_kmax(const Args& a) {
    const int lane = MK_TID & 63, gw = blockIdx.x * 8 + (MK_TID >> 6), NGW = gridDim.x * 8;
    const bf16_t* P = (const bf16_t*)(a.ws + WS_P); unsigned* KM = (unsigned*)(a.ws + WS_KMAX);
    for (int bb = 0; bb < NB; ++bb) { float mx = 0.f;
        for (int t = gw; t < T; t += NGW) { const u32x4* kp = (const u32x4*)(P + ((size_t)bb * T + t) * CD_LD + 2048 + 16 * lane); const u32x4 k0 = kp[0], k1 = kp[1];
            float s = bflo(k0.x) * bflo(k0.x) + bfhi(k0.x) * bfhi(k0.x) + bflo(k0.y) * bflo(k0.y) + bfhi(k0.y) * bfhi(k0.y) + bflo(k0.z) * bflo(k0.z) + bfhi(k0.z) * bfhi(k0.z) + bflo(k0.w) * bflo(k0.w) + bfhi(k0.w) * bfhi(k0.w)
                    + bflo(k1.x) * bflo(k1.x) + bfhi(k1.x) * bfhi(k1.x) + bflo(k1.y) * bflo(k1.y) + bfhi(k1.y) * bfhi(k1.y) + bflo(k1.z) * bflo(k1.z) + bfhi(k1.z) * bfhi(k1.z) + bflo(k1.w) * bflo(k1.w) + bfhi(k1.w) * bfhi(k1.w);
            s += __shfl_xor(s, 1); s += __shfl_xor(s, 2); s += __shfl_xor(s, 4); mx = fmaxf(mx, s); }
        if ((lane & 7) == 0) atomicMax(KM + bb * 8 + (lane >> 3), __float_as_uint(mx)); }
}

__device__ __forceinline__ void ph_fox(const Args& a, MK_LAS unsigned char* lds) {
    const int tid = MK_TID, lane = tid & 63, wave = tid >> 6, r = lane & 31, h = lane >> 5;
    const bf16_t* P = (const bf16_t*)(a.ws + WS_P); bf16_t* O = (bf16_t*)(a.ws + WS_O); const float* cum = (const float*)(a.ws + WS_CUM);
    const int G = (int)gridDim.x, c = (int)blockIdx.x;
    const float sc2 = 0.08838834764831845f * FX_L2E;
    unsigned* qhead = (unsigned*)(a.ws + WS_FOXQ);
    (void)G; (void)c;
    for (;;) {
        if (tid == 0) *(MK_LAS unsigned*)(lds + FX_LDS) = __hip_atomic_fetch_add(qhead, 1u, __ATOMIC_RELAXED, __HIP_MEMORY_SCOPE_AGENT);
        __syncthreads();
        const int L = (int)*(const MK_LAS unsigned*)(lds + FX_LDS);
        __syncthreads();
        if (L >= 1024) break;
        const int qt = 63 - (L >> 4), bh = L & 15, b = bh >> 3, hd = bh & 7, q0 = qt * 256, qw = q0 + 32 * wave, nt = 4 * (qt + 1);
        const size_t qrow = (size_t)b * T + qw + r;
        bf16x8 qf[8];
#pragma unroll
        for (int ks = 0; ks < 8; ++ks) qf[ks] = *(const bf16x8*)(P + qrow * CD_LD + 1024 + hd * 128 + 16 * ks + 8 * h);
        const float cq = cum[qrow * 8 + hd] * FX_L2E;
        float qb;
        {   float qn = 0.f;
#pragma unroll
            for (int ks = 0; ks < 8; ++ks) { const u32x4 w = __builtin_bit_cast(u32x4, qf[ks]);
                qn += bflo(w.x) * bflo(w.x) + bfhi(w.x) * bfhi(w.x) + bflo(w.y) * bflo(w.y) + bfhi(w.y) * bfhi(w.y) + bflo(w.z) * bflo(w.z) + bfhi(w.z) * bfhi(w.z) + bflo(w.w) * bflo(w.w) + bfhi(w.w) * bfhi(w.w); }
            qn += __shfl_xor(qn, 32);
            qb = sqrtf(qn * __uint_as_float(((const unsigned*)(a.ws + WS_KMAX))[bh])) * sc2 * 1.01f + 0.01f; }
        bool wdone = false;
        f32x16 o[4];
#pragma unroll
        for (int dt = 0; dt < 4; ++dt)
#pragma unroll
            for (int i = 0; i < 16; ++i) o[dt][i] = 0.f;
        float mrun = -3.0e38f, lrun = 0.f;
        const bf16_t* Kg = P + (size_t)b * T * CD_LD + 2048 + hd * 128; const bf16_t* Vg = P + (size_t)b * T * CD_LD + 3072 + hd * 128;
        u32x4 kreg[2], vreg[2]; float creg = 0.f;
#pragma unroll
        for (int i = 0; i < 2; ++i) { const int ch = tid + 512 * i; kreg[i] = *(const u32x4*)(Kg + (size_t)(64 * (nt - 1) + (ch >> 4)) * CD_LD + 8 * (ch & 15)); vreg[i] = *(const u32x4*)(Vg + (size_t)(64 * (nt - 1) + (ch & 63)) * CD_LD + 8 * (ch >> 6)); }
        if (tid < 64) creg = cum[((size_t)b * T + 64 * (nt - 1) + tid) * 8 + hd] * FX_L2E;
#define FX_WRITE(buf) do { _Pragma("unroll") for (int i = 0; i < 2; ++i) { const int ch = tid + 512 * i; \
            *(MK_LAS u32x4*)(lds + FX_OFF_K + (buf) * FX_KB + (ch >> 4) * FX_KS + (ch & 15) * 16) = kreg[i]; \
            MK_LAS unsigned short* vp = (MK_LAS unsigned short*)(lds + FX_OFF_V + (buf) * FX_VB + (8 * (ch >> 6)) * FX_VS + (ch & 63) * 2); \
            vp[0 * (FX_VS / 2)] = (unsigned short)(vreg[i].x & 0xffffu); vp[1 * (FX_VS / 2)] = (unsigned short)(vreg[i].x >> 16); vp[2 * (FX_VS / 2)] = (unsigned short)(vreg[i].y & 0xffffu); vp[3 * (FX_VS / 2)] = (unsigned short)(vreg[i].y >> 16); \
            vp[4 * (FX_VS / 2)] = (unsigned short)(vreg[i].z & 0xffffu); vp[5 * (FX_VS / 2)] = (unsigned short)(vreg[i].z >> 16); vp[6 * (FX_VS / 2)] = (unsigned short)(vreg[i].w & 0xffffu); vp[7 * (FX_VS / 2)] = (unsigned short)(vreg[i].w >> 16); } \
            if (tid < 64) *(MK_LAS float*)(lds + FX_OFF_C + (buf) * 256 + tid * 4) = creg; } while (0)
        FX_WRITE(0);
        __syncthreads();
        for (int jj = 0; jj < nt; ++jj) {
            const int j = nt - 1 - jj, buf = jj & 1, k0 = 64 * j;
            if (j > 0) {
#pragma unroll
                for (int i = 0; i < 2; ++i) { const int ch = tid + 512 * i; kreg[i] = *(const u32x4*)(Kg + (size_t)(k0 - 64 + (ch >> 4)) * CD_LD + 8 * (ch & 15)); vreg[i] = *(const u32x4*)(Vg + (size_t)(k0 - 64 + (ch & 63)) * CD_LD + 8 * (ch >> 6)); }
                if (tid < 64) creg = cum[((size_t)b * T + k0 - 64 + tid) * 8 + hd] * FX_L2E;
            }
            const MK_LAS float* Cb = (const MK_LAS float*)(lds + FX_OFF_C + buf * 256);
            if (!wdone) wdone = __all(qb + (cq - Cb[63]) <= mrun - FX_THR2);
            if (!wdone && k0 <= qw + 31) {
                const MK_LAS unsigned char* Kb = lds + FX_OFF_K + buf * FX_KB; const MK_LAS unsigned char* Vb = lds + FX_OFF_V + buf * FX_VB;
                f32x16 st[2];
#pragma unroll
                for (int kt = 0; kt < 2; ++kt) {
#pragma unroll
                    for (int i = 0; i < 16; ++i) st[kt][i] = 0.f;
#pragma unroll
                    for (int ks = 0; ks < 8; ++ks) { const bf16x8 kf = *(const MK_LAS bf16x8*)(Kb + (32 * kt + r) * FX_KS + ks * 32 + h * 16); st[kt] = MFMA32(kf, qf[ks], st[kt]); } }
                const bool diag = (k0 + 63 > qw);
                float mx = -3.0e38f;
#pragma unroll
                for (int kt = 0; kt < 2; ++kt)
#pragma unroll
                    for (int g = 0; g < 4; ++g) { const f32x4 ck = *(const MK_LAS f32x4*)(Cb + 32 * kt + 8 * g + 4 * h);
#pragma unroll
                        for (int i = 0; i < 4; ++i) { float s = st[kt][4 * g + i] * sc2 + (cq - ck[i]);
                            if (diag) { const int key = k0 + 32 * kt + 8 * g + 4 * h + i; if (key > qw + r) s = -3.0e38f; }
                            st[kt][4 * g + i] = s; mx = fmaxf(mx, s); } }
                mx = fmaxf(mx, __shfl_xor(mx, 32));
                const float mnew = fmaxf(mrun, mx), corr = __builtin_amdgcn_exp2f(mrun - mnew); mrun = mnew;
                float ls = 0.f;
#pragma unroll
                for (int kt = 0; kt < 2; ++kt)
#pragma unroll
                    for (int i = 0; i < 16; ++i) { const float p = __builtin_amdgcn_exp2f(st[kt][i] - mnew); st[kt][i] = p; ls += p; }
                lrun = lrun * corr + ls;
#pragma unroll
                for (int dt = 0; dt < 4; ++dt)
#pragma unroll
                    for (int i = 0; i < 16; ++i) o[dt][i] *= corr;
                bf16x8 pf[2][2];
#pragma unroll
                for (int kt = 0; kt < 2; ++kt)
#pragma unroll
                    for (int s = 0; s < 2; ++s) { u32x4 w; w.x = cvtpk(st[kt][8 * s + 0], st[kt][8 * s + 1]); w.y = cvtpk(st[kt][8 * s + 2], st[kt][8 * s + 3]); w.z = cvtpk(st[kt][8 * s + 4], st[kt][8 * s + 5]); w.w = cvtpk(st[kt][8 * s + 6], st[kt][8 * s + 7]);
                        pf[kt][s] = __builtin_bit_cast(bf16x8, w); }
#pragma unroll
                for (int dt = 0; dt < 4; ++dt)
#pragma unroll
                    for (int kt = 0; kt < 2; ++kt)
#pragma unroll
                        for (int s = 0; s < 2; ++s) { const MK_LAS unsigned char* vp = Vb + (32 * dt + r) * FX_VS + (32 * kt + 16 * s + 4 * h) * 2;
                            const u32x2 lo = *(const MK_LAS u32x2*)vp, hi = *(const MK_LAS u32x2*)(vp + 16); u32x4 w; w.x = lo.x; w.y = lo.y; w.z = hi.x; w.w = hi.y;
                            o[dt] = MFMA32(__builtin_bit_cast(bf16x8, w), pf[kt][s], o[dt]); }
            }
            if (j > 0) FX_WRITE(buf ^ 1);
            if (__syncthreads_and(wdone ? 1 : 0)) break;
        }
#undef FX_WRITE
        const float ltot = lrun + __shfl_xor(lrun, 32), inv = 1.0f / ltot;
        bf16_t* orow = O + qrow * D + 1024 + hd * 128;
#pragma unroll
        for (int dt = 0; dt < 4; ++dt)
#pragma unroll
            for (int g = 0; g < 4; ++g) { u32x2 w; w.x = cvtpk(o[dt][4 * g] * inv, o[dt][4 * g + 1] * inv); w.y = cvtpk(o[dt][4 * g + 2] * inv, o[dt][4 * g + 3] * inv);
                *(u32x2*)(orow + 32 * dt + 8 * g + 4 * h) = w; }
    }
}
#ifndef MK_RWKV_WP
#define MK_RWKV_WP 1
#endif
#define MFMA16(a, b, c) __builtin_amdgcn_mfma_f32_16x16x32_bf16((a), (b), (c), 0, 0, 0)
constexpr size_t WS_W2T = 8 * MiB, WS_A2T = 8 * MiB + 256 * 1024, WS_G2T = 9 * MiB;
constexpr size_t WS_HGS = WS_H, WS_RWQ = WS_H + 64 * MiB, WS_RWM = WS_H + 96 * MiB;
constexpr size_t WS_HGD = 10 * MiB;
constexpr size_t WS_RWLD = WS_SCR, WS_RWAG = WS_SCR + 64 * MiB;
constexpr int RW_AT = 0, RW_RT = RW_AT + 2304, RW_BH = RW_RT + 2304, RW_KH = RW_BH + 2304, RW_BCT = RW_KH + 2304, RW_KCT = RW_BCT + 2560, RW_VT = RW_KCT + 2560,
              RW_AM = RW_VT + 2560, RW_TM = RW_AM + 3072, RW_NF = RW_TM + 768, RW_WC = RW_NF + 1024, RW_RED = RW_WC + 256, RW_RAWX = RW_RED + 1024, RW_RAWL = RW_RAWX + 6528, RW_OUT = RW_RAWL + 6144, RW_GRP = RW_OUT + 2048;
constexpr int RW_SEG = 512, RW_NSEG = T / RW_SEG, RW_NCH = RW_SEG / 16;
constexpr int RP_RAW = 0, RP_TW = 58240, RP_PA = RP_TW + 13312, RP_SG = RP_PA + 13312, RP_MU = RP_SG + 33792, RP_END = RP_MU + 1792;
static_assert(RP_END <= LDS_RING, "rwkv pre lds");
static_assert(RW_GRP * 2 <= LDS_RING, "rwkv lds");
__device__ __forceinline__ bf16x8 mk8(u32x2 lo, u32x2 hi) { u32x4 w; w.x = lo.x; w.y = lo.y; w.z = hi.x; w.w = hi.y; return __builtin_bit_cast(bf16x8, w); }
__device__ __forceinline__ bf16x8 mk8z(u32x2 lo) { u32x4 w; w.x = lo.x; w.y = lo.y; w.z = 0u; w.w = 0u; return __builtin_bit_cast(bf16x8, w); }
__device__ __forceinline__ u32x2 pk4(const f32x4& v) { u32x2 w; w.x = cvtpk(v[0], v[1]); w.y = cvtpk(v[2], v[3]); return w; }
template <int CTRL> __device__ __forceinline__ float dpp_mov(float x) { return __builtin_bit_cast(float, __builtin_amdgcn_mov_dpp(__builtin_bit_cast(int, x), CTRL, 0xf, 0xf, true)); }
__device__ __forceinline__ float red16(float v) { v += dpp_mov<0xB1>(v); v += dpp_mov<0x4E>(v); v += dpp_mov<0x141>(v); v += dpp_mov<0x128>(v); return v; }

__device__ __forceinline__ void rwkv_convert_small(const Args& a) {
    const int gid = blockIdx.x * 512 + MK_TID, NG = gridDim.x * 512;
    bf16_t* w2t = (bf16_t*)(a.ws + WS_W2T); bf16_t* a2t = (bf16_t*)(a.ws + WS_A2T); bf16_t* g2t = (bf16_t*)(a.ws + WS_G2T);
    for (int i = gid; i < 1024 * 96; i += NG) { const int n = i / 96, m = i % 96; w2t[i] = (bf16_t)(cvtpk(a.in[I_RWW2][m * 1024 + n], 0.f) & 0xffffu); a2t[i] = (bf16_t)(cvtpk(a.in[I_RWA2][m * 1024 + n], 0.f) & 0xffffu); }
    for (int i = gid; i < 1024 * 256; i += NG) { const int n = i >> 8, m = i & 255; g2t[i] = (bf16_t)(cvtpk(a.in[I_RWG2][m * 1024 + n], 0.f) & 0xffffu); }
}

template <int ARR> __device__ __forceinline__ void rp_array(const Args& a, MK_LAS unsigned char* lds, size_t row0, int wave, int m, int q) {
    constexpr int NS = (ARR == 2) ? 8 : 3, KW = (ARR == 2) ? 256 : 96, AO = (ARR == 0) ? RP_TW : ((ARR == 1) ? RP_PA : RP_SG), AS = (ARR == 2) ? 528 : 208;
    const bf16_t* wt = (const bf16_t*)(a.ws + ((ARR == 0) ? WS_W2T : ((ARR == 1) ? WS_A2T : WS_G2T)));
    const int ch0 = 128 * wave + 8 * m;
#pragma unroll 1
    for (int rh = 0; rh < 2; ++rh) {
    f32x4 acc[8][2];
    bf16x8 af[2][NS];
#pragma unroll
    for (int rt = 0; rt < 2; ++rt)
#pragma unroll
        for (int s = 0; s < NS; ++s) af[rt][s] = *(const MK_LAS bf16x8*)(lds + AO + (32 * rh + 16 * rt + m) * AS + (32 * s + 8 * q) * 2);
    bf16x8 wn[NS], wn2[NS];
    constexpr bool TILED = (MK_RWKV_WP != 0) && (ARR < 2);
#define RP_CH(ct_) (TILED ? (128 * wave + 16 * (ct_) + m) : (128 * wave + 8 * m + (ct_)))
#pragma unroll
    for (int s = 0; s < NS; ++s) { wn[s] = *(const bf16x8*)(wt + RP_CH(0) * KW + 32 * s + 8 * q); wn2[s] = *(const bf16x8*)(wt + RP_CH(1) * KW + 32 * s + 8 * q); }
#pragma unroll
    for (int ct = 0; ct < 8; ++ct) { bf16x8 wf[NS];
#pragma unroll
        for (int s = 0; s < NS; ++s) { wf[s] = wn[s]; wn[s] = wn2[s]; }
        if (ct < 6) {
#pragma unroll
            for (int s = 0; s < NS; ++s) wn2[s] = *(const bf16x8*)(wt + RP_CH(ct + 2) * KW + 32 * s + 8 * q); }
#pragma unroll
        for (int rt = 0; rt < 2; ++rt) { f32x4 x = (f32x4){0.f, 0.f, 0.f, 0.f};
#pragma unroll
            for (int s = 0; s < NS; ++s) x = MFMA16(af[rt][s], wf[s], x);
            acc[ct][rt] = x; } }
    f32x4 b0 = (f32x4){0.f, 0.f, 0.f, 0.f}, b1 = b0;
    if (ARR == 0) { b0 = *(const f32x4*)(a.in[I_RWW0] + ch0); b1 = *(const f32x4*)(a.in[I_RWW0] + ch0 + 4); }
    if (ARR == 1) { b0 = *(const f32x4*)(a.in[I_RWA0] + ch0); b1 = *(const f32x4*)(a.in[I_RWA0] + ch0 + 4); }
    bf16_t* base = (ARR == 0) ? (bf16_t*)(a.ws + WS_RWLD) + ch0 : ((ARR == 1) ? (bf16_t*)(a.ws + WS_RWAG) + ch0 : (bf16_t*)(a.ws + WS_O) + 1024 + ch0);
    constexpr int LDO = (ARR == 2) ? D : 1024;
    if (TILED) {
#pragma unroll
        for (int ct = 0; ct < 8; ++ct) { const int ch = 128 * wave + 16 * ct + m; const float bias = (ARR == 0) ? a.in[I_RWW0][ch] : a.in[I_RWA0][ch];
#pragma unroll
            for (int rt = 0; rt < 2; ++rt) { f32x4 v;
#pragma unroll
                for (int e = 0; e < 4; ++e) { const float x = acc[ct][rt][e] + bias; v[e] = (ARR == 0) ? -0.6065306597f * fsigmoid(x) : fsigmoid(x); }
                const size_t cidx = (row0 + 32 * rh + 16 * rt) >> 4;
                *(u32x2*)((bf16_t*)(a.ws + WS_RWLD) + ((cidx * 16 + (ch >> 6)) * 2 + ARR) * 1024 + (ch & 63) * 16 + 4 * q) = pk4(v); } }
    } else
#pragma unroll
    for (int rt = 0; rt < 2; ++rt)
#pragma unroll
        for (int e = 0; e < 4; ++e) { const size_t row = row0 + 32 * rh + 16 * rt + 4 * q + e; float v[8];
#pragma unroll
            for (int ct = 0; ct < 8; ++ct) { const float x = acc[ct][rt][e] + (ct < 4 ? b0[ct & 3] : b1[ct & 3]);
                v[ct] = (ARR == 0) ? -0.6065306597f * fsigmoid(x) : ((ARR == 1) ? fsigmoid(x) : x); }
            u32x4 w; w.x = cvtpk(v[0], v[1]); w.y = cvtpk(v[2], v[3]); w.z = cvtpk(v[4], v[5]); w.w = cvtpk(v[6], v[7]);
            *(u32x4*)(base + row * LDO) = w; }
    }
#undef RP_CH
}
template <int ABL = 0> __device__ __forceinline__ void ph_rwkv_pre(const Args& a, MK_LAS unsigned char* lds) {
    const int tid = MK_TID, lane = tid & 63, wave = tid >> 6, m = lane & 15, q = lane >> 4;
    const bf16_t* P = (const bf16_t*)(a.ws + WS_P); bf16_t* O = (bf16_t*)(a.ws + WS_O); bf16_t* LD = (bf16_t*)(a.ws + WS_RWLD); bf16_t* AG = (bf16_t*)(a.ws + WS_RWAG);
    const bf16_t* w2t = (const bf16_t*)(a.ws + WS_W2T); const bf16_t* a2t = (const bf16_t*)(a.ws + WS_A2T); const bf16_t* g2t = (const bf16_t*)(a.ws + WS_G2T);
    if (tid < 448) *(MK_LAS float*)(lds + RP_MU + tid * 4) = a.in[I_RWMU][3072 + tid];
    const int G = (int)gridDim.x, nit = (NTOK / 64 + G - 1) / G;
    for (int it = 0; it < nit; ++it) {
        int u = it * G + (int)blockIdx.x; const bool valid = u < NTOK / 64; if (!valid) u = NTOK / 64 - 1;
        const size_t row0 = (size_t)u * 64; const bool first = ((u * 64) & (T - 1)) == 0;
#pragma unroll 4
        for (int i = 0; i < ((ABL & 4) ? 0 : 8); ++i) { const int j = tid + 512 * i; if (j < 65 * 56) { const int rw = j / 56, cc = j - rw * 56;
                const u32x4 v = (first && rw == 0) ? (u32x4){0u, 0u, 0u, 0u} : *(const u32x4*)(P + (row0 + rw - 1) * AB_LD + RWO + 3072 + 8 * cc);
                *(MK_LAS u32x4*)(lds + RP_RAW + rw * 896 + cc * 16) = v; } }
        __syncthreads();
#pragma unroll 2
        for (int i = 0; i < ((ABL & 2) ? 0 : 56); ++i) { const int idx = tid + 512 * i, tt = idx / 448, col = idx - tt * 448;
            const float cur = bf2f(*(const MK_LAS bf16_t*)(lds + RP_RAW + (tt + 1) * 896 + col * 2)), prv = bf2f(*(const MK_LAS bf16_t*)(lds + RP_RAW + tt * 896 + col * 2));
            const float x = cur + (prv - cur) * *(const MK_LAS float*)(lds + RP_MU + col * 4);
            if (col < 96) *(MK_LAS bf16_t*)(lds + RP_TW + tt * 208 + col * 2) = (bf16_t)(cvtpk(1.0f - 2.0f / (__expf(2.0f * x) + 1.0f), 0.f) & 0xffffu);
            else if (col < 192) *(MK_LAS bf16_t*)(lds + RP_PA + tt * 208 + (col - 96) * 2) = (bf16_t)(cvtpk(x, 0.f) & 0xffffu);
            else *(MK_LAS bf16_t*)(lds + RP_SG + tt * 528 + (col - 192) * 2) = (bf16_t)(cvtpk(fsigmoid(x), 0.f) & 0xffffu); }
        __syncthreads();
        if (valid && !(ABL & 1)) { rp_array<0>(a, lds, row0, wave, m, q); rp_array<1>(a, lds, row0, wave, m, q); rp_array<2>(a, lds, row0, wave, m, q); }
        __syncthreads();
    }
}
template <int MODE, int ABL = 0>
__device__ __forceinline__ void ph_rwkv(const Args& a, MK_LAS unsigned char* lds, unsigned* qhead = nullptr) {
    const int tid = MK_TID, lane = tid & 63, wave = tid >> 6, grp = wave >> 2, wq = wave & 3, m = lane & 15, q = lane >> 4, gtid = tid & 255;
    MK_LAS unsigned char* gl = lds + grp * RW_GRP;
    const bf16_t* P = (const bf16_t*)(a.ws + WS_P); bf16_t* O = (bf16_t*)(a.ws + WS_O); const float* mu = a.in[I_RWMU];
    const bf16_t* LD = (const bf16_t*)(a.ws + WS_RWLD); const bf16_t* AG = (const bf16_t*)(a.ws + WS_RWAG);
    float* RWQ = (float*)(a.ws + WS_RWQ); float* RWM = (float*)(a.ws + WS_RWM);
    constexpr int NU = 32 * RW_NSEG, NCT = (MODE == 0) ? 2 : 1, NLP = (MODE == 0) ? 256 : 384;
    const int G = (int)gridDim.x, nit = (NU / 2 + G - 1) / G;
    for (int it = 0; qhead != nullptr || it < nit; ++it) {
        int ub = it * G + (int)blockIdx.x;
        if (qhead != nullptr) { MK_LAS unsigned* slot = (MK_LAS unsigned*)(lds + LDS_MISC + 1024); __syncthreads(); if (tid == 0) *slot = __hip_atomic_fetch_add(qhead, 1u, __ATOMIC_RELAXED, __HIP_MEMORY_SCOPE_AGENT); __syncthreads(); ub = (int)*slot; if (ub >= NU / 2) break; }
        const bool valid = ub < NU / 2; if (!valid) ub = NU / 2 - 1;
        const int u = ub * 2 + grp;
        const int stream = u / RW_NSEG, seg = u - stream * RW_NSEG, b = stream >> 4, hh = stream & 15, ch = hh * 64 + 16 * wq + m;
        const float mu_r = mu[ch], mu_k = mu[1024 + ch], mu_v = mu[2048 + ch];
        const float k_k = a.in[I_RWKK][ch], k_a = a.in[I_RWKA][ch], r_k = a.in[I_RWRK][ch], ln_w = a.in[I_RWLNW][ch], ln_b = a.in[I_RWLNB][ch];
        f32x4 zt[NCT][4];
        if (MODE == 0) {
#pragma unroll
            for (int jt = 0; jt < 4; ++jt)
#pragma unroll
                for (int e = 0; e < 4; ++e) { zt[NCT - 1][jt][e] = ((16 * jt + 4 * q + e) == (16 * wq + m)) ? 1.0f : 0.0f; zt[0][jt][e] = 0.0f; }
        } else {
            const float* zs = RWQ + (size_t)u * 4096;
#pragma unroll
            for (int jt = 0; jt < 4; ++jt)
#pragma unroll
                for (int e = 0; e < 4; ++e) zt[0][jt][e] = zs[(16 * jt + 4 * q + e) * 64 + 16 * wq + m];
        }
        u32x4 pfX[2], pfL[2];
        const size_t rseg = (size_t)b * T + seg * RW_SEG;
#define RW_FETCH(t0c) do { const bool first = (seg == 0 && (t0c) == 0); \
            _Pragma("unroll") for (int i = 0; i < 2; ++i) { const int j = gtid + 256 * i; const int rw = j / 24, cc = j - rw * 24; const bool ok = (j < 408) && !(first && rw == 0); \
                pfX[i] = ok ? *(const u32x4*)(P + (rseg + (t0c) + rw - 1) * AB_LD + RWO + (cc >> 3) * 1024 + hh * 64 + 8 * (cc & 7)) : (u32x4){0u, 0u, 0u, 0u}; } \
            _Pragma("unroll") for (int i = 0; i < 2; ++i) { const int j = gtid + 256 * i; if (j < NLP) { const int arr = j >> 7, rem = j & 127, tt = rem >> 3, c8 = rem & 7; \
                const bf16_t* src = (arr == 0) ? LD + (rseg + (t0c) + tt) * 1024 + hh * 64 + 8 * c8 : ((arr == 1) ? AG + (rseg + (t0c) + tt) * 1024 + hh * 64 + 8 * c8 : O + (rseg + (t0c) + tt) * D + 1024 + hh * 64 + 8 * c8); \
                pfL[i] = *(const u32x4*)src; } } } while (0)
        RW_FETCH(0);
        for (int chunk = 0; chunk < RW_NCH; ++chunk) {
            const int t0 = seg * RW_SEG + chunk * 16; const size_t row0 = (size_t)b * T + t0;
#pragma unroll
            for (int i = 0; i < 2; ++i) { const int j = gtid + 256 * i; if (j < 408) *(MK_LAS u32x4*)(gl + RW_RAWX + j * 16) = pfX[i]; if (j < NLP) *(MK_LAS u32x4*)(gl + RW_RAWL + j * 16) = pfL[i]; }
            if (chunk < RW_NCH - 1) RW_FETCH((chunk + 1) * 16);
            __syncthreads();
            if (MODE == 1 && chunk > 0 && valid && gtid < 128) *(u32x4*)(O + (row0 - 16 + (gtid >> 3)) * D + 1024 + hh * 64 + 8 * (gtid & 7)) = *(const MK_LAS u32x4*)(gl + RW_OUT + gtid * 16);
            float rr[4], km[4], vv[4], ld[4], ag[4], kkr[4], ga[4];
            {   const MK_LAS unsigned char* rx = gl + RW_RAWX + (4 * q) * 384 + (16 * wq + m) * 2;
                float pr = bf2f(*(const MK_LAS bf16_t*)(rx)), pk = bf2f(*(const MK_LAS bf16_t*)(rx + 128)), pv = bf2f(*(const MK_LAS bf16_t*)(rx + 256));
#pragma unroll
                for (int e = 0; e < 4; ++e) { const MK_LAS unsigned char* rc = rx + (e + 1) * 384; const MK_LAS unsigned char* rl = gl + RW_RAWL + (4 * q + e) * 128 + (16 * wq + m) * 2;
                    const float cr = bf2f(*(const MK_LAS bf16_t*)(rc)), ck = bf2f(*(const MK_LAS bf16_t*)(rc + 128)), cv = bf2f(*(const MK_LAS bf16_t*)(rc + 256));
                    rr[e] = cr + (pr - cr) * mu_r; const float kx = ck + (pk - ck) * mu_k; vv[e] = cv + (pv - cv) * mu_v; pr = cr; pk = ck; pv = cv;
                    ld[e] = bf2f(*(const MK_LAS bf16_t*)(rl)); ag[e] = bf2f(*(const MK_LAS bf16_t*)(rl + 2048)); ga[e] = (MODE == 1) ? bf2f(*(const MK_LAS bf16_t*)(rl + 4096)) : 0.f;
                    kkr[e] = kx * k_k; km[e] = kx * (1.0f + (ag[e] - 1.0f) * k_a); }
            }
            if (!(ABL & 16)) {   MK_LAS float* red = (MK_LAS float*)(gl + RW_RED);
#pragma unroll
                for (int e = 0; e < 4; ++e) { const float ss = red16(kkr[e] * kkr[e]); const float sb = red16(rr[e] * km[e] * r_k);
                    if (m == 0) { red[wq * 16 + 4 * q + e] = ss; red[64 + wq * 16 + 4 * q + e] = sb; } } }
            __syncthreads();
            float bon[4] = {0.f, 0.f, 0.f, 0.f};
            if (!(ABL & 8)) {   const MK_LAS float* red = (const MK_LAS float*)(gl + RW_RED);
                float cl[4], run = 0.f;
#pragma unroll
                for (int e = 0; e < 4; ++e) { run += ld[e]; cl[e] = run; }
                { float pre = 0.f; const float x1 = __shfl_up(run, 16), x2 = __shfl_up(run, 32), x3 = __shfl_up(run, 48); if (q >= 1) pre += x1; if (q >= 2) pre += x2; if (q >= 3) pre += x3;
#pragma unroll
                  for (int e = 0; e < 4; ++e) cl[e] += pre; }
                const float CL = __shfl(cl[3], 48 + m);
                f32x4 bc4, kc4, v4;
#pragma unroll
                for (int e = 0; e < 4; ++e) { const int tt = 4 * q + e;
                    const float ssum = red[tt] + red[16 + tt] + red[32 + tt] + red[48 + tt]; bon[e] = red[64 + tt] + red[80 + tt] + red[96 + tt] + red[112 + tt];
                    const float kk = kkr[e] / fmaxf(sqrtf(ssum), 1e-12f), av = -kk, bv = kk * ag[e];
                    const float eW = __expf(cl[e]), eWp = __expf(cl[e] - ld[e]), eInv = __expf(-cl[e]), eC = __expf(CL - cl[e]);
                    const int off = tt * 144 + (16 * wq + m) * 2;
                    *(MK_LAS bf16_t*)(gl + RW_AT + off) = (bf16_t)(cvtpk(av * eWp, 0.f) & 0xffffu); *(MK_LAS bf16_t*)(gl + RW_RT + off) = (bf16_t)(cvtpk(rr[e] * eW, 0.f) & 0xffffu);
                    *(MK_LAS bf16_t*)(gl + RW_BH + off) = (bf16_t)(cvtpk(bv * eInv, 0.f) & 0xffffu); *(MK_LAS bf16_t*)(gl + RW_KH + off) = (bf16_t)(cvtpk(km[e] * eInv, 0.f) & 0xffffu);
                    bc4[e] = bv * eC; kc4[e] = km[e] * eC; v4[e] = vv[e]; }
                const int offT = (16 * wq + m) * 40 + 4 * q * 2;
                *(MK_LAS u32x2*)(gl + RW_BCT + offT) = pk4(bc4); *(MK_LAS u32x2*)(gl + RW_KCT + offT) = pk4(kc4); *(MK_LAS u32x2*)(gl + RW_VT + offT) = pk4(v4);
                if (q == 3) *(MK_LAS float*)(gl + RW_WC + (16 * wq + m) * 4) = __expf(CL);
            }
            __syncthreads();
            if (!(ABL & 4)) {   const int xo = (wq < 2) ? RW_AT : RW_RT, yo = (wq & 1) ? RW_KH : RW_BH; f32x4 acc = (f32x4){0.f, 0.f, 0.f, 0.f};
#pragma unroll
                for (int s = 0; s < 2; ++s) acc = MFMA16(*(const MK_LAS bf16x8*)(gl + xo + m * 144 + (32 * s + 8 * q) * 2), *(const MK_LAS bf16x8*)(gl + yo + m * 144 + (32 * s + 8 * q) * 2), acc);
#pragma unroll
                for (int e = 0; e < 4; ++e) { const int tt = 4 * q + e; const bool keep = (wq < 2) ? (m < tt) : (m <= tt); const float x = keep ? acc[e] : 0.f;
                    *(MK_LAS bf16_t*)(gl + RW_AM + wq * 768 + tt * 48 + m * 2) = (bf16_t)(cvtpk(x, 0.f) & 0xffffu);
                    if (wq == 0) *(MK_LAS float*)(gl + RW_NF + (tt * 16 + m) * 4) = x; } }
            __syncthreads();
#define RW_APERM(base, s) mk8(*(const MK_LAS u32x2*)(gl + (base) + m * 144 + (32 * (s) + 4 * q) * 2), *(const MK_LAS u32x2*)(gl + (base) + m * 144 + (32 * (s) + 16 + 4 * q) * 2))
#define RW_A16(base) mk8z(*(const MK_LAS u32x2*)(gl + (base) + m * 48 + 4 * q * 2))
            f32x4 y = (f32x4){0.f, 0.f, 0.f, 0.f}; f32x4 rhs[NCT];
            if (!(ABL & 2)) {
                const bf16x8 vf = mk8z(*(const MK_LAS u32x2*)(gl + RW_VT + (16 * wq + m) * 40 + 4 * q * 2));
                const bf16x8 at0 = RW_APERM(RW_AT, 0), at1 = RW_APERM(RW_AT, 1);
#pragma unroll
                for (int ct = 0; ct < NCT; ++ct) { const bool hasv = (MODE == 1) || (ct == 0);
                    const bf16x8 zp0 = mk8(pk4(zt[ct][0]), pk4(zt[ct][1])), zp1 = mk8(pk4(zt[ct][2]), pk4(zt[ct][3]));
                    f32x4 r4 = (f32x4){0.f, 0.f, 0.f, 0.f};
                    r4 = MFMA16(at0, zp0, r4); r4 = MFMA16(at1, zp1, r4);
                    if (hasv) r4 = MFMA16(RW_A16(RW_AM + 768), vf, r4);
                    rhs[ct] = r4;
                    if (MODE == 1) { y = MFMA16(RW_APERM(RW_RT, 0), zp0, y); y = MFMA16(RW_APERM(RW_RT, 1), zp1, y); y = MFMA16(RW_A16(RW_AM + 3 * 768), vf, y); }
#pragma unroll
                    for (int jt = 0; jt < 4; ++jt) { const f32x4 wc4 = *(const MK_LAS f32x4*)(gl + RW_WC + (16 * jt + 4 * q) * 4); f32x4 z = zt[ct][jt] * wc4;
                        if (hasv) z = MFMA16(mk8z(*(const MK_LAS u32x2*)(gl + RW_KCT + (16 * jt + m) * 40 + 4 * q * 2)), vf, z);
                        zt[ct][jt] = z; } }
            }
            if (!(ABL & 1) && wq == 0 && q == 0) {
                float tc[16];
                if (MODE == 0) { tc[0] = (m == 0) ? 1.f : 0.f;
#pragma unroll
                    for (int t = 1; t < 16; ++t) { float acc = 0.f;
#pragma unroll
                        for (int j = 0; j < t; ++j) acc += *(const MK_LAS float*)(gl + RW_NF + (t * 16 + j) * 4) * tc[j];
                        tc[t] = (m < t) ? acc : ((m == t) ? 1.f : 0.f); }
                } else {
                float ac[16];
#pragma unroll
                for (int t = 0; t < 16; ++t) ac[t] = 0.f;
                tc[0] = (m == 0) ? 1.f : 0.f;
#pragma unroll
                for (int j = 0; j < 15; ++j) {
#pragma unroll
                    for (int t = j + 1; t < 16; ++t) ac[t] += *(const MK_LAS float*)(gl + RW_NF + (t * 16 + j) * 4) * tc[j];
                    tc[j + 1] = (m < j + 1) ? ac[j + 1] : ((m == j + 1) ? 1.f : 0.f); }
                }
#pragma unroll
                for (int t = 0; t < 16; ++t) *(MK_LAS bf16_t*)(gl + RW_TM + t * 48 + m * 2) = (bf16_t)(cvtpk(tc[t], 0.f) & 0xffffu);
            }
            __syncthreads();
            if (!(ABL & 2)) {
                const bf16x8 tmf = RW_A16(RW_TM);
#pragma unroll
                for (int ct = 0; ct < NCT; ++ct) {
                    f32x4 uu = (f32x4){0.f, 0.f, 0.f, 0.f};
                    uu = MFMA16(tmf, mk8z(pk4(rhs[ct])), uu);
                    const bf16x8 ub8 = mk8z(pk4(uu));
                    if (MODE == 1) y = MFMA16(RW_A16(RW_AM + 2 * 768), ub8, y);
#pragma unroll
                    for (int jt = 0; jt < 4; ++jt) zt[ct][jt] = MFMA16(mk8z(*(const MK_LAS u32x2*)(gl + RW_BCT + (16 * jt + m) * 40 + 4 * q * 2)), ub8, zt[ct][jt]); }
            }
#undef RW_APERM
#undef RW_A16
            if (MODE == 1 && !(ABL & 32)) {
                MK_LAS float* red = (MK_LAS float*)(gl + RW_RED);
#pragma unroll
                for (int e = 0; e < 4; ++e) { const float s1 = red16(y[e]), s2 = red16(y[e] * y[e]); if (m == 0) { red[128 + wq * 16 + 4 * q + e] = s1; red[192 + wq * 16 + 4 * q + e] = s2; } }
                __syncthreads();
#pragma unroll
                for (int e = 0; e < 4; ++e) { const int tt = 4 * q + e;
                    const float s1 = red[128 + tt] + red[144 + tt] + red[160 + tt] + red[176 + tt], s2 = red[192 + tt] + red[208 + tt] + red[224 + tt] + red[240 + tt];
                    const float mean = s1 * (1.0f / 64.0f), var = fmaxf(s2 * (1.0f / 64.0f) - mean * mean, 0.f), rstd = rsqrtf(var + 64e-5f);
                    const float outv = ((y[e] - mean) * rstd * ln_w + ln_b + bon[e] * vv[e]) * ga[e];
                    *(MK_LAS bf16_t*)(gl + RW_OUT + tt * 128 + (16 * wq + m) * 2) = (bf16_t)(cvtpk(outv, 0.f) & 0xffffu); }
            }
        }
#undef RW_FETCH
        if (MODE == 1) { __syncthreads();
            if (valid && gtid < 128) *(u32x4*)(O + ((size_t)b * T + seg * RW_SEG + (RW_SEG - 16) + (gtid >> 3)) * D + 1024 + hh * 64 + 8 * (gtid & 7)) = *(const MK_LAS u32x4*)(gl + RW_OUT + gtid * 16); }
        if (MODE == 0 && valid) {
#pragma unroll
            for (int ct = 0; ct < NCT; ++ct) { float* dst = (ct == 0 ? RWQ : RWM) + (size_t)u * 4096;
#pragma unroll
                for (int jt = 0; jt < 4; ++jt)
#pragma unroll
                    for (int e = 0; e < 4; ++e) dst[(16 * jt + 4 * q + e) * 64 + 16 * wq + m] = zt[ct][jt][e]; } }
        __syncthreads();
    }
}

__device__ __forceinline__ void ph_rwkv_chain(const Args& a) {
    const int tid = MK_TID, lane = tid & 63, wave = tid >> 6, grp = wave >> 2, wq = wave & 3, m = lane & 15, q = lane >> 4;
    const int stream = (int)blockIdx.x * 2 + grp; if (stream >= 32) return;
    float* RWQ = (float*)(a.ws + WS_RWQ); const float* RWM = (const float*)(a.ws + WS_RWM);
    f32x4 zt[4];
#pragma unroll
    for (int jt = 0; jt < 4; ++jt) zt[jt] = (f32x4){0.f, 0.f, 0.f, 0.f};
    f32x4 mx[4][2][2], qn[4];
#define RB_LOAD(sg) do { const size_t u_ = (size_t)stream * RW_NSEG + (sg); const float* ms_ = RWM + u_ * 4096; const float* qs_ = RWQ + u_ * 4096; \
        _Pragma("unroll") for (int jt = 0; jt < 4; ++jt) { _Pragma("unroll") for (int s = 0; s < 2; ++s) { const float* mr = ms_ + (16 * jt + m) * 64 + 32 * s + 4 * q; mx[jt][s][0] = *(const f32x4*)mr; mx[jt][s][1] = *(const f32x4*)(mr + 16); } \
            _Pragma("unroll") for (int e = 0; e < 4; ++e) qn[jt][e] = qs_[(16 * jt + 4 * q + e) * 64 + 16 * wq + m]; } } while (0)
    RB_LOAD(0);
    for (int seg = 0; seg < RW_NSEG; ++seg) { const size_t u = (size_t)stream * RW_NSEG + seg; float* qs = RWQ + u * 4096;
        f32x4 zn[4]; bf16x8 mh[4][2], ml[4][2];
#pragma unroll
        for (int jt = 0; jt < 4; ++jt) { zn[jt] = qn[jt];
#pragma unroll
            for (int s = 0; s < 2; ++s) { const f32x4 x0 = mx[jt][s][0], x1 = mx[jt][s][1]; const u32x2 a0 = pk4(x0), a1 = pk4(x1); f32x4 h0, h1;
                h0[0] = bflo(a0.x); h0[1] = bfhi(a0.x); h0[2] = bflo(a0.y); h0[3] = bfhi(a0.y); h1[0] = bflo(a1.x); h1[1] = bfhi(a1.x); h1[2] = bflo(a1.y); h1[3] = bfhi(a1.y);
                mh[jt][s] = mk8(a0, a1); ml[jt][s] = mk8(pk4(x0 - h0), pk4(x1 - h1)); } }
#pragma unroll
        for (int jt = 0; jt < 4; ++jt)
#pragma unroll
            for (int e = 0; e < 4; ++e) qs[(16 * jt + 4 * q + e) * 64 + 16 * wq + m] = zt[jt][e];
        if (seg == RW_NSEG - 1) break;
        if (seg < RW_NSEG - 2) RB_LOAD(seg + 1);
        bf16x8 zh[2], zl[2];
#pragma unroll
        for (int s = 0; s < 2; ++s) { f32x4 h0, h1; const u32x2 a0 = pk4(zt[2 * s]), a1 = pk4(zt[2 * s + 1]);
            h0[0] = bflo(a0.x); h0[1] = bfhi(a0.x); h0[2] = bflo(a0.y); h0[3] = bfhi(a0.y); h1[0] = bflo(a1.x); h1[1] = bfhi(a1.x); h1[2] = bflo(a1.y); h1[3] = bfhi(a1.y);
            zh[s] = mk8(a0, a1); zl[s] = mk8(pk4(zt[2 * s] - h0), pk4(zt[2 * s + 1] - h1)); }
#pragma unroll
        for (int jt = 0; jt < 4; ++jt)
#pragma unroll
            for (int s = 0; s < 2; ++s) { zn[jt] = MFMA16(mh[jt][s], zh[s], zn[jt]); zn[jt] = MFMA16(mh[jt][s], zl[s], zn[jt]); zn[jt] = MFMA16(ml[jt][s], zh[s], zn[jt]); }
#pragma unroll
        for (int jt = 0; jt < 4; ++jt) zt[jt] = zn[jt];
    }
#undef RB_LOAD
}
constexpr int HG_Q1 = 0, HG_Q3 = 17408, HG_K3 = 34816, HG_K2T = 78336, HG_VT = 96768, HG_ATT = 115200, HG_TOT = 124416, HG_STAT = 126464, HG_DEC = 128512, HG_END = 129024;
static_assert(HG_END <= LDS_RING, "hgrn2 lds");
constexpr int HG_RAW = HG_Q3;
static_assert(HG_RAW + 64 * 768 <= HG_K2T, "hgrn2 raw staging");
template <int MODE>
__device__ __forceinline__ void ph_hgrn2(const Args& a, MK_LAS unsigned char* lds, int first_block = 0, unsigned* qhead = nullptr) {
    const int tid = MK_TID, lane = tid & 63, wave = tid >> 6, m = lane & 15, q = lane >> 4, chn = tid & 127, part = tid >> 7;
    const bf16_t* P = (const bf16_t*)(a.ws + WS_P); bf16_t* O = (bf16_t*)(a.ws + WS_O);
    float* HGS = (float*)(a.ws + WS_HGS); float* HGD = (float*)(a.ws + WS_HGD);
    if ((int)blockIdx.x < first_block) return;
    constexpr int NU = 1024; const int G = (int)gridDim.x - first_block, nit = (NU + G - 1) / G;
    for (int it = 0; qhead != nullptr || it < nit; ++it) {
        int u = it * G + (int)blockIdx.x - first_block;
        if (qhead != nullptr) { MK_LAS unsigned* slot = (MK_LAS unsigned*)(lds + LDS_MISC + 1024); __syncthreads(); if (tid == 0) *slot = __hip_atomic_fetch_add(qhead, 1u, __ATOMIC_RELAXED, __HIP_MEMORY_SCOPE_AGENT); __syncthreads(); u = (int)*slot; if (u >= NU) break; }
        const bool valid = u < NU; if (!valid) u = NU - 1;
        const int stream = u >> 6, seg = u & 63, b = stream >> 3, hh = stream & 7, cg = hh * 128 + chn;
        float lb; { const float l0 = a.in[I_HGLB][cg], l1 = a.in[I_HGLB][1024 + cg], mx = fmaxf(l0, l1), e0 = __expf(l0 - mx), e1 = __expf(l1 - mx); lb = e0 / (e0 + e1); }
        const int dvc = hh * 128 + 16 * wave + m;
        const float nw = a.in[I_HGNW][dvc];
        f32x4 st[8];
        if (MODE == 0) {
#pragma unroll
            for (int kt = 0; kt < 8; ++kt) st[kt] = (f32x4){0.f, 0.f, 0.f, 0.f};
        } else { int lofs = (4 * q) * 128 + 16 * wave + m; asm volatile("" : "+v"(lofs));
            const float* ss = HGS + (size_t)u * 16384 + lofs;
#pragma unroll
            for (int kt = 0; kt < 8; ++kt)
#pragma unroll
                for (int e = 0; e < 4; ++e) st[kt][e] = ss[(16 * kt + e) * 128]; }
        float segsum = 0.f;
        constexpr int NPT = (MODE == 1) ? 48 : 32, NPF = 64 * NPT / 512; u32x4 pf[NPF];
        const bf16_t* Pseg = P + ((size_t)b * T + seg * 256) * AB_LD + hh * 128;
#define HG_FETCH(t0c) do { int tq_ = tid; asm volatile("" : "+v"(tq_)); _Pragma("unroll") for (int i = 0; i < NPF; ++i) { const int j = tq_ + 512 * i, tt = j / NPT, rem = j - tt * NPT, arr = (rem >> 4) + ((MODE == 1) ? 0 : 1), c16 = rem & 15; \
            pf[i] = *(const u32x4*)(Pseg + (size_t)((t0c) + tt) * AB_LD + arr * 1024 + 8 * c16); } } while (0)
        HG_FETCH(0);
        for (int chunk = 0; chunk < 4; ++chunk) {
            const int t0 = seg * 256 + chunk * 64; const size_t row0 = (size_t)b * T + t0;
            { int tq_ = tid; asm volatile("" : "+v"(tq_));
#pragma unroll
            for (int i = 0; i < NPF; ++i) { const int j = tq_ + 512 * i, tt = j / NPT, rem = j - tt * NPT, arr = (rem >> 4) + ((MODE == 1) ? 0 : 1), c16 = rem & 15;
                *(MK_LAS u32x4*)(lds + HG_RAW + tt * 768 + arr * 256 + c16 * 16) = pf[i]; } }
            __syncthreads();
            float cl[16], kd[16], qs[16];
            {   float run = 0.f;
#pragma unroll
                for (int x = 0; x < 16; ++x) { const MK_LAS unsigned char* rw = lds + HG_RAW + (16 * part + x) * 768 + chn * 2; const float fl = bf2f(*(const MK_LAS bf16_t*)(rw + 256));
                    const float f = lb + (1.0f - lb) * fsigmoid(fl); run += __logf(f); cl[x] = run; kd[x] = 1.0f - f;
                    if (MODE == 1) qs[x] = siluf(bf2f(*(const MK_LAS bf16_t*)rw)); }
                *(MK_LAS float*)(lds + HG_TOT + (part * 128 + chn) * 4) = run; }
            u32x4 vw[2];
            {   float vv[16];
#pragma unroll
                for (int x = 0; x < 16; ++x) vv[x] = bf2f(*(const MK_LAS bf16_t*)(lds + HG_RAW + (16 * part + x) * 768 + 512 + chn * 2));
                vw[0].x = cvtpk(vv[0], vv[1]); vw[0].y = cvtpk(vv[2], vv[3]); vw[0].z = cvtpk(vv[4], vv[5]); vw[0].w = cvtpk(vv[6], vv[7]);
                vw[1].x = cvtpk(vv[8], vv[9]); vw[1].y = cvtpk(vv[10], vv[11]); vw[1].z = cvtpk(vv[12], vv[13]); vw[1].w = cvtpk(vv[14], vv[15]); }
            __syncthreads();
            {   const float t0s = *(const MK_LAS float*)(lds + HG_TOT + (0 * 128 + chn) * 4), t1s = *(const MK_LAS float*)(lds + HG_TOT + (1 * 128 + chn) * 4), t2s = *(const MK_LAS float*)(lds + HG_TOT + (2 * 128 + chn) * 4), t3s = *(const MK_LAS float*)(lds + HG_TOT + (3 * 128 + chn) * 4);
                const float r1 = t0s, r2 = t0s + t1s, r3 = r2 + t2s, Bc = r3 + t3s;
                const float rp = (part == 0) ? 0.f : (part == 1 ? r1 : (part == 2 ? r2 : r3));
                if (part == 0) { *(MK_LAS float*)(lds + HG_DEC + chn * 4) = __expf(Bc); segsum += Bc; }
                float k2[16], kb[16];
                if (MODE == 1) { const float eB = __expf(Bc - rp);
#pragma unroll
                    for (int x = 0; x < 16; ++x) { kb[x] = kd[x] * __expf(-cl[x]); k2[x] = kb[x] * eB; }
                } else {
#pragma unroll
                    for (int x = 0; x < 16; ++x) k2[x] = kd[x] * __expf(Bc - (rp + cl[x])); }
                u32x4 kw[2];
                kw[0].x = cvtpk(k2[0], k2[1]); kw[0].y = cvtpk(k2[2], k2[3]); kw[0].z = cvtpk(k2[4], k2[5]); kw[0].w = cvtpk(k2[6], k2[7]);
                kw[1].x = cvtpk(k2[8], k2[9]); kw[1].y = cvtpk(k2[10], k2[11]); kw[1].z = cvtpk(k2[12], k2[13]); kw[1].w = cvtpk(k2[14], k2[15]);
                *(MK_LAS u32x4*)(lds + HG_K2T + chn * 144 + part * 32) = kw[0]; *(MK_LAS u32x4*)(lds + HG_K2T + chn * 144 + part * 32 + 16) = kw[1];
                *(MK_LAS u32x4*)(lds + HG_VT + chn * 144 + part * 32) = vw[0]; *(MK_LAS u32x4*)(lds + HG_VT + chn * 144 + part * 32 + 16) = vw[1];
                if (MODE == 1) {
                    const float eR = __expf(rp);
#pragma unroll
                    for (int x = 0; x < 16; ++x) { const int tt = 16 * part + x; const float q3 = qs[x] * __expf(cl[x]);
                        *(MK_LAS bf16_t*)(lds + HG_Q1 + tt * 272 + chn * 2) = (bf16_t)(cvtpk(q3 * eR, 0.f) & 0xffffu);
                        *(MK_LAS bf16_t*)(lds + HG_Q3 + tt * 272 + chn * 2) = (bf16_t)(cvtpk(q3, 0.f) & 0xffffu);
                        if ((x & 3) == 3) __builtin_amdgcn_sched_barrier(0); }
                    for (int i2 = part; i2 < 4; ++i2) { const float ri = (i2 == 0) ? 0.f : (i2 == 1 ? r1 : (i2 == 2 ? r2 : r3)); const int off = (i2 == 0) ? 0 : (i2 == 1 ? 16 : (i2 == 2 ? 48 : 96));
                        const float eV = __expf(ri - rp);
#pragma unroll
                        for (int x = 0; x < 16; ++x) { *(MK_LAS bf16_t*)(lds + HG_K3 + (off + 16 * part + x) * 272 + chn * 2) = (bf16_t)(cvtpk(kb[x] * eV, 0.f) & 0xffffu);
                            if ((x & 3) == 3) __builtin_amdgcn_sched_barrier(0); } }
                }
            }
            __syncthreads();
            if (chunk < 3) HG_FETCH((chunk + 1) * 64);
            f32x4 o[4];
            if (MODE == 1) {
#pragma unroll
                for (int x = 0; x < 2; ++x) { const int blk = wave * 2 + x, bi = blk >> 2, bj = blk & 3; f32x4 acc = (f32x4){0.f, 0.f, 0.f, 0.f};
                    if (bj <= bi) { const int off = (bi == 0) ? 0 : (bi == 1 ? 16 : (bi == 2 ? 48 : 96));
#pragma unroll
                        for (int ks = 0; ks < 4; ++ks) acc = MFMA16(*(const MK_LAS bf16x8*)(lds + HG_Q3 + (16 * bi + m) * 272 + (32 * ks + 8 * q) * 2), *(const MK_LAS bf16x8*)(lds + HG_K3 + (off + 16 * bj + m) * 272 + (32 * ks + 8 * q) * 2), acc); }
#pragma unroll
                    for (int e = 0; e < 4; ++e) { const bool keep = (bj < bi) || (bj == bi && m <= 4 * q + e);
                        *(MK_LAS bf16_t*)(lds + HG_ATT + (16 * bi + 4 * q + e) * 144 + (16 * bj + m) * 2) = (bf16_t)(cvtpk(keep ? acc[e] : 0.f, 0.f) & 0xffffu); } }
                __syncthreads();
                bf16x8 sp[4];
#pragma unroll
                for (int s = 0; s < 4; ++s) sp[s] = mk8(pk4(st[2 * s]), pk4(st[2 * s + 1]));
#pragma unroll
                for (int ti = 0; ti < 4; ++ti) { f32x4 acc = (f32x4){0.f, 0.f, 0.f, 0.f};
#pragma unroll
                    for (int s = 0; s < 4; ++s) acc = MFMA16(mk8(*(const MK_LAS u32x2*)(lds + HG_Q1 + (16 * ti + m) * 272 + (32 * s + 4 * q) * 2), *(const MK_LAS u32x2*)(lds + HG_Q1 + (16 * ti + m) * 272 + (32 * s + 16 + 4 * q) * 2)), sp[s], acc);
#pragma unroll
                    for (int ks = 0; ks < 2; ++ks) if (ks <= (ti >> 1)) acc = MFMA16(*(const MK_LAS bf16x8*)(lds + HG_ATT + (16 * ti + m) * 144 + (32 * ks + 8 * q) * 2), *(const MK_LAS bf16x8*)(lds + HG_VT + (16 * wave + m) * 144 + (32 * ks + 8 * q) * 2), acc);
                    o[ti] = acc; }
            }
            {   const bf16x8 vf0 = *(const MK_LAS bf16x8*)(lds + HG_VT + (16 * wave + m) * 144 + (8 * q) * 2), vf1 = *(const MK_LAS bf16x8*)(lds + HG_VT + (16 * wave + m) * 144 + (32 + 8 * q) * 2);
#pragma unroll
                for (int kt = 0; kt < 8; ++kt) { const f32x4 d4 = *(const MK_LAS f32x4*)(lds + HG_DEC + (16 * kt + 4 * q) * 4); f32x4 z = st[kt] * d4;
                    z = MFMA16(*(const MK_LAS bf16x8*)(lds + HG_K2T + (16 * kt + m) * 144 + (8 * q) * 2), vf0, z);
                    z = MFMA16(*(const MK_LAS bf16x8*)(lds + HG_K2T + (16 * kt + m) * 144 + (32 + 8 * q) * 2), vf1, z); st[kt] = z; } }
            if (MODE == 1) {
#pragma unroll
                for (int ti = 0; ti < 4; ++ti)
#pragma unroll
                    for (int e = 0; e < 4; ++e) { const float s2 = red16(o[ti][e] * o[ti][e]); if (m == 0) *(MK_LAS float*)(lds + HG_STAT + (wave * 64 + 16 * ti + 4 * q + e) * 4) = s2; }
                __syncthreads();
#pragma unroll
                for (int ti = 0; ti < 4; ++ti)
#pragma unroll
                    for (int e = 0; e < 4; ++e) { const int tt = 16 * ti + 4 * q + e; float s2 = 0.f;
#pragma unroll
                        for (int w2 = 0; w2 < 8; ++w2) s2 += *(const MK_LAS float*)(lds + HG_STAT + (w2 * 64 + tt) * 4);
                        const float rstd = rsqrtf(s2 * (1.0f / 128.0f) + NORM_EPS);
                        *(MK_LAS bf16_t*)(lds + HG_Q1 + tt * 256 + (16 * wave + m) * 2) = (bf16_t)(cvtpk(o[ti][e] * rstd * nw, 0.f) & 0xffffu); }
                __syncthreads();
#pragma unroll
                for (int i = 0; i < 2; ++i) { const int pc = tid + 512 * i, tt = pc >> 4, c8 = pc & 15; const size_t row = row0 + tt;
                    const u32x4 ov = *(const MK_LAS u32x4*)(lds + HG_Q1 + tt * 256 + c8 * 16), gv = *(const u32x4*)(P + row * AB_LD + 3072 + hh * 128 + 8 * c8);
                    u32x4 w; w.x = cvtpk(bflo(ov.x) * siluf(bflo(gv.x)), bfhi(ov.x) * siluf(bfhi(gv.x))); w.y = cvtpk(bflo(ov.y) * siluf(bflo(gv.y)), bfhi(ov.y) * siluf(bfhi(gv.y)));
                    w.z = cvtpk(bflo(ov.z) * siluf(bflo(gv.z)), bfhi(ov.z) * siluf(bfhi(gv.z))); w.w = cvtpk(bflo(ov.w) * siluf(bflo(gv.w)), bfhi(ov.w) * siluf(bfhi(gv.w)));
                    if (valid) *(u32x4*)(O + row * D + hh * 128 + 8 * c8) = w; }
            }
            __syncthreads();
        }
#undef HG_FETCH
        if (MODE == 0 && valid) { int lofs = (4 * q) * 128 + 16 * wave + m; asm volatile("" : "+v"(lofs)); float* ss = HGS + (size_t)u * 16384 + lofs;
#pragma unroll
            for (int kt = 0; kt < 8; ++kt)
#pragma unroll
                for (int e = 0; e < 4; ++e) ss[(16 * kt + e) * 128] = st[kt][e];
            if (part == 0) HGD[(size_t)u * 128 + chn] = __expf(segsum); }
    }
}
__device__ __forceinline__ void ph_hgrn2_chain(const Args& a, int first_block) {
    float* HGS = (float*)(a.ws + WS_HGS); const float* HGD = (const float*)(a.ws + WS_HGD);
    const int gid = ((int)blockIdx.x - first_block) * 512 + MK_TID, NG = ((int)gridDim.x - first_block) * 512;
    for (int idx = gid; idx < 16 * 16384; idx += NG) { const int stream = idx >> 14, el = idx & 16383, dk = el >> 7; float run = 0.f;
        for (int c0 = 0; c0 < 64; c0 += 16) { float tv[16], dv[16];
#pragma unroll
            for (int i = 0; i < 16; ++i) { const size_t u = (size_t)stream * 64 + c0 + i; tv[i] = HGS[u * 16384 + el]; dv[i] = HGD[u * 128 + dk]; }
#pragma unroll
            for (int i = 0; i < 16; ++i) { const size_t u = (size_t)stream * 64 + c0 + i; HGS[u * 16384 + el] = run; run = dv[i] * run + tv[i]; } } }
}
constexpr size_t WS_S5BBT = 11 * MiB, WS_S5CP = 11 * MiB + 512 * 1024, WS_S5AB = 12 * MiB, WS_S5AL = 12 * MiB + 64 * 1024, WS_S5X = WS_SCR; constexpr size_t WS_S5Q = 65536 + 512;
__device__ __forceinline__ void s5_param_prep(const Args& a) {
    const int gid = blockIdx.x * 512 + MK_TID;
    if (gid >= 64 * 64) return;
    const int g = gid >> 6, p = gid & 63;
    const float lr = fminf(a.in[I_S5LR][gid], -1e-4f), li = a.in[I_S5LI][gid], dt = expf(a.in[I_S5DT][g]);
    const float mag = expf(lr * dt), abr = mag * cosf(li * dt), abi = mag * sinf(li * dt);
    const float nr = abr - 1.0f, ni = abi, den = lr * lr + li * li, zr = (nr * lr + ni * li) / den, zi = (ni * lr - nr * li) / den;
    float* AB = (float*)(a.ws + WS_S5AB); float* AL = (float*)(a.ws + WS_S5AL); bf16_t* BBT = (bf16_t*)(a.ws + WS_S5BBT); bf16_t* CP = (bf16_t*)(a.ws + WS_S5CP);
    AB[gid * 2] = abr; AB[gid * 2 + 1] = abi;
    float pr = abr, pi = abi;
#pragma unroll
    for (int i = 0; i < 8; ++i) { const float nr2 = pr * pr - pi * pi, ni2 = 2.0f * pr * pi; pr = nr2; pi = ni2; }
    AL[gid * 2] = pr; AL[gid * 2 + 1] = pi;
    for (int c = 0; c < 16; ++c) { const float br = a.in[I_S5BR][gid * 16 + c], bi = a.in[I_S5BI][gid * 16 + c];
        BBT[(g * 128 + p) * 16 + c] = (bf16_t)(cvtpk(zr * br - zi * bi, 0.f) & 0xffffu); BBT[(g * 128 + 64 + p) * 16 + c] = (bf16_t)(cvtpk(zr * bi + zi * br, 0.f) & 0xffffu);
        CP[(g * 16 + c) * 128 + p] = (bf16_t)(cvtpk(a.in[I_S5CR][(g * 16 + c) * 64 + p], 0.f) & 0xffffu); CP[(g * 16 + c) * 128 + 64 + p] = (bf16_t)(cvtpk(-a.in[I_S5CI][(g * 16 + c) * 64 + p], 0.f) & 0xffffu); }
}
template <int MODE_>
__device__ __forceinline__ void ph_s5(const Args& a, MK_LAS unsigned char* lds) {
    constexpr int MODE = (MODE_ >= 1) ? 1 : 0;
    const int tid = MK_TID, lane = tid & 63, wave = tid >> 6, m = lane & 15, q = lane >> 4, gw = blockIdx.x * 8 + wave, NGW = gridDim.x * 8;
    const bf16_t* P = (const bf16_t*)(a.ws + WS_P); bf16_t* Z = (bf16_t*)(a.ws + ((MODE_ >= 2) ? (WS_P + 360 * MiB) : WS_H)); float* SX = (float*)(a.ws + WS_S5X);
    const bf16_t* BBT = (const bf16_t*)(a.ws + WS_S5BBT); const bf16_t* CP = (const bf16_t*)(a.ws + WS_S5CP); const float* AB = (const float*)(a.ws + WS_S5AB);
    MK_LAS float* Lbu = (MK_LAS float*)(lds + wave * 12800); MK_LAS unsigned char* Lx = lds + wave * 12800 + 8448;
    const bf16x8 zero8 = (bf16x8){0, 0, 0, 0, 0, 0, 0, 0};
    if (MODE == 1 && MK_S5_ACQ) { __builtin_amdgcn_fence(__ATOMIC_ACQUIRE, "agent"); asm volatile("s_waitcnt vmcnt(0)" ::: "memory"); }
    unsigned* qhead = (unsigned*)(a.ws + WS_S5Q + ((MODE_ >= 2) ? 64 : 0));
    for (int u0 = gw;; u0 += NGW) {
        int u = u0;
        if (MODE == 1 && MK_S5_DYN) { unsigned c_ = 0u; if (lane == 0) c_ = __hip_atomic_fetch_add(qhead, 1u, __ATOMIC_RELAXED, __HIP_MEMORY_SCOPE_AGENT); u = __builtin_amdgcn_readfirstlane((int)c_); }
        if (u >= 8192) break;
        const int seg = u & 63, s = u >> 6, b = s >> 6, g = s & 63;
        bf16x8 bbf[8], cpf[4];
#pragma unroll
        for (int ct = 0; ct < 8; ++ct) { bbf[ct] = zero8; if (q < 2) bbf[ct] = (MODE == 1 && MK_S5_NTP) ? __builtin_nontemporal_load((const bf16x8*)(BBT + (g * 128 + 16 * ct + m) * 16 + 8 * q)) : *(const bf16x8*)(BBT + (g * 128 + 16 * ct + m) * 16 + 8 * q); }
        if (MODE == 1) {
#pragma unroll
            for (int ks = 0; ks < 4; ++ks) cpf[ks] = MK_S5_NTP ? __builtin_nontemporal_load((const bf16x8*)(CP + (g * 16 + m) * 128 + 32 * ks + 8 * q)) : *(const bf16x8*)(CP + (g * 16 + m) * 128 + 32 * ks + 8 * q); }
        const float abr = (MODE == 1 && MK_S5_NTP) ? __builtin_nontemporal_load(AB + (g * 64 + lane) * 2) : AB[(g * 64 + lane) * 2], abi = (MODE == 1 && MK_S5_NTP) ? __builtin_nontemporal_load(AB + (g * 64 + lane) * 2 + 1) : AB[(g * 64 + lane) * 2 + 1], dch = a.in[I_S5D][g * 16 + m];
        float xr = 0.f, xi = 0.f;
        if (MODE == 1) {
            const float alr = MK_S5_NTP ? __builtin_nontemporal_load((const float*)(a.ws + WS_S5AL) + (g * 64 + lane) * 2) : ((const float*)(a.ws + WS_S5AL))[(g * 64 + lane) * 2], ali = MK_S5_NTP ? __builtin_nontemporal_load((const float*)(a.ws + WS_S5AL) + (g * 64 + lane) * 2 + 1) : ((const float*)(a.ws + WS_S5AL))[(g * 64 + lane) * 2 + 1];
            for (int c0 = 0; c0 < ((MODE_ == 2) ? 0 : seg); c0 += 16) { float tr[16], ti[16]; const int n = (seg - c0) < 16 ? (seg - c0) : 16;
#pragma unroll
                for (int i = 0; i < 16; ++i) { const size_t uu = (size_t)s * 64 + c0 + (i < n ? i : 0); if (MODE_ == 4 || MK_S5_SC1) { tr[i] = __hip_atomic_load(SX + uu * 128 + lane, __ATOMIC_RELAXED, MK_S5_SCOPE); ti[i] = __hip_atomic_load(SX + uu * 128 + 64 + lane, __ATOMIC_RELAXED, MK_S5_SCOPE); } else { tr[i] = SX[uu * 128 + lane]; ti[i] = SX[uu * 128 + 64 + lane]; } }
#pragma unroll
                for (int i = 0; i < 16; ++i) if (i < n) { const float nxr = alr * xr - ali * xi + tr[i], nxi = alr * xi + ali * xr + ti[i]; xr = nxr; xi = nxi; } } }
        const size_t rowu = (size_t)b * T + seg * 256;
        bf16x8 ufn = zero8; if (q < 2) ufn = (MODE == 1 && MK_S5_NT) ? __builtin_nontemporal_load((const bf16x8*)(P + (rowu + m) * CD_LD + g * 16 + 8 * q)) : *(const bf16x8*)(P + (rowu + m) * CD_LD + g * 16 + 8 * q);
        for (int tile = 0; tile < 16; ++tile) {
            const size_t row0 = rowu + tile * 16;
            const bf16x8 uf = ufn;
            if (tile < 15 && q < 2) ufn = (MODE == 1 && MK_S5_NT) ? __builtin_nontemporal_load((const bf16x8*)(P + (row0 + 16 + m) * CD_LD + g * 16 + 8 * q)) : *(const bf16x8*)(P + (row0 + 16 + m) * CD_LD + g * 16 + 8 * q);
            float uvv[4];
            if (MODE == 1) {
#pragma unroll
                for (int e = 0; e < 4; ++e) uvv[e] = bf2f(MK_S5_NT ? __builtin_nontemporal_load(P + (row0 + 4 * q + e) * CD_LD + g * 16 + m) : P[(row0 + 4 * q + e) * CD_LD + g * 16 + m]); }
#pragma unroll
            for (int ct = 0; ct < 8; ++ct) { f32x4 acc = (f32x4){0.f, 0.f, 0.f, 0.f}; acc = MFMA16(uf, bbf[ct], acc);
#pragma unroll
                for (int e = 0; e < 4; ++e) Lbu[(4 * q + e) * 132 + 16 * ct + m] = acc[e]; }
            asm volatile("s_waitcnt lgkmcnt(0)" ::: "memory");
#pragma unroll
            for (int tt = 0; tt < 16; ++tt) { const float br = Lbu[tt * 132 + lane], bi = Lbu[tt * 132 + 64 + lane];
                const float nxr = abr * xr - abi * xi + br, nxi = abr * xi + abi * xr + bi; xr = nxr; xi = nxi;
                if (MODE == 1) { *(MK_LAS bf16_t*)(Lx + tt * 272 + lane * 2) = (bf16_t)(cvtpk(xr, 0.f) & 0xffffu); *(MK_LAS bf16_t*)(Lx + tt * 272 + (64 + lane) * 2) = (bf16_t)(cvtpk(xi, 0.f) & 0xffffu); } }
            asm volatile("s_waitcnt lgkmcnt(0)" ::: "memory");
            if (MODE == 1) { f32x4 y = (f32x4){0.f, 0.f, 0.f, 0.f};
#pragma unroll
                for (int ks = 0; ks < 4; ++ks) y = MFMA16(*(const MK_LAS bf16x8*)(Lx + m * 272 + (32 * ks + 8 * q) * 2), cpf[ks], y);
#pragma unroll
                for (int e = 0; e < 4; ++e) { const size_t row = row0 + 4 * q + e;
                    Z[row * 1024 + g * 16 + m] = (bf16_t)(cvtpk(gelu_tanh(y[e] + dch * uvv[e]), 0.f) & 0xffffu); }
                asm volatile("s_waitcnt lgkmcnt(0)" ::: "memory"); }
        }
        if (MODE == 0) { if (MK_S5_SC1ST) { __hip_atomic_store(SX + (size_t)u * 128 + lane, xr, __ATOMIC_RELAXED, __HIP_MEMORY_SCOPE_AGENT); __hip_atomic_store(SX + (size_t)u * 128 + 64 + lane, xi, __ATOMIC_RELAXED, __HIP_MEMORY_SCOPE_AGENT); } else { SX[(size_t)u * 128 + lane] = xr; SX[(size_t)u * 128 + 64 + lane] = xi; } }
    }
}
__device__ __forceinline__ void ph_s5_chain(const Args& a) {
    const int idx = blockIdx.x * 64 + (MK_TID & 63); if (idx >= 8192) return;
    const int s = idx >> 6, p = idx & 63, g = s & 63; float* SX = (float*)(a.ws + WS_S5X); const float* AL = (const float*)(a.ws + WS_S5AL);
    const float alr = AL[(g * 64 + p) * 2], ali = AL[(g * 64 + p) * 2 + 1]; float xr = 0.f, xi = 0.f;
    for (int s0 = 0; s0 < 64; s0 += 16) { float tr[16], ti[16];
#pragma unroll
        for (int i = 0; i < 16; ++i) { const size_t u = (size_t)s * 64 + s0 + i; tr[i] = SX[u * 128 + p]; ti[i] = SX[u * 128 + 64 + p]; }
#pragma unroll
        for (int i = 0; i < 16; ++i) { const size_t u = (size_t)s * 64 + s0 + i; SX[u * 128 + p] = xr; SX[u * 128 + 64 + p] = xi; const float nxr = alr * xr - ali * xi + tr[i], nxi = alr * xi + ali * xr + ti[i]; xr = nxr; xi = nxi; } }
}
__device__ __forceinline__ void ph_fox_cumsum(const Args& a, MK_LAS unsigned char* lds) {
    const int lane = MK_TID & 63, wave = MK_TID >> 6, s = blockIdx.x, b = s >> 3, hd = s & 7;
    const float* logf = (const float*)(a.ws + WS_LOGF); float* cum = (float*)(a.ws + WS_CUM);
    MK_LAS double* tot = (MK_LAS double*)(lds + 8 * 12800);
    float v[32]; double sum = 0.0;
#pragma unroll
    for (int i = 0; i < 32; ++i) { v[i] = logf[((size_t)b * T + 2048 * wave + 64 * i + lane) * 8 + hd]; sum += (double)v[i]; }
#pragma unroll
    for (int o = 32; o > 0; o >>= 1) sum += __shfl_xor(sum, o);
    if (lane == 0) tot[wave] = sum;
    __syncthreads();
    double carry = 0.0;
    for (int w2 = 0; w2 < wave; ++w2) carry += tot[w2];
#pragma unroll
    for (int i = 0; i < 32; ++i) { double x = (double)v[i];
#pragma unroll
        for (int o = 1; o < 64; o <<= 1) { const double w = __shfl_up(x, o); if (lane >= o) x += w; }
        cum[((size_t)b * T + 2048 * wave + 64 * i + lane) * 8 + hd] = (float)(carry + x); carry += __shfl(x, 63); }
    __syncthreads();
}
constexpr size_t WS_ROWTOK = 15 * MiB;
constexpr size_t WS_WRH = 13 * MiB, WS_WRL = 13 * MiB + 512 * 1024, WS_RSTOK = 14 * MiB, WS_RSP = 14 * MiB + 512 * 1024;
constexpr int NRT = 1;
constexpr int RT_RED = 0, RT_SS = 8 * 32 * 48 * 4, RT_LOG = RT_SS + 8 * 32 * 4, RT_RSTD = RT_LOG + 32 * 36 * 4, RT_END = RT_RSTD + 128;
__device__ __forceinline__ void router_weight_prep(const Args& a) {
    const int gid = blockIdx.x * 512 + MK_TID, NG = gridDim.x * 512;
    bf16_t* WH = (bf16_t*)(a.ws + WS_WRH); bf16_t* WL = (bf16_t*)(a.ws + WS_WRL);
    for (int i = gid; i < 2 * 48 * 2048; i += NG) { const int layer = i / (48 * 2048), rem = i - layer * 48 * 2048, c = rem >> 11, k = rem & 2047;
        float w = 0.f; if (c < 4) w = a.in[I_MWG][((size_t)layer * D + k) * 4 + c]; else if (c < 36) w = a.in[I_MWR][((size_t)layer * D + k) * 32 + (c - 4)];
        w *= a.in[I_FFNW][layer * D + k];
        const unsigned hb = cvtpk(w, 0.f) & 0xffffu; const float hf = __uint_as_float(hb << 16);
        WH[i] = (bf16_t)hb; WL[i] = (bf16_t)(cvtpk(w - hf, 0.f) & 0xffffu); }
}
constexpr int RT_WROW = 272, RT_WARR = 48 * RT_WROW, RT_WBUF = 2 * RT_WARR, RT_LOGO = 2 * RT_WBUF, RT_END2 = RT_LOGO + 8 * 16 * 48 * 4;
static_assert(RT_END2 <= LDS_RING, "router lds");
template <int ABL = 0> __device__ __forceinline__ void ph_router(const Args& a, int layer, MK_LAS unsigned char* lds) {
    const int tid = MK_TID, lane = tid & 63, wave = tid >> 6, m = lane & 15, q = lane >> 4;
    MK_LAS int* Lh = (MK_LAS int*)(lds + LDS_MISC + 64);
    if (tid < 32) Lh[tid] = 0;
    __syncthreads();
    const float* x = a.out; bf16_t* H = (bf16_t*)(a.ws + WS_H);
    const float* wn = a.in[I_FFNW] + layer * D; const float* bg = a.in[I_MBG] + layer * 4; const float* br = a.in[I_MBR] + layer * 32;
    const bf16_t* WH = (const bf16_t*)(a.ws + WS_WRH) + (size_t)layer * 48 * 2048; const bf16_t* WL = (const bf16_t*)(a.ws + WS_WRL) + (size_t)layer * 48 * 2048;
    int* re = (int*)(a.ws + WS_RE); float* rwt = (float*)(a.ws + WS_RWT);
    MK_LAS float* LOGW = (MK_LAS float*)(lds + RT_LOGO + wave * 16 * 48 * 4);
    for (int blk = blockIdx.x; blk < NTOK / 128; blk += gridDim.x) {
        const float* xrow = x + (size_t)(blk * 128 + 16 * wave + m) * D + 8 * q;
        f32x4 acc[3], xs[4][2], xn[4][2]; u32x4 wreg[3]; float ss = 0.f;
#pragma unroll
        for (int ct = 0; ct < 3; ++ct) acc[ct] = (f32x4){0.f, 0.f, 0.f, 0.f};
#define RT_WLOAD(c) do { _Pragma("unroll") for (int i = 0; i < 3; ++i) { const int j = tid + 512 * i, arr = j / 768, rem = j - arr * 768, r = rem >> 4, p16 = rem & 15; \
            wreg[i] = *(const u32x4*)((arr ? WL : WH) + (size_t)r * 2048 + 128 * (c) + 8 * p16); } } while (0)
#define RT_WSTORE(buf) do { _Pragma("unroll") for (int i = 0; i < 3; ++i) { const int j = tid + 512 * i, arr = j / 768, rem = j - arr * 768, r = rem >> 4, p16 = rem & 15; \
            *(MK_LAS u32x4*)(lds + (buf) * RT_WBUF + arr * RT_WARR + r * RT_WROW + p16 * 16) = wreg[i]; } } while (0)
#define RT_XLOAD(dst, c) do { _Pragma("unroll") for (int s = 0; s < 4; ++s) { const float* xp = xrow + 128 * (c) + 32 * s; dst[s][0] = *(const f32x4*)xp; dst[s][1] = *(const f32x4*)(xp + 4); } } while (0)
        RT_WLOAD(0); RT_XLOAD(xs, 0);
        for (int c = 0; c < 16; ++c) { const int buf = c & 1;
            RT_WSTORE(buf);
            if (c < 15) { RT_WLOAD(c + 1); RT_XLOAD(xn, c + 1); }
            __syncthreads();
            if (!(ABL & 1)) {
#pragma unroll
            for (int s = 0; s < 4; ++s) { const f32x4 v0 = xs[s][0], v1 = xs[s][1];
                ss += (v0[0] * v0[0] + v0[1] * v0[1]) + (v0[2] * v0[2] + v0[3] * v0[3]) + (v1[0] * v1[0] + v1[1] * v1[1]) + (v1[2] * v1[2] + v1[3] * v1[3]);
                const u32x2 h0 = pk4(v0), h1 = pk4(v1); f32x4 f0, f1;
                f0[0] = bflo(h0.x); f0[1] = bfhi(h0.x); f0[2] = bflo(h0.y); f0[3] = bfhi(h0.y); f1[0] = bflo(h1.x); f1[1] = bfhi(h1.x); f1[2] = bflo(h1.y); f1[3] = bfhi(h1.y);
                const bf16x8 xh = mk8(h0, h1), xl = mk8(pk4(v0 - f0), pk4(v1 - f1));
                if (!(ABL & 2)) { const int k = 128 * c + 32 * s + 8 * q; const f32x4 g0 = *(const f32x4*)(wn + k), g1 = *(const f32x4*)(wn + k + 4);
                    const u32x2 p0 = pk4(v0 * g0), p1 = pk4(v1 * g1); u32x4 w; w.x = p0.x; w.y = p0.y; w.z = p1.x; w.w = p1.y;
                    *(u32x4*)(H + (size_t)(blk * 128 + 16 * wave + m) * D + k) = w; }
#pragma unroll
                for (int ct = 0; ct < 3; ++ct) { const MK_LAS unsigned char* wp = lds + buf * RT_WBUF + (16 * ct + m) * RT_WROW + (32 * s + 8 * q) * 2;
                    const bf16x8 wh = *(const MK_LAS bf16x8*)wp, wl = *(const MK_LAS bf16x8*)(wp + RT_WARR);
                    acc[ct] = MFMA16(xh, wh, acc[ct]); acc[ct] = MFMA16(xl, wh, acc[ct]); acc[ct] = MFMA16(xh, wl, acc[ct]); } } }
#pragma unroll
            for (int s = 0; s < 4; ++s) { xs[s][0] = xn[s][0]; xs[s][1] = xn[s][1]; }
        }
#undef RT_WLOAD
#undef RT_WSTORE
#undef RT_XLOAD
        ss += __shfl_xor(ss, 16); ss += __shfl_xor(ss, 32);
        const float rstd = rsqrtf(ss * (1.0f / D) + NORM_EPS);
#pragma unroll
        for (int e = 0; e < 4; ++e) { const float rs = __shfl(rstd, 4 * q + e);
#pragma unroll
            for (int ct = 0; ct < 3; ++ct) LOGW[(4 * q + e) * 48 + 16 * ct + m] = acc[ct][e] * rs; }
        asm volatile("s_waitcnt lgkmcnt(0)" ::: "memory");
        if (!(ABL & 4) && q == 0) { const MK_LAS float* lg = LOGW + m * 48; const int tok = blk * 128 + 16 * wave + m;
            float gl4[4];
#pragma unroll
            for (int c2 = 0; c2 < 4; ++c2) gl4[c2] = lg[c2] + bg[c2];
            int gi = 0; float gm = gl4[0];
#pragma unroll
            for (int c2 = 1; c2 < 4; ++c2) if (gl4[c2] > gm) { gm = gl4[c2]; gi = c2; }
            float gs = 0.f;
#pragma unroll
            for (int c2 = 0; c2 < 4; ++c2) gs += __expf(gl4[c2] - gm);
            const float gw = 1.0f / gs; const MK_LAS float* el = lg + 4 + gi * 8; const float* bre = br + gi * 8;
            float ev[8];
#pragma unroll
            for (int c2 = 0; c2 < 8; ++c2) ev[c2] = el[c2] + bre[c2];
            int i0 = 0; float v0 = ev[0];
#pragma unroll
            for (int c2 = 1; c2 < 8; ++c2) if (ev[c2] > v0) { v0 = ev[c2]; i0 = c2; }
            int i1 = -1; float v1 = -3.0e38f;
#pragma unroll
            for (int c2 = 0; c2 < 8; ++c2) if (c2 != i0 && ev[c2] > v1) { v1 = ev[c2]; i1 = c2; }
            const float ex = __expf(v1 - v0), w0 = gw / (1.0f + ex), w1 = gw * ex / (1.0f + ex);
            const int e0 = gi * 8 + i0, e1 = gi * 8 + i1; re[2 * tok] = e0; re[2 * tok + 1] = e1; rwt[2 * tok] = w0; rwt[2 * tok + 1] = w1;
            atomicAdd((int*)(Lh + e0), 1); atomicAdd((int*)(Lh + e1), 1); }
        if (q == 0) ((float*)(a.ws + WS_RSTOK))[blk * 128 + 16 * wave + m] = rstd;
        __syncthreads();
        if (tid < 32) { ((int*)(a.ws + WS_HIST))[blk * 32 + tid] = Lh[tid]; Lh[tid] = 0; }
        __syncthreads();
    }
}
__device__ __forceinline__ void ph_scatter(const Args& a, MK_LAS unsigned char* lds) {
    const int tid = MK_TID, lane = tid & 63, wave = tid >> 6;
    MK_LAS int* Lbase = (MK_LAS int*)(lds + LDS_MISC + 64); MK_LAS int* Lcur = Lbase + 32; MK_LAS int* Ltot = Lcur + 32; MK_LAS int* Loff = Ltot + 32;
    const int* hist = (const int*)(a.ws + WS_HIST); const int* re = (const int*)(a.ws + WS_RE); int* pos = (int*)(a.ws + WS_POS);
    const bf16_t* H = (const bf16_t*)(a.ws + WS_H); bf16_t* HP = (bf16_t*)(a.ws + WS_P);
    for (int blk = blockIdx.x; blk < NTOK / 128; blk += gridDim.x) {
        if (tid < 32) { Ltot[tid] = 0; Lbase[tid] = 0; Lcur[tid] = 0; }
        __syncthreads();
        {   const int e = tid & 31; int hv[16], tot = 0, bef = 0;
#pragma unroll
            for (int j = 0; j < 16; ++j) hv[j] = hist[((tid >> 5) + 16 * j) * 32 + e];
#pragma unroll
            for (int j = 0; j < 16; ++j) { tot += hv[j]; bef += (((tid >> 5) + 16 * j) < blk) ? hv[j] : 0; }
            atomicAdd((int*)(Ltot + e), tot); atomicAdd((int*)(Lbase + e), bef); }
        __syncthreads();
        if (tid == 0) { int off = 0; for (int e = 0; e < 32; ++e) { Loff[e] = off; off += ((Ltot[e] + 255) >> 8) << 8; }
            if (blk == 0) { int* te = (int*)(a.ws + WS_TILEE); for (int e = 0; e < 32; ++e) { const int t0 = Loff[e] >> 8, nt = (Ltot[e] + 255) >> 8; for (int q = 0; q < nt; ++q) te[t0 + q] = e; }
                *(int*)(a.ws + WS_NT) = off >> 8; } }
        __syncthreads();
        {
            const int mb = blk * 128 + 16 * wave; int p0 = 0, p1 = 0;
            if (lane < 16) { const int m = mb + lane; const int e0 = re[2 * m], e1 = re[2 * m + 1];
                p0 = Loff[e0] + Lbase[e0] + atomicAdd((int*)(Lcur + e0), 1); p1 = Loff[e1] + Lbase[e1] + atomicAdd((int*)(Lcur + e1), 1);
                pos[2 * m] = p0; pos[2 * m + 1] = p1; { int* rowtok = (int*)(a.ws + WS_ROWTOK); rowtok[p0] = m; rowtok[p1] = m; } const float rs = ((const float*)(a.ws + WS_RSTOK))[m]; float* rsp = (float*)(a.ws + WS_RSP); rsp[p0] = rs; rsp[p1] = rs; }
            (void)H; (void)HP;
        }
        __syncthreads();
    }
}
__device__ __forceinline__ void ph_combine(const Args& a, int mode, MK_LAS unsigned char* lds) {
    const int lane = MK_TID & 63, gw = blockIdx.x * 8 + (MK_TID >> 6), NGW = gridDim.x * 8;
    const bf16_t* Y = (const bf16_t*)(a.ws + WS_P); const int* pos = (const int*)(a.ws + WS_POS); const float* rwt = (const float*)(a.ws + WS_RWT);
    bf16_t* H = (bf16_t*)(a.ws + WS_H); float* logf = (float*)(a.ws + WS_LOGF);
    int pp0 = 0, pp1 = 0; float pw0 = 0.f, pw1 = 0.f;
    { const int mm = gw + lane * NGW; if (lane < 16 && mm < NTOK) { pp0 = pos[2 * mm]; pp1 = pos[2 * mm + 1]; pw0 = rwt[2 * mm]; pw1 = rwt[2 * mm + 1]; } }
    int ti = 0;
    for (int m = gw; m < NTOK; m += NGW, ++ti) {
        float* xr = a.out + (size_t)m * D; int p0, p1; float w0, w1;
        if (ti < 16) { p0 = __shfl(pp0, ti); p1 = __shfl(pp1, ti); w0 = __shfl(pw0, ti); w1 = __shfl(pw1, ti); } else { p0 = pos[2 * m]; p1 = pos[2 * m + 1]; w0 = rwt[2 * m]; w1 = rwt[2 * m + 1]; }
        const bf16_t* y0 = Y + (size_t)p0 * D; const bf16_t* y1 = Y + (size_t)p1 * D; f32x4 v[8];
#pragma unroll
        for (int j = 0; j < 8; ++j) { const int k = 4 * (lane + 64 * j); v[j] = *(const f32x4*)(xr + k); const u32x2 a0 = *(const u32x2*)(y0 + k), a1 = *(const u32x2*)(y1 + k);
            v[j][0] += w0 * bflo(a0.x) + w1 * bflo(a1.x); v[j][1] += w0 * bfhi(a0.x) + w1 * bfhi(a1.x); v[j][2] += w0 * bflo(a0.y) + w1 * bflo(a1.y); v[j][3] += w0 * bfhi(a0.y) + w1 * bfhi(a1.y); }
        const float rstd = row_rstd(v);
        if (mode == 0) {
#pragma unroll
            for (int j = 0; j < 8; ++j) *(f32x4*)(xr + 4 * (lane + 64 * j)) = v[j];
            norm_scale(v, rstd, a.in[I_MIXW] + D, lane); store_row_bf16(v, H + (size_t)m * D, lane);
            float fl[8];
#pragma unroll
            for (int q = 0; q < 8; ++q) fl[q] = 0.f;
#pragma unroll
            for (int j = 0; j < 8; ++j)
#pragma unroll
                for (int i4 = 0; i4 < 4; ++i4) { const int k = 4 * (lane + 64 * j) + i4; const float* wrow = a.in[I_CDIN] + (size_t)k * CD_COLS + 4096; const f32x4 wa = *(const f32x4*)wrow, wb = *(const f32x4*)(wrow + 4);
#pragma unroll
                    for (int q = 0; q < 4; ++q) { fl[q] += v[j][i4] * wa[q]; fl[4 + q] += v[j][i4] * wb[q]; } }
#pragma unroll
            for (int q = 0; q < 8; ++q) fl[q] = wave_sum(fl[q]);
            if (lane < 8) { float f = fl[0];
#pragma unroll
                for (int q = 1; q < 8; ++q) f = (lane == q) ? fl[q] : f;
                logf[(size_t)m * 8 + lane] = -softplusf(-(f + a.in[I_FOXB][lane])); }
        } else {
            norm_scale(v, rstd, a.in[I_FINW], lane);
#pragma unroll
            for (int j = 0; j < 8; ++j) *(f32x4*)(xr + 4 * (lane + 64 * j)) = v[j];
        }
    }
    (void)lds;
}
__device__ __forceinline__ void ph_s5_naive(const Args& a, MK_LAS unsigned char* lds) {
    const int tid = MK_TID, lane = tid & 63, wave = tid >> 6;
    if (blockIdx.x < 16) {
        constexpr int TS = 16;
        const int s = blockIdx.x * 8 + wave, b = s >> 6, g = s & 63, p = lane;
        const bf16_t* P = (const bf16_t*)(a.ws + WS_P); bf16_t* Z = (bf16_t*)(a.ws + WS_H);
        MK_LAS float* Lu = (MK_LAS float*)lds + wave * (TS * 16 + 2 * TS * 64); MK_LAS float* Lxr = Lu + TS * 16; MK_LAS float* Lxi = Lxr + TS * 64;
        const float lr = fminf(a.in[I_S5LR][g * 64 + p], -1e-4f), li = a.in[I_S5LI][g * 64 + p], dt = expf(a.in[I_S5DT][g]);
        const float mag = expf(lr * dt), abr = mag * cosf(li * dt), abi = mag * sinf(li * dt);
        const float nr = abr - 1.0f, ni = abi, den = lr * lr + li * li, zr = (nr * lr + ni * li) / den, zi = (ni * lr - nr * li) / den;
        float bbr[16], bbi[16];
#pragma unroll
        for (int c = 0; c < 16; ++c) { const float br = a.in[I_S5BR][(g * 64 + p) * 16 + c], bi = a.in[I_S5BI][(g * 64 + p) * 16 + c]; bbr[c] = zr * br - zi * bi; bbi[c] = zr * bi + zi * br; }
        float xr = 0.f, xi = 0.f;
        for (int t0 = 0; t0 < T; t0 += TS) {
#pragma unroll
            for (int q = 0; q < 4; ++q) { const int i = lane + 64 * q, tt = i >> 4, c = i & 15; Lu[i] = bf2f(P[((size_t)b * T + t0 + tt) * CD_LD + g * 16 + c]); }
            asm volatile("s_waitcnt lgkmcnt(0)" ::: "memory");
            for (int tt = 0; tt < TS; ++tt) { float ur = 0.f, ui = 0.f;
#pragma unroll
                for (int c = 0; c < 16; ++c) { const float u = Lu[tt * 16 + c]; ur += bbr[c] * u; ui += bbi[c] * u; }
                const float nxr = abr * xr - abi * xi + ur, nxi = abr * xi + abi * xr + ui; xr = nxr; xi = nxi;
                Lxr[tt * 64 + p] = xr; Lxi[tt * 64 + p] = xi; }
            asm volatile("s_waitcnt lgkmcnt(0)" ::: "memory");
#pragma unroll
            for (int q = 0; q < 4; ++q) { const int i = lane + 64 * q, tt = i >> 4, c = i & 15; float y = 0.f;
                const float* cr = a.in[I_S5CR] + (g * 16 + c) * 64; const float* ci = a.in[I_S5CI] + (g * 16 + c) * 64;
                for (int pp = 0; pp < 64; ++pp) y += cr[pp] * Lxr[tt * 64 + pp] - ci[pp] * Lxi[tt * 64 + pp];
                y += a.in[I_S5D][g * 16 + c] * Lu[i];
                Z[((size_t)b * T + t0 + tt) * 1024 + g * 16 + c] = (bf16_t)(cvt_pk_bf16(gelu_tanh(y), 0.f) & 0xffffu); }
            asm volatile("s_waitcnt lgkmcnt(0)" ::: "memory");
        }
    } else if (blockIdx.x < 32 && wave == 0) {
        const int s = blockIdx.x - 16, b = s >> 3, hd = s & 7;
        const float* logf = (const float*)(a.ws + WS_LOGF); float* cum = (float*)(a.ws + WS_CUM);
        double carry = 0.0;
        for (int t0 = 0; t0 < T; t0 += 64) { const size_t idx = ((size_t)b * T + t0 + lane) * 8 + hd;
            double v = (double)logf[idx];
#pragma unroll
            for (int o = 1; o < 64; o <<= 1) { const double u = __shfl_up(v, o); if (lane >= o) v += u; }
            cum[idx] = (float)(carry + v); carry += __shfl(v, 63); }
    }
}
__device__ __forceinline__ void ph_fox_naive(const Args& a, MK_LAS unsigned char* lds) {
    const int tid = MK_TID, lane = tid & 63, wave = tid >> 6, gw = blockIdx.x * 8 + wave, NGW = gridDim.x * 8;
    const bf16_t* P = (const bf16_t*)(a.ws + WS_P); bf16_t* O = (bf16_t*)(a.ws + WS_O); const float* cum = (const float*)(a.ws + WS_CUM);
    MK_LAS float* Lq = (MK_LAS float*)lds + wave * 128;
    const float scale = 0.08838834764831845f;
    for (int u = gw; u < NB * 8 * T; u += NGW) { const int bh = u / T, t = u % T, b = bh >> 3, hd = bh & 7; const size_t row = (size_t)b * T + t;
        { const unsigned w = *(const unsigned*)(P + row * CD_LD + 1024 + hd * 128 + 2 * lane); Lq[2 * lane] = bflo(w) * scale; Lq[2 * lane + 1] = bfhi(w) * scale; }
        asm volatile("s_waitcnt lgkmcnt(0)" ::: "memory");
        const float ct = cum[row * 8 + hd]; float mrun = -3.0e38f, lrun = 0.f, o0 = 0.f, o1 = 0.f;
        for (int j0 = 0; j0 <= t; j0 += 64) { const int key = j0 + lane; const bool valid = key <= t; const size_t krow = (size_t)b * T + (valid ? key : t);
            const u32x4* kp = (const u32x4*)(P + krow * CD_LD + 2048 + hd * 128); float dot = 0.f;
#pragma unroll
            for (int i = 0; i < 16; ++i) { const u32x4 kw = kp[i]; const f32x4 qa = *(const MK_LAS f32x4*)(Lq + 8 * i), qb = *(const MK_LAS f32x4*)(Lq + 8 * i + 4);
                dot += bflo(kw.x) * qa[0] + bfhi(kw.x) * qa[1] + bflo(kw.y) * qa[2] + bfhi(kw.y) * qa[3] + bflo(kw.z) * qb[0] + bfhi(kw.z) * qb[1] + bflo(kw.w) * qb[2] + bfhi(kw.w) * qb[3]; }
            const float sc = valid ? dot + (ct - cum[krow * 8 + hd]) : -3.0e38f;
            const float mnew = fmaxf(mrun, wave_max(sc)); const float pj = valid ? __expf(sc - mnew) : 0.f; const float corr = __expf(mrun - mnew);
            lrun = lrun * corr + wave_sum(pj); o0 *= corr; o1 *= corr; mrun = mnew;
            const int nk = (t - j0 + 1) < 64 ? (t - j0 + 1) : 64;
            for (int jj = 0; jj < nk; ++jj) { const float pb = __shfl(pj, jj); const unsigned vw = *(const unsigned*)(P + ((size_t)b * T + j0 + jj) * CD_LD + 3072 + hd * 128 + 2 * lane);
                o0 += pb * bflo(vw); o1 += pb * bfhi(vw); } }
        const float inv = 1.0f / lrun;
        *(unsigned*)(O + row * D + 1024 + hd * 128 + 2 * lane) = cvt_pk_bf16(o0 * inv, o1 * inv);
        asm volatile("s_waitcnt lgkmcnt(0)" ::: "memory");
    }
}
#if MK_RWKV_WP
#define RWKV_RA(b_, l_) ph_rwkv_wp<0>(b_, l_)
#define RWKV_RB(b_) ph_rwkv_wp_chain(b_)
#define RWKV_RC(b_, l_) ph_rwkv_wp<1>(b_, l_)
#else
#define RWKV_RA(b_, l_) ph_rwkv<0>(b_, l_)
#define RWKV_RB(b_) ph_rwkv_chain(b_)
#define RWKV_RC(b_, l_) ph_rwkv<1>(b_, l_)
#endif
enum { PH_PRO = 0, PH_INPROJ0, PH_MIXA0, PH_MIXA1, PH_MIXB0, PH_MIXC0, PH_OUTPROJ0, PH_ROUTE0, PH_SCAT0, PH_GU0, PH_DN0, PH_COMB0, PH_INPROJ1, PH_S5A, PH_FOX, PH_GLU, PH_OUTPROJ1, PH_ROUTE1, PH_SCAT1, PH_GU1, PH_DN1, PH_FINAL, NPH };

#if defined(MK_SELFCHK) || defined(MK_GSTRESS)
constexpr size_t WS_CKS = 128 * 1024, WS_BAD = 130 * 1024;
__device__ __forceinline__ void cks_range(const unsigned char* p, size_t nbytes, unsigned* dst) {
    const u32x4* q = (const u32x4*)p; const size_t n = nbytes / 16; unsigned s = 0u;
    for (size_t i = (size_t)blockIdx.x * 512 + MK_TID; i < n; i += (size_t)gridDim.x * 512) { const u32x4 v = q[i]; s += (v.x + 3u * v.y + 5u * v.z + 7u * v.w) * (unsigned)(2 * i + 1); }
#pragma unroll
    for (int o = 32; o > 0; o >>= 1) s += __shfl_xor(s, o);
    if ((MK_TID & 63) == 0) atomicAdd(dst, s);
}

constexpr size_t WS_TCKS = 132 * 1024;
__device__ __forceinline__ void cks_out_tiles(const Args& a, int slot) {
    unsigned* tc = (unsigned*)(a.ws + WS_TCKS) + slot * 1024;
    for (int t = blockIdx.x; t < 1024; t += gridDim.x) { const int pm = t >> 3, pn = t & 7; unsigned s = 0u;
        for (int i = MK_TID; i < 256 * 64; i += 512) { const int r = i >> 6, c4 = i & 63; const u32x4 v = *(const u32x4*)(a.out + (size_t)(pm * 256 + r) * D + pn * 256 + 4 * c4);
            s += (v.x + 3u * v.y + 5u * v.z + 7u * v.w) * (unsigned)(2 * i + 1); }
#pragma unroll
        for (int o = 32; o > 0; o >>= 1) s += __shfl_xor(s, o);
        if ((MK_TID & 63) == 0) atomicAdd(tc + t, s); }
}

constexpr size_t WS_UCKS = 192 * 1024;
__device__ __forceinline__ void cks_z_units(const Args& a, int slot) {
    unsigned* uc = (unsigned*)(a.ws + WS_UCKS) + slot * 8192;
#ifdef MK_S5_PROBE
    const bf16_t* Z = (const bf16_t*)(a.ws + WS_P + 360 * MiB);
#else
    const bf16_t* Z = (const bf16_t*)(a.ws + WS_H);
#endif
    const int lane = MK_TID & 63, gw = blockIdx.x * 8 + (MK_TID >> 6), NGW = gridDim.x * 8;
    for (int u = gw; u < 8192; u += NGW) { const int seg = u & 63, s2 = u >> 6, b2 = s2 >> 6, g = s2 & 63; unsigned sum = 0u;
        for (int i = 0; i < 32; ++i) { const int idx = i * 64 + lane, r = idx >> 3, d = idx & 7;
            const unsigned v = *(const unsigned*)(Z + ((size_t)b2 * T + seg * 256 + r) * 1024 + g * 16 + 2 * d); sum += v * (unsigned)(2 * idx + 1); }
#pragma unroll
        for (int o = 32; o > 0; o >>= 1) sum += __shfl_xor(sum, o);
        if (lane == 0) uc[u] = sum; }
}
__device__ __forceinline__ void ph_cks(const Args& a, int k, int slot) {
    unsigned* dst = (unsigned*)(a.ws + WS_CKS) + slot * 32 + k; unsigned char* ws = a.ws;
#define CR(lo_, hi_) cks_range(ws + (size_t)((lo_) * 1048576.0), (size_t)(((hi_) - (lo_)) * 1048576.0), dst)
#define COUT cks_range((const unsigned char*)a.out, (size_t)NTOK * D * 4, dst)
    switch (k) {
    case PH_PRO: CR(8, 14); CR(16, 400); break;
    case PH_INPROJ0: CR(528, 1008); break;
    case PH_MIXA0: CR(272, 336); CR(10, 10.5); CR(1008, 1136); CR(400, 528); break;
    case PH_MIXA1: CR(272, 400); break;
    case PH_MIXB0: CR(336, 368); CR(400, 528); break;
    case PH_MIXC0: CR(400, 528); break;
    case PH_OUTPROJ0: COUT; cks_out_tiles(a, slot); break;
    case PH_ROUTE0: case PH_ROUTE1: CR(272, 400); CR(2, 2.25); CR(3, 3.25); CR(1, 1.03125); CR(14, 14.125); break;
    case PH_SCAT0: case PH_SCAT1: CR(1.0625, 1.09375); break;
    case PH_COMB0: COUT; CR(272, 400); CR(5, 6); CR(80, 272); break;
    case PH_INPROJ1: CR(528, 784); break;
    case PH_S5A: CR(6, 7); CR(1008, 1012); CR(0.0625, 0.06256103515625); break;
    case PH_FOX: CR(400, 528); cks_range(ws + 272 * MiB, 64 * MiB, (unsigned*)(a.ws + WS_CKS) + slot * 32 + PH_DN0); break;
    case PH_GLU: CR(400, 528); break;
    case PH_OUTPROJ1: COUT; break;
    case PH_FINAL: COUT; break;
    default: break; }
#undef CR
#undef COUT
}
__device__ __forceinline__ void ph_poison(const Args& a) {
    const u32x4 pz = (u32x4){0xAAAAAAAAu, 0xAAAAAAAAu, 0xAAAAAAAAu, 0xAAAAAAAAu};
    { u32x4* q = (u32x4*)(a.ws + 1 * MiB); const size_t n = (WS_END - 1 * MiB) / 16; for (size_t i = (size_t)blockIdx.x * 512 + MK_TID; i < n; i += (size_t)gridDim.x * 512) q[i] = pz; }
    { u32x4* q = (u32x4*)a.out; const size_t n = (size_t)NTOK * D * 4 / 16; for (size_t i = (size_t)blockIdx.x * 512 + MK_TID; i < n; i += (size_t)gridDim.x * 512) q[i] = pz; }
    if (blockIdx.x == 0 && MK_TID < 256) ((unsigned*)(a.ws + 65536))[MK_TID] = 0u;
}
#endif
__device__ __forceinline__ Args load_args() {
    Args b{};
#if defined(__HIP_DEVICE_COMPILE__)
    typedef __attribute__((address_space(4))) const Args* KArgsPtr;
    unsigned long long v = (unsigned long long)__builtin_amdgcn_kernarg_segment_ptr(); asm volatile("" : "+s"(v)); const KArgsPtr k = (KArgsPtr)v;
#pragma unroll
    for (int i = 0; i < 39; ++i) b.in[i] = k->in[i];
    b.out = k->out; b.ws = k->ws; b.ph_lo = k->ph_lo; b.ph_hi = k->ph_hi;
#endif
    return b;
}
#define PHB const Args b = load_args(); unsigned char* const ws = b.ws; (void)ws;
#ifndef MK_ONE_LAUNCH
#define MK_ONE_LAUNCH 0
#endif
#ifndef MK_DUP
#define MK_DUP -1
#endif
__device__ __forceinline__ int probe_reps(bool dup) { int r = 1; if (dup) { r = 2; asm volatile("" : "+s"(r)); } return r; }
template <int ONLY> __global__ void __launch_bounds__(512, 2) fwd(Args a) {
    extern __shared__ __attribute__((aligned(16))) unsigned char lds_raw[];
    MK_LAS unsigned char* lds = (MK_LAS unsigned char*)lds_raw;
    if (MK_TID < 16) ((MK_LAS unsigned*)(lds + LDS_MISC))[MK_TID] = 0u;
    __syncthreads();
    const int lo = a.ph_lo, hi = a.ph_hi & 255;
    XcdBarrier bar; bar.bar = (unsigned*)(a.ws + WS_CTL); bar.x = 0; bar.st = nullptr;
#ifdef MK_GSTRESS
    const int pass_ = a.ph_hi >> 8;
    bar = xcd_barrier_post((unsigned*)(a.ws + WS_CTL), (volatile LAS unsigned*)(lds + LDS_MISC));
#else
    if (hi - lo > 1) bar = xcd_barrier_post((unsigned*)(a.ws + WS_CTL), (volatile LAS unsigned*)(lds + LDS_MISC));
#endif
#define IN(k) ((ONLY < 0 || (k) == ONLY) && lo <= (k) && (k) < hi)
#define REPS(k) ((MK_DUP == (k)) ? 2 : 1)
#ifdef MK_SELFCHK
#define SEAM(k) do { if (IN(k) && IN((k) + 1)) { xcd_barrier(bar); { PHB ph_cks(b, (k), slot_); } xcd_barrier(bar); if ((k) == PH_FOX) { { PHB cks_z_units(b, slot_); } xcd_barrier(bar); } } } while (0)
#else
#define SEAM(k) do { if (IN(k) && IN((k) + 1)) xcd_barrier(bar); } while (0)
#endif
#define H ((bf16_t*)(ws + WS_H))
#define O ((bf16_t*)(ws + WS_O))
#define P ((bf16_t*)(ws + WS_P))
#define HID ((bf16_t*)(ws + WS_HID))
    const int G = (int)gridDim.x, c = (int)blockIdx.x;
#ifdef MK_SELFCHK
    const int pass_ = a.ph_hi >> 8, slot_ = pass_ ? 1 : 0;
#endif

    if (IN(PH_PRO)) for (int rep_ = 0; rep_ < REPS(PH_PRO); ++rep_) { PHB ph_prologue(b, lds); rwkv_convert_small(b); s5_param_prep(b); router_weight_prep(b); } SEAM(PH_PRO);
    if (IN(PH_INPROJ0)) for (int rep_ = 0; rep_ < REPS(PH_INPROJ0); ++rep_) { PHB pg8::Gemm g{H, (const bf16_t*)(ws + WS_ABIN), NTOK, AB_LD, D}; pg8::StaticOrder S; S.init(NTOK, AB_LD, G, c); pg8::EpiStoreBf16 E{P, AB_LD, 0x7fffffff};
        pg8::gemm_phase<pg8::EpiStoreBf16, pg8::StaticOrder, MK_INPROJ_ALIGN, true>(lds, g, S, E); } SEAM(PH_INPROJ0);
#ifdef MK_GSTRESS
    if (hi == 2) { const int slot_ = pass_ ? 1 : 0;
        xcd_barrier(bar); { PHB cks_range(b.ws + WS_P, 480 * MiB, (unsigned*)(b.ws + WS_CKS) + slot_ * 32 + 0); }
        xcd_barrier(bar); { PHB cks_range(b.ws + WS_P, 480 * MiB, (unsigned*)(b.ws + WS_CKS) + slot_ * 32 + 1); }
        xcd_barrier(bar);
        if (blockIdx.x == 0 && MK_TID == 0) { PHB unsigned* ck = (unsigned*)(b.ws + WS_CKS); unsigned* bad = (unsigned*)(b.ws + WS_BAD);
            const unsigned r0 = __hip_atomic_load(ck + 0, __ATOMIC_RELAXED, __HIP_MEMORY_SCOPE_AGENT), a0 = __hip_atomic_load(ck + slot_ * 32 + 0, __ATOMIC_RELAXED, __HIP_MEMORY_SCOPE_AGENT), a1 = __hip_atomic_load(ck + slot_ * 32 + 1, __ATOMIC_RELAXED, __HIP_MEMORY_SCOPE_AGENT);
            unsigned code = 0u; if (a0 != a1) code = 2u; else if (a0 != r0) code = 1u;
            if (code != 0u && __hip_atomic_load(bad, __ATOMIC_RELAXED, __HIP_MEMORY_SCOPE_AGENT) == 0u) __hip_atomic_store(bad, code, __ATOMIC_RELAXED, __HIP_MEMORY_SCOPE_AGENT);
            if (slot_) { __hip_atomic_store(ck + 32, 0u, __ATOMIC_RELAXED, __HIP_MEMORY_SCOPE_AGENT); __hip_atomic_store(ck + 33, 0u, __ATOMIC_RELAXED, __HIP_MEMORY_SCOPE_AGENT); } } }
#endif
    if (IN(PH_MIXA0)) for (int rep_ = 0; rep_ < REPS(PH_MIXA0); ++rep_) { PHB ph_hgrn2<0>(b, lds); ph_rwkv_pre<0>(b, lds); } SEAM(PH_MIXA0);
    if (IN(PH_MIXA1)) for (int rep_ = 0; rep_ < REPS(PH_MIXA1); ++rep_) { PHB RWKV_RA(b, lds); if (rep_ == 0) ph_hgrn2_chain(b, 0); } SEAM(PH_MIXA1);
    if (IN(PH_MIXB0)) for (int rep_ = 0; rep_ < REPS(PH_MIXB0); ++rep_) { PHB if (rep_ == 0 && blockIdx.x < 16) RWKV_RB(b); ph_hgrn2<1>(b, lds, 16); } SEAM(PH_MIXB0);
    if (IN(PH_MIXC0)) for (int rep_ = 0; rep_ < REPS(PH_MIXC0); ++rep_) { PHB RWKV_RC(b, lds); } SEAM(PH_MIXC0);
    if (IN(PH_OUTPROJ0)) for (int rep_ = 0; rep_ < REPS(PH_OUTPROJ0); ++rep_) { PHB pg8::Gemm g{O, (const bf16_t*)(ws + WS_ABOUT), NTOK, D, D}; pg8::StaticOrder S; S.init(NTOK, D, G, c); pg8::EpiResF32 E{b.in[I_X], b.out, D};
        pg8::gemm_phase<pg8::EpiResF32, pg8::StaticOrder, true, true>(lds, g, S, E); } SEAM(PH_OUTPROJ0);
    if (IN(PH_ROUTE0)) for (int rep_ = 0; rep_ < REPS(PH_ROUTE0); ++rep_) { PHB ph_router<0>(b, 0, lds); } SEAM(PH_ROUTE0);
    if (IN(PH_SCAT0)) for (int rep_ = 0; rep_ < REPS(PH_SCAT0); ++rep_) { PHB ph_scatter(b, lds); } SEAM(PH_SCAT0);
    if (IN(PH_GU0)) for (int rep_ = 0; rep_ < REPS(PH_GU0); ++rep_) { PHB const int nt = *(const int*)(ws + WS_NT); pg8::Gemm g{H, (const bf16_t*)(ws + WS_GU), ROWS_MAX, NEXP * 1024, D}; pg8::MoeGatherOrder S{(const int*)(ws + WS_TILEE), nt * 4, 4, G, c, (const int*)(ws + WS_ROWTOK), NTOK}; pg8::EpiSwiGlu E{HID, (const float*)(ws + WS_RSP)};
        pg8::gemm_phase<pg8::EpiSwiGlu, pg8::MoeGatherOrder, true, true, true>(lds, g, S, E); } SEAM(PH_GU0);
    if (IN(PH_DN0)) for (int rep_ = 0; rep_ < REPS(PH_DN0); ++rep_) { PHB const int nt = *(const int*)(ws + WS_NT); pg8::Gemm g{HID, (const bf16_t*)(ws + WS_DN), ROWS_MAX, NEXP * D, FF}; pg8::MoeOrder S{(const int*)(ws + WS_TILEE), nt * 8, 8, G, c}; pg8::EpiStoreBf16 E{P, D, 7};
        pg8::gemm_phase<pg8::EpiStoreBf16, pg8::MoeOrder, true, true>(lds, g, S, E); } SEAM(PH_DN0);
    if (IN(PH_COMB0)) for (int rep_ = 0; rep_ < REPS(PH_COMB0); ++rep_) { PHB ph_combine(b, 0, lds); convert_items<2>(b, (MK_LAS float*)lds); } SEAM(PH_COMB0);
    if (IN(PH_INPROJ1)) for (int rep_ = 0; rep_ < REPS(PH_INPROJ1); ++rep_) { PHB pg8::Gemm g{H, (const bf16_t*)(ws + WS_CDIN), NTOK, CD_LD, D}; pg8::StaticOrder S; S.init(NTOK, CD_LD, G, c); pg8::EpiStoreBf16 E{P, CD_LD, 0x7fffffff};
        pg8::gemm_phase<pg8::EpiStoreBf16, pg8::StaticOrder, MK_INPROJ_ALIGN, true>(lds, g, S, E); } SEAM(PH_INPROJ1);
    if (IN(PH_S5A)) for (int rep_ = 0; rep_ < REPS(PH_S5A); ++rep_) { PHB if (blockIdx.x < 16) ph_fox_cumsum(b, lds); ph_fox_kmax(b); ph_s5<0>(b, lds);
#if MK_S5_REL
        asm volatile("s_waitcnt vmcnt(0)" ::: "memory"); __builtin_amdgcn_fence(__ATOMIC_RELEASE, "agent"); asm volatile("s_waitcnt vmcnt(0)" ::: "memory");
#endif
        } SEAM(PH_S5A);
    if (IN(PH_FOX)) for (int rep_ = 0; rep_ < REPS(PH_FOX); ++rep_) { PHB if (MK_S5_FIRST) { ph_s5<1>(b, lds); __syncthreads(); ph_fox(b, lds); } else { ph_fox(b, lds); if (MK_S5_SEP) xcd_barrier(bar); ph_s5<1>(b, lds); }
#ifdef MK_S5_PROBE
        ph_s5<MK_S5_PROBE>(b, lds);
#endif
 } SEAM(PH_FOX);
    if (IN(PH_GLU)) for (int rep_ = 0; rep_ < REPS(PH_GLU); ++rep_) { PHB pg8::Gemm g{H, (const bf16_t*)(ws + WS_GLU), NTOK, 1024, 1024}; pg8::StaticOrder S; S.init(NTOK, 1024, G, c); pg8::EpiGlu E{H, 1024, b.in[I_S5BG], O, D};
        pg8::gemm_phase<pg8::EpiGlu, pg8::StaticOrder, true, true>(lds, g, S, E); } SEAM(PH_GLU);
    if (IN(PH_OUTPROJ1)) for (int rep_ = 0; rep_ < REPS(PH_OUTPROJ1); ++rep_) { PHB pg8::Gemm g{O, (const bf16_t*)(ws + WS_CDOUT), NTOK, D, D}; pg8::StaticOrder S; S.init(NTOK, D, G, c); pg8::EpiResF32 E{b.out, b.out, D};
        pg8::gemm_phase<pg8::EpiResF32, pg8::StaticOrder, true, true>(lds, g, S, E); } SEAM(PH_OUTPROJ1);
    if (IN(PH_ROUTE1)) for (int rep_ = 0; rep_ < REPS(PH_ROUTE1); ++rep_) { PHB ph_router<0>(b, 1, lds); } SEAM(PH_ROUTE1);
    if (IN(PH_SCAT1)) for (int rep_ = 0; rep_ < REPS(PH_SCAT1); ++rep_) { PHB ph_scatter(b, lds); } SEAM(PH_SCAT1);
    if (IN(PH_GU1)) for (int rep_ = 0; rep_ < REPS(PH_GU1); ++rep_) { PHB const int nt = *(const int*)(ws + WS_NT); pg8::Gemm g{H, (const bf16_t*)(ws + WS_GU), ROWS_MAX, NEXP * 1024, D}; pg8::MoeGatherOrder S{(const int*)(ws + WS_TILEE), nt * 4, 4, G, c, (const int*)(ws + WS_ROWTOK), NTOK}; pg8::EpiSwiGlu E{HID, (const float*)(ws + WS_RSP)};
        pg8::gemm_phase<pg8::EpiSwiGlu, pg8::MoeGatherOrder, true, true, true>(lds, g, S, E); } SEAM(PH_GU1);
    if (IN(PH_DN1)) for (int rep_ = 0; rep_ < REPS(PH_DN1); ++rep_) { PHB const int nt = *(const int*)(ws + WS_NT); pg8::Gemm g{HID, (const bf16_t*)(ws + WS_DN), ROWS_MAX, NEXP * D, FF}; pg8::MoeOrder S{(const int*)(ws + WS_TILEE), nt * 8, 8, G, c}; pg8::EpiStoreBf16 E{P, D, 7};
        pg8::gemm_phase<pg8::EpiStoreBf16, pg8::MoeOrder, true, true>(lds, g, S, E); } SEAM(PH_DN1);
    if (IN(PH_FINAL)) for (int rep_ = 0; rep_ < REPS(PH_FINAL); ++rep_) { PHB ph_combine(b, 1, lds); }
#ifdef MK_SELFCHK
    xcd_barrier(bar); { PHB ph_cks(b, PH_FINAL, slot_); } xcd_barrier(bar);
    if (pass_ > 0 && blockIdx.x == 0 && MK_TID == 0) { PHB unsigned* ck = (unsigned*)(b.ws + WS_CKS); unsigned* bad = (unsigned*)(b.ws + WS_BAD);
        { const unsigned* uc = (const unsigned*)(b.ws + WS_UCKS); unsigned cnt = 0u, firstu = 0u, nstr = 0u, lasts = 0xffffffffu;
          for (int u = 0; u < 8192; ++u) { const unsigned r0 = __hip_atomic_load(uc + u, __ATOMIC_RELAXED, __HIP_MEMORY_SCOPE_AGENT), r1 = __hip_atomic_load(uc + 8192 + u, __ATOMIC_RELAXED, __HIP_MEMORY_SCOPE_AGENT);
              if (r0 != r1) { if (cnt == 0u) firstu = (unsigned)u; ++cnt; if ((unsigned)(u >> 6) != lasts) { lasts = (unsigned)(u >> 6); ++nstr; } } }
          if (cnt != 0u && MK_UNITCMP) { __hip_atomic_store(bad, 0u, __ATOMIC_RELAXED, __HIP_MEMORY_SCOPE_AGENT); __hip_atomic_store(bad + 1, 1000u + firstu, __ATOMIC_RELAXED, __HIP_MEMORY_SCOPE_AGENT); __hip_atomic_store(bad + 2, 1u, __ATOMIC_RELAXED, __HIP_MEMORY_SCOPE_AGENT); } }
        for (int k = 23; k >= 0; --k) { const unsigned r0 = __hip_atomic_load(ck + k, __ATOMIC_RELAXED, __HIP_MEMORY_SCOPE_AGENT), r1 = __hip_atomic_load(ck + 32 + k, __ATOMIC_RELAXED, __HIP_MEMORY_SCOPE_AGENT);
            if (r0 != r1 && __hip_atomic_load(bad + 2, __ATOMIC_RELAXED, __HIP_MEMORY_SCOPE_AGENT) == 0u) { const unsigned cur = __hip_atomic_load(bad, __ATOMIC_RELAXED, __HIP_MEMORY_SCOPE_AGENT); if (cur == 0u || (unsigned)(k + 1) < cur) __hip_atomic_store(bad, (unsigned)(k + 1), __ATOMIC_RELAXED, __HIP_MEMORY_SCOPE_AGENT); }
            __hip_atomic_store(ck + 32 + k, 0u, __ATOMIC_RELAXED, __HIP_MEMORY_SCOPE_AGENT); }
        { unsigned* tc = (unsigned*)(b.ws + WS_TCKS); unsigned rowm[4] = {0u, 0u, 0u, 0u}, colm = 0u;
          for (int t = 0; t < 1024; ++t) { const unsigned r0 = __hip_atomic_load(tc + t, __ATOMIC_RELAXED, __HIP_MEMORY_SCOPE_AGENT), r1 = __hip_atomic_load(tc + 1024 + t, __ATOMIC_RELAXED, __HIP_MEMORY_SCOPE_AGENT);
              if (r0 != r1) { rowm[(t >> 3) >> 5] |= 1u << ((t >> 3) & 31); colm |= 1u << (t & 7); }
              __hip_atomic_store(tc + 1024 + t, 0u, __ATOMIC_RELAXED, __HIP_MEMORY_SCOPE_AGENT); }
          const int nrow = __popc(rowm[0]) + __popc(rowm[1]) + __popc(rowm[2]) + __popc(rowm[3]), ncol = __popc(colm);
          if (nrow > 0 && __hip_atomic_load(bad + 2, __ATOMIC_RELAXED, __HIP_MEMORY_SCOPE_AGENT) == 0u && __hip_atomic_load(bad + 1, __ATOMIC_RELAXED, __HIP_MEMORY_SCOPE_AGENT) == 0u) __hip_atomic_store(bad + 1, (unsigned)(10 * (nrow < 9 ? nrow : 9) + (ncol < 8 ? ncol : 8)), __ATOMIC_RELAXED, __HIP_MEMORY_SCOPE_AGENT); } }
    xcd_barrier(bar);
    if (pass_ == MK_SELFCHK - 1) { PHB const unsigned bad = __hip_atomic_load((unsigned*)(b.ws + WS_BAD), __ATOMIC_RELAXED, __HIP_MEMORY_SCOPE_AGENT);
      const unsigned tcode = __hip_atomic_load((unsigned*)(b.ws + WS_BAD) + 1, __ATOMIC_RELAXED, __HIP_MEMORY_SCOPE_AGENT);
      const unsigned long long ticks = (unsigned long long)bad * 500000ull + (unsigned long long)tcode * 2000ull; const unsigned long long t0 = wall_clock64();
      while (wall_clock64() - t0 < ticks) __builtin_amdgcn_s_sleep(8); }
#endif
#ifdef MK_GSTRESS
    if (hi == NPH) { xcd_barrier(bar); { PHB const unsigned bad = __hip_atomic_load((unsigned*)(b.ws + WS_BAD), __ATOMIC_RELAXED, __HIP_MEMORY_SCOPE_AGENT);
      if (bad != 0u) { const float sc = 1.0f + (float)bad; f32x4* q = (f32x4*)b.out; const size_t n = (size_t)NTOK * D / 4;
          for (size_t i = (size_t)blockIdx.x * 512 + MK_TID; i < n; i += (size_t)gridDim.x * 512) q[i] = q[i] * sc; } } }
#endif
#ifdef MK_TAIL
    if (hi == NPH) { xcd_barrier(bar); { PHB
        if (MK_TAIL == PH_MIXA1) RWKV_RA(b, lds);
        if (MK_TAIL == PH_ROUTE0) ph_router<0>(b, 0, lds);
        if (MK_TAIL == PH_MIXA0) ph_hgrn2<0>(b, lds);
        if (MK_TAIL == PH_MIXB0) ph_hgrn2<1>(b, lds);
        if (MK_TAIL >= 400 && MK_TAIL < 408) ph_rwkv_pre<(MK_TAIL >= 400 && MK_TAIL < 408) ? MK_TAIL - 400 : 0>(b, lds);
        if (MK_TAIL >= 300 && MK_TAIL < 316) ph_router<(MK_TAIL >= 300 && MK_TAIL < 316) ? MK_TAIL - 300 : 0>(b, 0, lds);
        if (MK_TAIL >= 200 && MK_TAIL < 264) ph_rwkv<1, (MK_TAIL >= 200 && MK_TAIL < 264) ? MK_TAIL - 200 : 0>(b, lds);
        if (MK_TAIL == 101) { if (blockIdx.x < 16) RWKV_RB(b); }
        if (MK_TAIL == 102) ph_hgrn2_chain(b, 0);
        if (MK_TAIL == 103) { convert_items<2>(b, (MK_LAS float*)lds); }
        if (MK_TAIL == 104) ph_scatter(b, lds);
        if (MK_TAIL == 105) { ph_fox_kmax(b); }
        if (MK_TAIL == 106) { xcd_barrier(bar); xcd_barrier(bar); xcd_barrier(bar); xcd_barrier(bar); xcd_barrier(bar); xcd_barrier(bar); xcd_barrier(bar); xcd_barrier(bar); xcd_barrier(bar); xcd_barrier(bar); }
    } }
#endif
#undef IN
#undef SEAM
#undef H
#undef O
#undef P
#undef HID
}

#ifdef MK_HB
template <int MIT> __global__ void __launch_bounds__(512, 2) hb_kernel(Args a) {
    extern __shared__ __attribute__((aligned(16))) unsigned char lds_raw[];
    MK_LAS unsigned char* lds = (MK_LAS unsigned char*)lds_raw;
    if (MK_TID < 16) ((MK_LAS unsigned*)(lds + LDS_MISC))[MK_TID] = 0u;
    __syncthreads();
    unsigned* ctl = (unsigned*)(a.ws + 256 * 1024);
    XcdBarrier bar = xcd_barrier_post(ctl, (volatile LAS unsigned*)(lds + LDS_MISC));
    const int c = (int)blockIdx.x, G = (int)gridDim.x, r = (c * 37 + 11) % G;
    unsigned nb = 0u, nb2 = 0u, first = 0xffffffffu;
    for (int it = 0; it < MK_HB; ++it) {
        u32x4* dst = (u32x4*)(a.ws + WS_P + (size_t)c * 262144);
#pragma unroll 8
        for (int i = 0; i < 32; ++i) { const unsigned idx = (unsigned)(MK_TID + 512 * i); const unsigned h = (unsigned)it * 0x9E3779B1u + (unsigned)c * 0x85EBCA77u + idx * 0xC2B2AE3Du;
            u32x4 v; v.x = h; v.y = h ^ 0x5555u; v.z = h + 77u; v.w = ~h;
#if MK_HB_SC1
            __builtin_nontemporal_store(v, dst + idx);
#else
            dst[idx] = v;
#endif
        }
#if MK_HB_FENCE
        asm volatile("s_waitcnt vmcnt(0)" ::: "memory"); __syncthreads();
        if (MK_TID == 0) { __builtin_amdgcn_fence(__ATOMIC_RELEASE, "agent"); asm volatile("s_waitcnt vmcnt(0)" ::: "memory"); }
#endif
        xcd_barrier(bar);
        const u32x4* src = (const u32x4*)(a.ws + WS_P + (size_t)r * 262144);
#pragma unroll 8
        for (int i = 0; i < 32; ++i) { const unsigned idx = (unsigned)(MK_TID + 512 * i); const unsigned h = (unsigned)it * 0x9E3779B1u + (unsigned)r * 0x85EBCA77u + idx * 0xC2B2AE3Du;
            const u32x4 v = src[idx]; if (v.x != h || v.y != (h ^ 0x5555u) || v.z != h + 77u || v.w != ~h) { ++nb; if (first == 0xffffffffu) first = (unsigned)it; } }
        xcd_barrier(bar);
        { unsigned* sc = (unsigned*)(a.ws + WS_P + 64 * MiB);
#pragma unroll
          for (int j = 0; j < 8; ++j) { const unsigned e = (((unsigned)(c * 4096 + MK_TID * 8 + j)) * 2654435761u + (unsigned)it * 40503u) & 0xFFFFFu; sc[e] = (unsigned)it * 0x9E3779B1u + e; }
          xcd_barrier(bar);
          const u32x4 v0 = *(const u32x4*)(sc + c * 4096 + MK_TID * 8), v1 = *(const u32x4*)(sc + c * 4096 + MK_TID * 8 + 4); const unsigned e0 = (unsigned)(c * 4096 + MK_TID * 8), kk = (unsigned)it * 0x9E3779B1u;
          if (v0.x != kk + e0 || v0.y != kk + e0 + 1 || v0.z != kk + e0 + 2 || v0.w != kk + e0 + 3 || v1.x != kk + e0 + 4 || v1.y != kk + e0 + 5 || v1.z != kk + e0 + 6 || v1.w != kk + e0 + 7) ++nb2;
          xcd_barrier(bar); }
    }
    if (nb2) atomicAdd(ctl + 8195, nb2);
    if (nb) { atomicAdd(ctl + 8192, nb); atomicAdd(ctl + 8193, 1u); atomicMin(ctl + 8194, first); }
    xcd_barrier(bar);
    { const unsigned tot = __hip_atomic_load(ctl + 8192, __ATOMIC_RELAXED, __HIP_MEMORY_SCOPE_AGENT);
      const unsigned tot2 = __hip_atomic_load(ctl + 8195, __ATOMIC_RELAXED, __HIP_MEMORY_SCOPE_AGENT);
      if (tot != 0u || tot2 != 0u) { unsigned code = (tot != 0u) ? 1u : 41u, t = (tot != 0u) ? tot : tot2; while (t > 1u) { t >>= 1; ++code; }
          const float sc = 1.0f + (float)code; f32x4* q = (f32x4*)a.out; const size_t n = (size_t)NTOK * D / 4;
          for (size_t i = (size_t)blockIdx.x * 512 + MK_TID; i < n; i += (size_t)gridDim.x * 512) q[i] = q[i] * sc; } }
}
#endif
}

#ifdef MK_PROBE_ONLY
static const void* const fn_table[1] = {(const void*)mk::fwd<MK_PROBE_ONLY>};
constexpr int N_FN = 1;
#elif MK_ONE_LAUNCH
static const void* const fn_table[1] = {(const void*)mk::fwd<-1>};
constexpr int N_FN = 1;
#else
#define FN(k) (const void*)mk::fwd<k>
static const void* const fn_table[mk::NPH] = {FN(0), FN(1), FN(2), FN(3), FN(4), FN(5), FN(6), FN(7), FN(8), FN(9), FN(10), FN(11), FN(12), FN(13), FN(14), FN(15), FN(16), FN(17), FN(18), FN(19), FN(20), FN(21)};
constexpr int N_FN = mk::NPH;
#endif
extern "C" void kernel_launch(void* const* d_in, const int* in_sizes, int n_in, void* d_out, int out_size, void* d_ws, size_t ws_size, hipStream_t stream) {
    static int grid = 0;
    if (grid == 0) {
        if (n_in != 39 || ws_size < mk::WS_END) { fprintf(stderr, "kernel_launch: built for 39 inputs and >= %zu bytes of workspace; got n_in %d, ws %zu; nothing launched\n", (size_t)mk::WS_END, n_in, ws_size); grid = -1; return; }
        int dev = 0, cus = 0, per_cu = 0;
        if (hipGetDevice(&dev) != hipSuccess || hipDeviceGetAttribute(&cus, hipDeviceAttributeMultiprocessorCount, dev) != hipSuccess) { grid = -1; return; }
        for (int ph = 0; ph < N_FN; ++ph) if (hipFuncSetAttribute(fn_table[ph], hipFuncAttributeMaxDynamicSharedMemorySize, mk::LDS_BYTES) != hipSuccess) { fprintf(stderr, "kernel_launch: hipFuncSetAttribute failed\n"); grid = -1; return; }
        if (hipOccupancyMaxActiveBlocksPerMultiprocessor(&per_cu, fn_table[0], 512, mk::LDS_BYTES) != hipSuccess || per_cu < 1) fprintf(stderr, "kernel_launch: note: occupancy query reports %d workgroups per CU\n", per_cu);
        (void)hipGetLastError();
        grid = cus > 0 ? cus : 256;
    }
    if (grid < 0) return;
    (void)in_sizes; (void)out_size;
    if (hipMemsetAsync((char*)d_ws + mk::WS_CTL, 0, mk::CTL_ZERO, stream) != hipSuccess) return;
    mk::Args a{};
    for (int i = 0; i < 39; ++i) a.in[i] = (const float*)d_in[i];
    a.out = (float*)d_out; a.ws = (unsigned char*)d_ws;
    void* kargs[] = {&a};
#if defined(MK_HB)
    a.ph_lo = 0; a.ph_hi = mk::NPH;
    (void)hipLaunchKernel(fn_table[0], dim3(grid), dim3(512), kargs, mk::LDS_BYTES, stream);
    { static bool attr = false; if (!attr) { (void)hipFuncSetAttribute((const void*)mk::hb_kernel<0>, hipFuncAttributeMaxDynamicSharedMemorySize, mk::LDS_BYTES); attr = true; }
      (void)hipLaunchKernel((const void*)mk::hb_kernel<0>, dim3(grid), dim3(512), kargs, mk::LDS_BYTES, stream); }
#elif defined(MK_GSTRESS)
    for (int pass = 0; pass < MK_GSTRESS; ++pass) {
        if (pass > 0) { if (hipMemsetAsync((char*)d_ws, 0, 128 * 1024, stream) != hipSuccess) return; }
        if (pass > 0 && pass < MK_GSTRESS - 1) { if (hipMemsetAsync((char*)d_ws + mk::WS_P, 0xAA, 480 * mk::MiB, stream) != hipSuccess) return; }
        a.ph_lo = (pass == 0) ? 0 : ((pass == MK_GSTRESS - 1) ? 2 : 1); a.ph_hi = ((pass == MK_GSTRESS - 1) ? mk::NPH : 2) | (pass << 8);
        (void)hipLaunchKernel(fn_table[0], dim3(grid), dim3(512), kargs, mk::LDS_BYTES, stream); }
#elif defined(MK_SELFCHK)
    for (int pass = 0; pass < MK_SELFCHK; ++pass) {
        { if (pass > 0 && hipMemsetAsync((char*)d_ws, 0, 128 * 1024, stream) != hipSuccess) return;
            if (hipMemsetAsync((char*)d_ws + mk::MiB, 0xAA, mk::WS_END - mk::MiB, stream) != hipSuccess) return; if (hipMemsetAsync(d_out, 0xAA, (size_t)mk::NTOK * mk::D * 4, stream) != hipSuccess) return; }
        a.ph_lo = 0; a.ph_hi = mk::NPH | (pass << 8);
        (void)hipLaunchKernel(fn_table[0], dim3(grid), dim3(512), kargs, mk::LDS_BYTES, stream); }
#elif MK_ONE_LAUNCH
    a.ph_lo = 0; a.ph_hi = mk::NPH;
    (void)hipLaunchKernel(fn_table[0], dim3(grid), dim3(512), kargs, mk::LDS_BYTES, stream);
#else
    for (int ph = 0; ph < mk::NPH; ++ph) { a.ph_lo = ph; a.ph_hi = ph + 1; (void)hipLaunchKernel(fn_table[ph], dim3(grid), dim3(512), kargs, mk::LDS_BYTES, stream); }
#endif
}
```

```cpp
#include <hip/hip_runtime.h>
#include <cstdio>
#include <cstdint>
#define MK_ONE_LAUNCH 1
#define MK_DUP -1
#define MK_RWKV_WP 0
#define MK_S5_DYN 1
#define MK_S5_SEP 0
#define MK_S5_SC1 1
#define MK_S5_NT 0
#define MK_S5_PAIR 2
#define MK_S5_ACQ 0
#define MK_S5_FIRST 0
#define MK_INPROJ_ALIGN true
#define MK_MOE_BAR 0
#define MK_S5_NTP 0
#define MK_S5_REL 0
#define MK_S5_SC1ST 0
#define MK_UNITCMP 1
#define MK_S5_SCOPE __HIP_MEMORY_SCOPE_AGENT
namespace pg8 {
#define PG8_LAS __attribute__((address_space(3)))
typedef unsigned short bf16_t;
typedef short bf16x8 __attribute__((ext_vector_type(8)));
typedef float f32x4 __attribute__((ext_vector_type(4)));
typedef unsigned u32x4 __attribute__((ext_vector_type(4)));
constexpr int BM = 256, BK = 64, HALF = 128, HTB = HALF * BK * 2  , STAGE_BYTES = 8 * HTB, NXCD = 8, WGM = 4;

__host__ __device__ __forceinline__ int lds_byte(int r, int c) { const int st = (r >> 4) * 2 + (c >> 5), rr = r & 15, cc = c & 31, ob = rr * 64 + cc * 2; return st * 1024 + (ob ^ (((ob >> 9) & 1) << 5)); }
__host__ __device__ __forceinline__ void stage_rc(int b, int& R, int& C) { const int st = b / 1024, sb = b % 1024, swz = sb ^ (((sb >> 9) & 1) << 5); R = (st >> 1) * 16 + swz / 64; C = (st & 1) * 32 + (swz % 64) / 2; }
__host__ __device__ __forceinline__ int perm32(int rho) { const int n = rho >> 4, i = rho & 15; return 8 * (i >> 2) + 4 * n + (i & 3); }

struct Unit { int pm, pn; };
struct Gemm { const bf16_t* A; const bf16_t* Bt; int M, N, K; };

struct StaticOrder {
    int nM, nN, nwg, G, c;
    __host__ __device__ void init(int M, int N, int G_, int c_) { nM = M / BM; nN = N / BM; nwg = nM * nN; G = G_; c = c_; }
    __host__ __device__ bool next(int i, Unit& u) const {
        const long L = (long)i * G + c; if (L >= nwg) return false;
        int wgid = (int)L; { const int q = nwg / NXCD, r = nwg % NXCD, xcd = wgid % NXCD, off = wgid / NXCD; wgid = (xcd < r ? xcd * (q + 1) : r * (q + 1) + (xcd - r) * q) + off; }
        const int nig = WGM * nN, gid = wgid / nig, fm = gid * WGM, gsz = (nM - fm) < WGM ? (nM - fm) : WGM;
        u.pm = fm + ((wgid % nig) % gsz); u.pn = (wgid % nig) / gsz; return true;
    }
    __device__ __forceinline__ void a_ready(const Unit&) const {}
    __device__ __forceinline__ void done(const Unit&) const {}
};

__device__ __forceinline__ unsigned cvt_pk_bf16(float lo, float hi) { unsigned r; asm volatile("v_cvt_pk_bf16_f32 %0, %1, %2" : "=v"(r) : "v"(lo), "v"(hi)); return r; }
typedef float f32x2 __attribute__((ext_vector_type(2)));
typedef unsigned u32x2 __attribute__((ext_vector_type(2)));
__device__ __forceinline__ float fsigmoid(float x) { return __builtin_amdgcn_rcpf(1.0f + __expf(-x)); }
__device__ __forceinline__ float bflo(unsigned w) { return __uint_as_float(w << 16); }
__device__ __forceinline__ float bfhi(unsigned w) { return __uint_as_float(w & 0xffff0000u); }

struct EpiStoreBf16 {
    static constexpr bool PERM = true, AFTER_DRAIN = false;
    bf16_t* O; int ldc; int colmask;
    __device__ __forceinline__ void operator()(const f32x4 (&acc)[2][2][4][2], const Unit& u, int wr, int wc, int fr, int fq) const {
        const int row0 = u.pm * BM + wr * 64 + fr, col0 = (u.pn & colmask) * BM + wc * 32 + 8 * fq;
#pragma unroll
        for (int ai = 0; ai < 2; ++ai)
#pragma unroll
            for (int m = 0; m < 4; ++m) { bf16_t* rowp = O + (size_t)(row0 + ai * HALF + m * 16) * ldc + col0;
#pragma unroll
                for (int bj = 0; bj < 2; ++bj) { const f32x4 v0 = acc[ai][bj][m][0], v1 = acc[ai][bj][m][1];
                    u32x4 w; w.x = cvt_pk_bf16(v0[0], v0[1]); w.y = cvt_pk_bf16(v0[2], v0[3]); w.z = cvt_pk_bf16(v1[0], v1[1]); w.w = cvt_pk_bf16(v1[2], v1[3]);
                    *(u32x4*)(rowp + bj * HALF) = w; } }
    }
};
struct EpiResF32 {
    static constexpr bool PERM = false, AFTER_DRAIN = false;
    const float* base; float* out; int ldc;
    __device__ __forceinline__ void operator()(const f32x4 (&acc)[2][2][4][2], const Unit& u, int wr, int wc, int fr, int fq) const {
        const int row0 = u.pm * BM + wr * 64 + fr, col0 = u.pn * BM + wc * 32 + 4 * fq;
#pragma unroll
        for (int ai = 0; ai < 2; ++ai)
#pragma unroll
            for (int m = 0; m < 4; ++m) { const size_t off = (size_t)(row0 + ai * HALF + m * 16) * ldc + col0;
#pragma unroll
                for (int bj = 0; bj < 2; ++bj)
#pragma unroll
                    for (int n = 0; n < 2; ++n) { const f32x4 b = *(const f32x4*)(base + off + bj * HALF + n * 16); *(f32x4*)(out + off + bj * HALF + n * 16) = b + acc[ai][bj][m][n]; } }
    }
};
struct EpiGlu {
    static constexpr bool PERM = true, AFTER_DRAIN = false;
    const bf16_t* Z; int ldz; const float* bias; bf16_t* O; int ldo;
    __device__ __forceinline__ void operator()(const f32x4 (&acc)[2][2][4][2], const Unit& u, int wr, int wc, int fr, int fq) const {
        const int row0 = u.pm * BM + wr * 64 + fr, col0 = u.pn * BM + wc * 32 + 8 * fq;
#pragma unroll
        for (int ai = 0; ai < 2; ++ai)
#pragma unroll
            for (int m = 0; m < 4; ++m) { const int row = row0 + ai * HALF + m * 16;
#pragma unroll
                for (int bj = 0; bj < 2; ++bj) { const int col = col0 + bj * HALF;
                    const u32x4 z = *(const u32x4*)(Z + (size_t)row * ldz + col); const f32x4 b0 = *(const f32x4*)(bias + col), b1 = *(const f32x4*)(bias + col + 4);
                    const f32x4 v0 = acc[ai][bj][m][0] + b0, v1 = acc[ai][bj][m][1] + b1;
                    u32x4 w; w.x = cvt_pk_bf16(bflo(z.x) * fsigmoid(v0[0]), bfhi(z.x) * fsigmoid(v0[1])); w.y = cvt_pk_bf16(bflo(z.y) * fsigmoid(v0[2]), bfhi(z.y) * fsigmoid(v0[3]));
                    w.z = cvt_pk_bf16(bflo(z.z) * fsigmoid(v1[0]), bfhi(z.z) * fsigmoid(v1[1])); w.w = cvt_pk_bf16(bflo(z.w) * fsigmoid(v1[2]), bfhi(z.w) * fsigmoid(v1[3]));
                    *(u32x4*)(O + (size_t)row * ldo + col) = w; } }
    }
};
struct EpiSwiGlu {
    static constexpr bool PERM = true, AFTER_DRAIN = false;
    bf16_t* HID; const float* rsp;
    __device__ __forceinline__ void operator()(const f32x4 (&acc)[2][2][4][2], const Unit& u, int wr, int wc, int fr, int fq) const {
        const int row0 = u.pm * BM + wr * 64 + fr, col0 = (u.pn & 3) * HALF + wc * 32 + 8 * fq;
#pragma unroll
        for (int ai = 0; ai < 2; ++ai)
#pragma unroll
            for (int m = 0; m < 4; ++m) { const int row = row0 + ai * HALF + m * 16;
                const float rs = rsp[row]; const f32x4 g0 = acc[ai][0][m][0] * rs, g1 = acc[ai][0][m][1] * rs, u0 = acc[ai][1][m][0] * rs, u1 = acc[ai][1][m][1] * rs;
                u32x4 w;
                w.x = cvt_pk_bf16(g0[0] * fsigmoid(g0[0]) * u0[0], g0[1] * fsigmoid(g0[1]) * u0[1]); w.y = cvt_pk_bf16(g0[2] * fsigmoid(g0[2]) * u0[2], g0[3] * fsigmoid(g0[3]) * u0[3]);
                w.z = cvt_pk_bf16(g1[0] * fsigmoid(g1[0]) * u1[0], g1[1] * fsigmoid(g1[1]) * u1[1]); w.w = cvt_pk_bf16(g1[2] * fsigmoid(g1[2]) * u1[2], g1[3] * fsigmoid(g1[3]) * u1[3]);
                *(u32x4*)(HID + (size_t)row * 512 + col0) = w; }
    }
};
struct MoeOrder {
    const int* tile_e; int ntot, NT, G, c;
    __device__ __forceinline__ bool next(int i, Unit& u) const { const long L = (long)i * G + c; if (L >= ntot) return false; const int pm = (int)(L / NT), nt = (int)(L % NT); u.pm = pm; u.pn = tile_e[pm] * NT + nt; return true; }
    __device__ __forceinline__ void a_ready(const Unit&) const {}
    __device__ __forceinline__ void done(const Unit&) const {}
};

struct MoeGatherOrder {
    const int* tile_e; int ntot, NT, G, c; const int* rowtok; int ntok;
    __device__ __forceinline__ bool next(int i, Unit& u) const { const long L = (long)i * G + c; if (L >= ntot) return false; const int pm = (int)(L / NT), nt = (int)(L % NT); u.pm = pm; u.pn = tile_e[pm] * NT + nt; return true; }
    __device__ __forceinline__ void a_ready(const Unit&) const {}
    __device__ __forceinline__ void done(const Unit&) const {}
};

template <class Epi, class Sched, bool ALIGN_EPI = false, bool SP2 = false, bool GATHER = false>
__device__ __forceinline__ void gemm_phase(PG8_LAS unsigned char* lds, const Gemm g, const Sched& S, const Epi& E) {
    int tid_ = threadIdx.x; asm volatile("" : "+v"(tid_));
    const int tid = tid_, wid = __builtin_amdgcn_readfirstlane(tid >> 6), lane = tid & 63, wr = wid >> 2, wc = wid & 3, fr = lane & 15, fq = lane >> 4;
    const int K = g.K, nt = K / BK;
    unsigned voffA[2], voffB[2];
#pragma unroll
    for (int i = 0; i < 2; ++i) { int R, C; stage_rc(tid * 16 + i * 8192, R, C); const int Rb = Epi::PERM ? ((R & ~31) + perm32(R & 31)) : R;
        voffA[i] = (unsigned)(R * K + C) * 2u; voffB[i] = (unsigned)(Rb * K + C) * 2u; }
    static_assert(!GATHER || SP2, "gather needs the SP2 loop");
    unsigned vA[2][2] = {{0u, 0u}, {0u, 0u}}, vN[2][2] = {{0u, 0u}, {0u, 0u}};
#define PG8_GOFF(u_, v_) do { _Pragma("unroll") for (int h_ = 0; h_ < 2; ++h_) _Pragma("unroll") for (int i_ = 0; i_ < 2; ++i_) { int R_, C_; stage_rc(tid * 16 + i_ * 8192, R_, C_); \
        int tok_ = 0; if constexpr (GATHER) { tok_ = S.rowtok[(u_).pm * BM + h_ * HALF + R_]; if ((unsigned)tok_ >= (unsigned)S.ntok) tok_ = 0; } v_[h_][i_] = (unsigned)(tok_ * K + C_) * 2u; } } while (0)
    const size_t kstep = (size_t)(BK * 2);
    const size_t hstep = (size_t)HALF * K * 2;
    const size_t tstep = 2 * hstep;
    const unsigned ldsw = (unsigned)wid * 1024u;
    const int aoff = lds_byte(wr * 64 + fr, fq * 8), boff = lds_byte(wc * 32 + fr, fq * 8);
#define PG8_SA(b, h) (((b) * 2 + (h)) * HTB)
#define PG8_SB(b, h) ((4 + (b) * 2 + (h)) * HTB)
#define PG8_STAGE(bufoff, gbase, voff) do { _Pragma("unroll") for (int _i = 0; _i < 2; ++_i) \
        __builtin_amdgcn_global_load_lds((const unsigned*)((const char*)(gbase) + (voff)[_i]), (PG8_LAS unsigned*)(lds + (bufoff) + ldsw + _i * 8192), 16, 0, 0); } while (0)
#define PG8_STAGE_A(bufoff, kb_, h_, nx_) do { if constexpr (GATHER) { if (nx_) PG8_STAGE(bufoff, (const char*)g.A + (kb_), vN[h_]); else PG8_STAGE(bufoff, (const char*)g.A + (kb_), vA[h_]); } \
        else PG8_STAGE(bufoff, ((nx_) ? nA : cA) + (kb_) + (h_) * hstep, voffA); } while (0)
#define PG8_LDA(dst, b, h) do { _Pragma("unroll") for (int m = 0; m < 4; ++m) _Pragma("unroll") for (int k = 0; k < 2; ++k) dst[m][k] = *(const PG8_LAS bf16x8*)(lds + PG8_SA(b, h) + aoff + m * 2048 + k * 1024); } while (0)
#define PG8_LDB(dst, b, h) do { _Pragma("unroll") for (int n = 0; n < 2; ++n) _Pragma("unroll") for (int k = 0; k < 2; ++k) dst[n][k] = *(const PG8_LAS bf16x8*)(lds + PG8_SB(b, h) + boff + n * 2048 + k * 1024); } while (0)
#define PG8_MMA(ai, bj, At, Bt) do { __builtin_amdgcn_s_setprio(1); _Pragma("unroll") for (int m = 0; m < 4; ++m) _Pragma("unroll") for (int n = 0; n < 2; ++n) _Pragma("unroll") for (int k = 0; k < 2; ++k) \
        acc[ai][bj][m][n] = __builtin_amdgcn_mfma_f32_16x16x32_bf16(Bt[n][k], At[m][k], acc[ai][bj][m][n], 0, 0, 0); __builtin_amdgcn_s_setprio(0); } while (0)
#define PG8_WAIT_V(n) asm volatile("s_waitcnt vmcnt(" #n ")" ::: "memory")
#define PG8_WAIT_L(n) asm volatile("s_waitcnt lgkmcnt(" #n ")" ::: "memory")
#define PG8_BAR __builtin_amdgcn_s_barrier()
#define PG8_SCHED __builtin_amdgcn_sched_barrier(0)
    Unit cur, nxt; int ui = 0;
    if (!S.next(0, cur)) return;
    f32x4 acc[2][2][4][2];
#pragma unroll
    for (int a = 0; a < 2; ++a)
#pragma unroll
        for (int b = 0; b < 2; ++b)
#pragma unroll
            for (int m = 0; m < 4; ++m)
#pragma unroll
                for (int n = 0; n < 2; ++n) acc[a][b][m][n] = (f32x4){0.f, 0.f, 0.f, 0.f};
    bf16x8 At[4][2], B0[2][2], B1[2][2];
    const char* cA = (const char*)g.A + (size_t)cur.pm * tstep; const char* cB = (const char*)g.Bt + (size_t)cur.pn * tstep;
    S.a_ready(cur);
    if constexpr (SP2) {
        const char* nA = cA; (void)nA;
        if constexpr (GATHER) PG8_GOFF(cur, vA);
        PG8_STAGE(PG8_SB(0, 0), cB, voffB); PG8_STAGE(PG8_SB(0, 1), cB + hstep, voffB); PG8_STAGE_A(PG8_SA(0, 0), (size_t)0, 0, false); PG8_STAGE_A(PG8_SA(0, 1), (size_t)0, 1, false);
        if (wr == 1) PG8_BAR;
        PG8_WAIT_V(2); PG8_BAR;
        PG8_STAGE(PG8_SB(1, 0), cB + kstep, voffB); PG8_STAGE_A(PG8_SA(1, 0), kstep, 0, false); PG8_STAGE(PG8_SB(1, 1), cB + hstep + kstep, voffB);
        PG8_WAIT_V(6); PG8_BAR;
    } else {
        PG8_STAGE(PG8_SB(0, 0), cB, voffB); PG8_STAGE(PG8_SA(0, 0), cA, voffA); PG8_STAGE(PG8_SB(0, 1), cB + hstep, voffB); PG8_STAGE(PG8_SA(0, 1), cA + hstep, voffA);
        if (wr == 1) PG8_BAR;
        PG8_WAIT_V(4); PG8_BAR;
        PG8_STAGE(PG8_SB(1, 0), cB + kstep, voffB); PG8_STAGE(PG8_SA(1, 0), cA + kstep, voffA); PG8_STAGE(PG8_SB(1, 1), cB + hstep + kstep, voffB);
        PG8_WAIT_V(6); PG8_BAR;
    }
    for (;;) {
        const bool has_next = S.next(ui + 1, nxt);
        const char* nA = has_next ? (const char*)g.A + (size_t)nxt.pm * tstep : cA; const char* nB = has_next ? (const char*)g.Bt + (size_t)nxt.pn * tstep : cB;
        if constexpr (GATHER) { if (has_next) PG8_GOFF(nxt, vN); else { vN[0][0] = vA[0][0]; vN[0][1] = vA[0][1]; vN[1][0] = vA[1][0]; vN[1][1] = vA[1][1]; } }
        for (int t = 0; t < nt; t += 2) {
            const bool last = (t == nt - 2);
            const char* a1 = cA + (size_t)(t + 1) * kstep;
            const char* a2 = last ? nA : cA + (size_t)(t + 2) * kstep; const char* b2 = last ? nB : cB + (size_t)(t + 2) * kstep;
            const char* a3 = a2 + kstep; const char* b3 = b2 + kstep; (void)a1; (void)a3;
            const size_t k2 = last ? (size_t)0 : (size_t)(t + 2) * kstep;
            if (last && has_next) S.a_ready(nxt);
            if constexpr (SP2) {
            PG8_LDB(B0, 0, 0); PG8_LDB(B1, 0, 1); PG8_SCHED; PG8_LDA(At, 0, 0); PG8_STAGE_A(PG8_SA(1, 1), (size_t)(t + 1) * kstep, 1, false);
            PG8_WAIT_V(8); PG8_WAIT_L(0); PG8_BAR; PG8_MMA(0, 0, At, B0); PG8_MMA(0, 1, At, B1); PG8_BAR; PG8_SCHED;
            PG8_LDA(At, 0, 1); PG8_STAGE(PG8_SB(0, 0), b2, voffB); PG8_STAGE(PG8_SB(0, 1), b2 + hstep, voffB); PG8_STAGE_A(PG8_SA(0, 0), k2, 0, last);
            PG8_WAIT_V(8); PG8_WAIT_L(0); PG8_BAR; PG8_MMA(1, 0, At, B0); PG8_MMA(1, 1, At, B1); PG8_BAR; PG8_SCHED;
            PG8_LDB(B0, 1, 0); PG8_LDB(B1, 1, 1); PG8_SCHED; PG8_LDA(At, 1, 0); PG8_STAGE_A(PG8_SA(0, 1), k2, 1, last);
            PG8_WAIT_V(8); PG8_WAIT_L(0); PG8_BAR; PG8_MMA(0, 0, At, B0); PG8_MMA(0, 1, At, B1); PG8_BAR; PG8_SCHED;
            PG8_LDA(At, 1, 1); PG8_STAGE(PG8_SB(1, 0), b3, voffB); PG8_STAGE(PG8_SB(1, 1), b3 + hstep, voffB); PG8_STAGE_A(PG8_SA(1, 0), k2 + kstep, 0, last);
            PG8_WAIT_V(8); PG8_WAIT_L(0); PG8_BAR; PG8_MMA(1, 0, At, B0); PG8_MMA(1, 1, At, B1); PG8_BAR; PG8_SCHED;
            } else {
            PG8_LDB(B0, 0, 0); PG8_SCHED; PG8_LDA(At, 0, 0); PG8_STAGE(PG8_SA(1, 1), a1 + hstep, voffA);
            PG8_WAIT_L(8); PG8_BAR; PG8_WAIT_L(0); PG8_MMA(0, 0, At, B0); PG8_BAR; PG8_SCHED;
            PG8_LDB(B1, 0, 1); PG8_STAGE(PG8_SB(0, 0), b2, voffB);
            PG8_BAR; PG8_WAIT_L(0); PG8_MMA(0, 1, At, B1); PG8_BAR;
            PG8_LDA(At, 0, 1); PG8_STAGE(PG8_SA(0, 0), a2, voffA);
            PG8_BAR; PG8_WAIT_L(0); PG8_MMA(1, 0, At, B0); PG8_BAR; PG8_SCHED;
            PG8_STAGE(PG8_SB(0, 1), b2 + hstep, voffB);
            PG8_WAIT_V(6); PG8_BAR; PG8_MMA(1, 1, At, B1); PG8_BAR;
            PG8_LDB(B0, 1, 0); PG8_SCHED; PG8_LDA(At, 1, 0); PG8_STAGE(PG8_SA(0, 1), a2 + hstep, voffA);
            PG8_WAIT_L(8); PG8_BAR; PG8_WAIT_L(0); PG8_MMA(0, 0, At, B0); PG8_BAR; PG8_SCHED;
            PG8_LDB(B1, 1, 1); PG8_STAGE(PG8_SB(1, 0), b3, voffB);
            PG8_BAR; PG8_WAIT_L(0); PG8_MMA(0, 1, At, B1); PG8_BAR;
            PG8_LDA(At, 1, 1); PG8_STAGE(PG8_SA(1, 0), a3, voffA);
            PG8_BAR; PG8_WAIT_L(0); PG8_MMA(1, 0, At, B0); PG8_BAR; PG8_SCHED;
            PG8_STAGE(PG8_SB(1, 1), b3 + hstep, voffB);
            PG8_WAIT_V(6); PG8_BAR; PG8_MMA(1, 1, At, B1); PG8_BAR;
            }
        }
        if constexpr (ALIGN_EPI) { if (wr == 0) PG8_BAR; }
        if constexpr (!Epi::AFTER_DRAIN) { E(acc, cur, wr, wc, fr, fq); S.done(cur); }
        if (!has_next) break;
#pragma unroll
        for (int a = 0; a < 2; ++a)
#pragma unroll
            for (int b = 0; b < 2; ++b)
#pragma unroll
                for (int m = 0; m < 4; ++m)
#pragma unroll
                    for (int n = 0; n < 2; ++n) acc[a][b][m][n] = (f32x4){0.f, 0.f, 0.f, 0.f};
        cur = nxt; cA = nA; cB = nB; ++ui;
        if constexpr (GATHER) { vA[0][0] = vN[0][0]; vA[0][1] = vN[0][1]; vA[1][0] = vN[1][0]; vA[1][1] = vN[1][1]; }
        if constexpr (ALIGN_EPI) { if (wr == 1) PG8_BAR; }
    }
    PG8_WAIT_V(0);
    if constexpr (!ALIGN_EPI) { if (wr == 0) PG8_BAR; }
    PG8_BAR;
    if constexpr (Epi::AFTER_DRAIN) { E.fused(acc, cur, wr, wc, fr, fq, lds, wid, lane); S.done(cur); }
#undef PG8_SA
#undef PG8_SB
#undef PG8_STAGE
#undef PG8_STAGE_A
#undef PG8_GOFF
#undef PG8_LDA
#undef PG8_LDB
#undef PG8_MMA
#undef PG8_WAIT_V
#undef PG8_WAIT_L
#undef PG8_BAR
#undef PG8_SCHED
}
}
#define XB_TMO      128
#define XB_XCNT(j)  (256  + 64 * (j))
#define XB_XSUB(j)  (1280 + 64 * (j))
#define XB_XGEN(j)  (2304 + 64 * (j))
#define XB_TOP      3328
#define XB_TOPGEN   3392
#define XCD_BAR_WORDS 3456
#define XB_SPIN_CAP (1u << 22)
#define LAS __attribute__((address_space(3)))

__device__ __forceinline__ unsigned xb_ld(unsigned* p)              { return __hip_atomic_load(p, __ATOMIC_RELAXED, __HIP_MEMORY_SCOPE_AGENT); }
__device__ __forceinline__ unsigned xb_add(unsigned* p, unsigned v) { return __hip_atomic_fetch_add(p, v, __ATOMIC_RELAXED, __HIP_MEMORY_SCOPE_AGENT); }
__device__ __forceinline__ unsigned xb_xcc_id() { return (unsigned)__builtin_amdgcn_s_getreg((3 << 11) | 20) & 0xFu; }
#define XB_SPIN(cond, bar) do { unsigned _sp = 0; while (cond) { __builtin_amdgcn_s_sleep(1); \
    if ((++_sp & 255u) == 0u) { if (xb_ld(&(bar)[XB_TMO])) break; if (_sp > XB_SPIN_CAP) { atomicAdd(&(bar)[XB_TMO], 1u); break; } } } } while (0)

struct XcdBarrier {
    unsigned* bar; unsigned x;
    volatile LAS unsigned* st;
};

__device__ __forceinline__ XcdBarrier xcd_barrier_post(unsigned* bar, volatile LAS unsigned* st) {
    XcdBarrier b; b.bar = bar; b.x = xb_xcc_id(); b.st = st;
    if (threadIdx.x == 0) (void)xb_add(&bar[XB_XCNT(b.x)], 1u);
    return b;
}
__device__ __forceinline__ void xcd_barrier_complete(unsigned* bar, unsigned x, unsigned& nloc, unsigned& nx) {
    const unsigned G = gridDim.x * gridDim.y * gridDim.z;
    unsigned sum, cnt, mine, sp = 0u;
    for (;;) {
        sum = 0u; cnt = 0u; mine = 0u;
#pragma unroll
        for (unsigned j = 0; j < 16; ++j) { const unsigned c = xb_ld(&bar[XB_XCNT(j)]); sum += c; cnt += (c > 0u) ? 1u : 0u; mine = (j == x) ? c : mine; }
        if (sum == G) break;
        __builtin_amdgcn_s_sleep(1);
        if ((++sp & 255u) == 0u) { if (xb_ld(&bar[XB_TMO])) break; if (sp > XB_SPIN_CAP) { atomicAdd(&bar[XB_TMO], 1u); break; } }
    }
    nloc = mine > 0u ? mine : 1u; nx = cnt > 0u ? cnt : 1u;
}

__device__ __forceinline__ void xcd_barrier(const XcdBarrier& b) {
    asm volatile("s_waitcnt vmcnt(0)" ::: "memory");
    __syncthreads();
    if (threadIdx.x == 0) {
        unsigned* bar = b.bar;
        __builtin_amdgcn_s_waitcnt(0);
        unsigned nloc = b.st[0], nx = b.st[1];
        if (nloc == 0u) { xcd_barrier_complete(bar, b.x, nloc, nx); b.st[0] = nloc; b.st[1] = nx; }
        const unsigned old = xb_add(&bar[XB_XSUB(b.x)], 1u);
        const unsigned gen = old / nloc;
        if (old + 1u == (gen + 1u) * nloc) {
            __builtin_amdgcn_fence(__ATOMIC_RELEASE, "agent");
            asm volatile("s_waitcnt vmcnt(0)" ::: "memory");
            const unsigned og = xb_add(&bar[XB_TOP], 1u);
            const unsigned tg = og / nx;
            if (og + 1u == (tg + 1u) * nx) xb_add(&bar[XB_TOPGEN], 1u);
            else XB_SPIN(xb_ld(&bar[XB_TOPGEN]) == tg, bar);
            __builtin_amdgcn_fence(__ATOMIC_ACQUIRE, "agent");
            xb_add(&bar[XB_XGEN(b.x)], 1u);
            asm volatile("s_waitcnt vmcnt(0)" ::: "memory");
        } else {
            XB_SPIN(xb_ld(&bar[XB_XGEN(b.x)]) == gen, bar);
            __builtin_amdgcn_fence(__ATOMIC_ACQUIRE, "agent");
            asm volatile("s_waitcnt vmcnt(0)" ::: "memory");
        }
    }
    __syncthreads();
}

namespace mk {
using pg8::bf16_t; using pg8::f32x4; using pg8::u32x4; using pg8::u32x2; using pg8::cvt_pk_bf16; using pg8::bflo; using pg8::bfhi; using pg8::fsigmoid;
#define MK_LAS __attribute__((address_space(3)))
__device__ __forceinline__ int otid() { int t = threadIdx.x; asm volatile("" : "+v"(t)); return t; }
#define MK_TID otid()

constexpr int NB = 2, T = 16384, D = 2048, NTOK = NB * T;
constexpr int AB_COLS = 7616, AB_LD = 7680, RWO = 4096;
constexpr int CD_COLS = 4104, CD_LD = 4096;
constexpr int NEXP = 32, FF = 512, ROWS_MAX = 2 * NTOK + NEXP * 256;
constexpr float NORM_EPS = 1e-6f;

constexpr size_t MiB = 1u << 20;
constexpr size_t WS_CTL = 0, CTL_ZERO = 1 * MiB;
constexpr size_t WS_HIST = 1 * MiB, WS_TILEE = 1 * MiB + 64 * 1024, WS_NT = 1 * MiB + 96 * 1024;
constexpr size_t WS_RE = 2 * MiB, WS_RWT = 3 * MiB, WS_POS = 4 * MiB, WS_LOGF = 5 * MiB, WS_CUM = 6 * MiB;
constexpr size_t WS_ABIN = 16 * MiB, WS_ABOUT = 46 * MiB, WS_CDIN = 54 * MiB, WS_CDOUT = 70 * MiB, WS_GLU = 78 * MiB;
constexpr size_t WS_GU = 80 * MiB, WS_DN = 208 * MiB;
constexpr size_t WS_H = 272 * MiB, WS_O = 400 * MiB, WS_P = 528 * MiB, WS_SCR = 1008 * MiB, WS_END = 1136 * MiB;
constexpr size_t WS_HID = WS_P + 288 * MiB;

constexpr int LDS_RING = 128 * 1024, LDS_MISC = 144 * 1024, LDS_BYTES = LDS_MISC + 4096;

struct Args { const float* in[39]; float* out; unsigned char* ws; int ph_lo, ph_hi; };
enum { I_X = 0, I_MIXW, I_FFNW, I_FINW, I_ABIN, I_ABOUT, I_HGLB, I_HGNW, I_RWMU, I_RWW0, I_RWW2, I_RWA0, I_RWA2, I_RWG2, I_RWKK, I_RWKA, I_RWRK, I_RWLNW, I_RWLNB,
       I_CDIN, I_CDOUT, I_S5LR, I_S5LI, I_S5DT, I_S5BR, I_S5BI, I_S5CR, I_S5CI, I_S5D, I_S5GLU, I_S5BG, I_FOXB, I_MWG, I_MBG, I_MWR, I_MBR, I_MGATE, I_MUP, I_MDOWN };

__device__ __forceinline__ float bf2f(bf16_t v) { return __uint_as_float((unsigned)v << 16); }
__device__ __forceinline__ float wave_sum(float v) {
#pragma unroll
    for (int o = 32; o > 0; o >>= 1) v += __shfl_xor(v, o); return v; }
__device__ __forceinline__ float wave_max(float v) {
#pragma unroll
    for (int o = 32; o > 0; o >>= 1) v = fmaxf(v, __shfl_xor(v, o)); return v; }
__device__ __forceinline__ float softplusf(float x) { return fmaxf(x, 0.f) + log1pf(__expf(-fabsf(x))); }
__device__ __forceinline__ float siluf(float x) { return x * fsigmoid(x); }
__device__ __forceinline__ float gelu_tanh(float y) { const float u2 = 1.5957691216057308f * (y + 0.044715f * y * y * y); return y * fsigmoid(u2); }

struct TileDesc { const float* src; bf16_t* dst; int ldn, k0, n0, nvalid, K, row0; };
__device__ __forceinline__ void tile_load(const TileDesc& d, f32x4 (&v)[2]) {
    const int tid = MK_TID;
#pragma unroll
    for (int i = 0; i < 2; ++i) { const int k = (tid >> 4) + 32 * i, n4 = (tid & 15) * 4;
        v[i] = (f32x4){0.f, 0.f, 0.f, 0.f}; if (d.n0 + n4 < d.nvalid) v[i] = *(const f32x4*)(d.src + (size_t)(d.k0 + k) * d.ldn + d.n0 + n4); }
}
__device__ __forceinline__ void tile_store(const TileDesc& d, const f32x4 (&v)[2], MK_LAS float* scr) {
    const int tid = MK_TID;
#pragma unroll
    for (int i = 0; i < 2; ++i) { const int k = (tid >> 4) + 32 * i, n4 = (tid & 15) * 4;
        scr[(n4 + 0) * 65 + k] = v[i][0]; scr[(n4 + 1) * 65 + k] = v[i][1]; scr[(n4 + 2) * 65 + k] = v[i][2]; scr[(n4 + 3) * 65 + k] = v[i][3]; }
    __syncthreads();
    { const int n = tid >> 3, k8 = (tid & 7) * 8; const MK_LAS float* s = scr + n * 65 + k8;
      u32x4 w; w.x = cvt_pk_bf16(s[0], s[1]); w.y = cvt_pk_bf16(s[2], s[3]); w.z = cvt_pk_bf16(s[4], s[5]); w.w = cvt_pk_bf16(s[6], s[7]);
      *(u32x4*)(d.dst + (size_t)(d.row0 + n) * d.K + d.k0 + k8) = w; }
    __syncthreads();
}
constexpr int IT_ABIN = 32 * 120, IT_ABOUT = 32 * 32, IT_CDIN = 32 * 64, IT_CDOUT = 32 * 32, IT_GLU = 16 * 16, IT_PROJ = IT_ABIN + IT_ABOUT + IT_CDIN + IT_CDOUT + IT_GLU;
constexpr int IT_GU = 32 * 32 * 16, IT_DN = 32 * 8 * 32, IT_MOE = IT_GU + IT_DN;
__device__ __forceinline__ TileDesc proj_item(const Args& a, int r) {
    unsigned char* ws = a.ws;
    if (r < IT_ABIN) return TileDesc{a.in[I_ABIN], (bf16_t*)(ws + WS_ABIN), AB_COLS, (r / 120) * 64, (r % 120) * 64, AB_COLS, D, (r % 120) * 64}; r -= IT_ABIN;
    if (r < IT_ABOUT) return TileDesc{a.in[I_ABOUT], (bf16_t*)(ws + WS_ABOUT), D, (r / 32) * 64, (r % 32) * 64, D, D, (r % 32) * 64}; r -= IT_ABOUT;
    if (r < IT_CDIN) return TileDesc{a.in[I_CDIN], (bf16_t*)(ws + WS_CDIN), CD_COLS, (r / 64) * 64, (r % 64) * 64, CD_COLS, D, (r % 64) * 64}; r -= IT_CDIN;
    if (r < IT_CDOUT) return TileDesc{a.in[I_CDOUT], (bf16_t*)(ws + WS_CDOUT), D, (r / 32) * 64, (r % 32) * 64, D, D, (r % 32) * 64}; r -= IT_CDOUT;
    return TileDesc{a.in[I_S5GLU], (bf16_t*)(ws + WS_GLU), 1024, (r / 16) * 64, (r % 16) * 64, 1024, 1024, (r % 16) * 64};
}
__device__ __forceinline__ TileDesc moe_item(const Args& a, int layer, int r) {
    unsigned char* ws = a.ws;
    if (r < IT_GU) { const int e = r / 512, rem = r % 512, kt = rem / 16, q = rem % 16, j = q >> 2, half = (q >> 1) & 1, sub = q & 1;
        const float* src = (half ? a.in[I_MUP] : a.in[I_MGATE]) + (size_t)(layer * NEXP + e) * D * FF;
        return TileDesc{src, (bf16_t*)(ws + WS_GU), FF, kt * 64, 128 * j + 64 * sub, FF, D, e * 1024 + 256 * j + 128 * half + 64 * sub}; }
    r -= IT_GU;
    { const int e = r / 256, rem = r % 256, kt = rem / 32, nt = rem % 32;
      const float* src = a.in[I_MDOWN] + (size_t)(layer * NEXP + e) * FF * D;
      return TileDesc{src, (bf16_t*)(ws + WS_DN), D, kt * 64, nt * 64, D, FF, e * D + nt * 64}; }
}
template <int KIND> __device__ __forceinline__ void convert_items(const Args& a, MK_LAS float* scr) {
    constexpr int NIT = (KIND == 0) ? IT_PROJ : IT_MOE; const int G = (int)gridDim.x;
    int it = (int)blockIdx.x; if (it >= NIT) return;
    f32x4 v0[2], v1[2], v2[2]; TileDesc d0 = (KIND == 0) ? proj_item(a, it) : moe_item(a, KIND - 1, it), d1 = d0, d2 = d0;
    tile_load(d0, v0);
    const bool has1 = it + G < NIT; if (has1) { d1 = (KIND == 0) ? proj_item(a, it + G) : moe_item(a, KIND - 1, it + G); tile_load(d1, v1); }
    for (;;) { const int n2 = it + 2 * G; const bool more2 = n2 < NIT, more1 = it + G < NIT;
        if (more2) { d2 = (KIND == 0) ? proj_item(a, n2) : moe_item(a, KIND - 1, n2); tile_load(d2, v2); }
        tile_store(d0, v0, scr);
        if (!more1) break;
        v0[0] = v1[0]; v0[1] = v1[1]; d0 = d1; v1[0] = v2[0]; v1[1] = v2[1]; d1 = d2; it += G; }
}

__device__ __forceinline__ float row_rstd(const f32x4 (&v)[8]) {
    float s = 0.f;
#pragma unroll
    for (int j = 0; j < 8; ++j) s += (v[j][0] * v[j][0] + v[j][1] * v[j][1]) + (v[j][2] * v[j][2] + v[j][3] * v[j][3]);
    return rsqrtf(wave_sum(s) * (1.0f / D) + NORM_EPS);
}
__device__ __forceinline__ void norm_scale(f32x4 (&v)[8], float rstd, const float* w, int lane) {
#pragma unroll
    for (int j = 0; j < 8; ++j) { const f32x4 g = *(const f32x4*)(w + 4 * (lane + 64 * j)); v[j] = v[j] * rstd * g; }
}
__device__ __forceinline__ void store_row_bf16(const f32x4 (&v)[8], bf16_t* orow, int lane) {
#pragma unroll
    for (int j = 0; j < 8; ++j) { u32x2 w; w.x = cvt_pk_bf16(v[j][0], v[j][1]); w.y = cvt_pk_bf16(v[j][2], v[j][3]); *(u32x2*)(orow + 4 * (lane + 64 * j)) = w; }
}

__device__ __forceinline__ void ph_prologue(const Args& a, MK_LAS unsigned char* lds) {
    MK_LAS float* scr = (MK_LAS float*)lds;
    convert_items<0>(a, scr); convert_items<1>(a, scr);
    const int lane = MK_TID & 63, gw = blockIdx.x * 8 + (MK_TID >> 6), NGW = gridDim.x * 8;
    bf16_t* H = (bf16_t*)(a.ws + WS_H);
    for (int m = gw; m < NTOK; m += NGW) {
        const float* xr = a.in[I_X] + (size_t)m * D; f32x4 v[8];
#pragma unroll
        for (int j = 0; j < 8; ++j) v[j] = *(const f32x4*)(xr + 4 * (lane + 64 * j));
        const float rstd = row_rstd(v); norm_scale(v, rstd, a.in[I_MIXW], lane); store_row_bf16(v, H + (size_t)m * D, lane);
    }
}

__device__ __forceinline__ void ph_hgrn2_naive(const Args& a, MK_LAS unsigned char* lds) {
    constexpr int TS = 8;
    const int tid = MK_TID, grp = tid >> 7, v = tid & 127, s = blockIdx.x * 4 + grp, b = s >> 3, hh = s & 7;
    const bf16_t* P = (const bf16_t*)(a.ws + WS_P); float* raw = (float*)(a.ws + WS_H);
    MK_LAS float* Lq = (MK_LAS float*)lds + grp * (3 * TS * 128); MK_LAS float* Lf = Lq + TS * 128; MK_LAS float* Lk = Lf + TS * 128;
    const int c = hh * 128 + v;
    const float l0 = a.in[I_HGLB][c], l1 = a.in[I_HGLB][1024 + c]; const float mx = fmaxf(l0, l1), e0 = __expf(l0 - mx), e1 = __expf(l1 - mx), lb = e0 / (e0 + e1);
    float S[128];
#pragma unroll
    for (int k = 0; k < 128; ++k) S[k] = 0.f;
    for (int t0 = 0; t0 < T; t0 += TS) {
#pragma unroll
        for (int tt = 0; tt < TS; ++tt) { const size_t row = (size_t)b * T + t0 + tt;
            const float q = bf2f(P[row * AB_LD + c]), fl = bf2f(P[row * AB_LD + 1024 + c]);
            const float f = lb + (1.0f - lb) * fsigmoid(fl);
            Lq[tt * 128 + v] = siluf(q); Lf[tt * 128 + v] = f; Lk[tt * 128 + v] = 1.0f - f; }
        __syncthreads();
        for (int tt = 0; tt < TS; ++tt) { const size_t row = (size_t)b * T + t0 + tt;
            const float vi = bf2f(P[row * AB_LD + 2048 + c]); float o = 0.f;
#pragma unroll
            for (int k4 = 0; k4 < 32; ++k4) { const f32x4 q = *(const MK_LAS f32x4*)(Lq + tt * 128 + 4 * k4), f = *(const MK_LAS f32x4*)(Lf + tt * 128 + 4 * k4), kd = *(const MK_LAS f32x4*)(Lk + tt * 128 + 4 * k4);
#pragma unroll
                for (int i = 0; i < 4; ++i) { S[4 * k4 + i] = f[i] * S[4 * k4 + i] + kd[i] * vi; o += S[4 * k4 + i] * q[i]; } }
            raw[row * 1024 + c] = o; }
        __syncthreads();
    }
}

__device__ __forceinline__ float rw_pf(const bf16_t* P, const float* mu, size_t row, int t, int col) {
    const float cur = bf2f(P[row * AB_LD + RWO + col]); const float prv = (t == 0) ? 0.f : bf2f(P[(row - 1) * AB_LD + RWO + col]);
    return cur + (prv - cur) * mu[col];
}
__device__ __forceinline__ void ph_rwkv_naive(const Args& a, MK_LAS unsigned char* lds) {
    constexpr int TS = 16;
    const int tid = MK_TID, s = blockIdx.x - 4, b = s >> 4, hh = s & 15;
    const bf16_t* P = (const bf16_t*)(a.ws + WS_P); float* yraw = (float*)(a.ws + WS_SCR);
    const float* mu = a.in[I_RWMU];
    MK_LAS float* Lr = (MK_LAS float*)lds; MK_LAS float* Lw = Lr + TS * 64; MK_LAS float* Lk = Lw + TS * 64; MK_LAS float* Lv = Lk + TS * 64; MK_LAS float* La = Lv + TS * 64; MK_LAS float* Lb = La + TS * 64;
    MK_LAS float* Lkk = Lb + TS * 64; MK_LAS float* Ltw = Lkk + TS * 64; MK_LAS float* Lpa = Ltw + TS * 96;
    float S[64];
#pragma unroll
    for (int j = 0; j < 64; ++j) S[j] = 0.f;
    for (int t0 = 0; t0 < T; t0 += TS) {
        for (int i = tid; i < TS * 96; i += 512) { const int tt = i / 96, m = i % 96; const size_t row = (size_t)b * T + t0 + tt;
            Ltw[i] = tanhf(rw_pf(P, mu, row, t0 + tt, 3072 + m)); Lpa[i] = rw_pf(P, mu, row, t0 + tt, 3168 + m); }
        __syncthreads();
        float kreg[2], agreg[2];
#pragma unroll
        for (int q = 0; q < 2; ++q) { const int i = tid + 512 * q, tt = i >> 6, ch = i & 63, c = hh * 64 + ch; const size_t row = (size_t)b * T + t0 + tt;
            const float r = rw_pf(P, mu, row, t0 + tt, c), k = rw_pf(P, mu, row, t0 + tt, 1024 + c), v = rw_pf(P, mu, row, t0 + tt, 2048 + c);
            float lw = a.in[I_RWW0][c], la = a.in[I_RWA0][c];

_Pragma("unroll 8")
            for (int m = 0; m < 96; ++m) { lw += Ltw[tt * 96 + m] * a.in[I_RWW2][m * 1024 + c]; la += Lpa[tt * 96 + m] * a.in[I_RWA2][m * 1024 + c]; }
            const float wlog = -softplusf(-lw) - 0.5f, decay = __expf(-__expf(wlog)), ag = fsigmoid(la);
            Lr[i] = r; Lw[i] = decay; Lv[i] = v; Lkk[i] = k * a.in[I_RWKK][c]; kreg[q] = k; agreg[q] = ag; }
        __syncthreads();
#pragma unroll
        for (int q = 0; q < 2; ++q) { const int i = tid + 512 * q, tt = i >> 6, ch = i & 63, c = hh * 64 + ch;
            float ss = 0.f;
_Pragma("unroll 8")
            for (int j = 0; j < 64; ++j) { const float x = Lkk[tt * 64 + j]; ss += x * x; }
            const float kk = Lkk[i] / fmaxf(sqrtf(ss), 1e-12f);
            Lk[i] = kreg[q] * (1.0f + (agreg[q] - 1.0f) * a.in[I_RWKA][c]); La[i] = -kk; Lb[i] = kk * agreg[q]; }
        __syncthreads();
        if (tid < 64) {
            for (int tt = 0; tt < TS; ++tt) { const size_t row = (size_t)b * T + t0 + tt;
                float sa = 0.f;
#pragma unroll
                for (int j = 0; j < 64; ++j) sa += S[j] * La[tt * 64 + j];
                const float vi = Lv[tt * 64 + tid]; float y = 0.f;
#pragma unroll
                for (int j = 0; j < 64; ++j) { S[j] = S[j] * Lw[tt * 64 + j] + sa * Lb[tt * 64 + j] + vi * Lk[tt * 64 + j]; y += S[j] * Lr[tt * 64 + j]; }
                yraw[row * 1024 + hh * 64 + tid] = y; }
        }
        __syncthreads();
    }
}

__device__ __forceinline__ void ph_post0_naive(const Args& a, MK_LAS unsigned char* lds) {
    const int tid = MK_TID, lane = tid & 63;
    const bf16_t* P = (const bf16_t*)(a.ws + WS_P); const float* hraw = (const float*)(a.ws + WS_H); const float* yraw = (const float*)(a.ws + WS_SCR);
    bf16_t* O = (bf16_t*)(a.ws + WS_O); const float* mu = a.in[I_RWMU];
    MK_LAS float* Lpa = (MK_LAS float*)lds; MK_LAS float* Lsg = Lpa + 96;
    for (int m = blockIdx.x; m < NTOK; m += gridDim.x) { const size_t row = (size_t)m; const int t = m & (T - 1);
        for (int i = tid; i < 96 + 256; i += 512) { if (i < 96) Lpa[i] = rw_pf(P, mu, row, t, 3168 + i); else Lsg[i - 96] = fsigmoid(rw_pf(P, mu, row, t, 3264 + (i - 96))); }
        __syncthreads();
        {
            const int c = tid * 2; const float o0 = hraw[row * 1024 + c], o1 = hraw[row * 1024 + c + 1];
            const float rstd = rsqrtf(wave_sum(o0 * o0 + o1 * o1) * (1.0f / 128.0f) + NORM_EPS);
            const float g0 = bf2f(P[row * AB_LD + 3072 + c]), g1 = bf2f(P[row * AB_LD + 3072 + c + 1]);
            *(unsigned*)(O + row * D + c) = cvt_pk_bf16(o0 * rstd * a.in[I_HGNW][c] * siluf(g0), o1 * rstd * a.in[I_HGNW][c + 1] * siluf(g1)); }
        {
            const int c = tid * 2; float y[2], r[2], k[2], v[2], g[2];
#pragma unroll
            for (int q = 0; q < 2; ++q) { const int cc = c + q; y[q] = yraw[row * 1024 + cc];
                r[q] = rw_pf(P, mu, row, t, cc); const float kx = rw_pf(P, mu, row, t, 1024 + cc); v[q] = rw_pf(P, mu, row, t, 2048 + cc);
                float la = a.in[I_RWA0][cc];
_Pragma("unroll 8")
                for (int i = 0; i < 96; ++i) la += Lpa[i] * a.in[I_RWA2][i * 1024 + cc];
                k[q] = kx * (1.0f + (fsigmoid(la) - 1.0f) * a.in[I_RWKA][cc]);
                float gg = 0.f;
_Pragma("unroll 8")
                for (int i = 0; i < 256; ++i) gg += Lsg[i] * a.in[I_RWG2][i * 1024 + cc];
                g[q] = gg; }
            float sm = y[0] + y[1], sb = r[0] * k[0] * a.in[I_RWRK][c] + r[1] * k[1] * a.in[I_RWRK][c + 1];
#pragma unroll
            for (int o = 16; o > 0; o >>= 1) { sm += __shfl_xor(sm, o); sb += __shfl_xor(sb, o); }
            const float mean = sm * (1.0f / 64.0f); const float d0 = y[0] - mean, d1 = y[1] - mean; float sv = d0 * d0 + d1 * d1;
#pragma unroll
            for (int o = 16; o > 0; o >>= 1) sv += __shfl_xor(sv, o);
            const float rstd = rsqrtf(sv * (1.0f / 64.0f) + 64e-5f);
            const float z0 = (d0 * rstd * a.in[I_RWLNW][c] + a.in[I_RWLNB][c] + sb * v[0]) * g[0], z1 = (d1 * rstd * a.in[I_RWLNW][c + 1] + a.in[I_RWLNB][c + 1] + sb * v[1]) * g[1];
            *(unsigned*)(O + row * D + 1024 + c) = cvt_pk_bf16(z0, z1); }
        __syncthreads();
    }
    (void)lane;
}
typedef short bf16x8 __attribute__((ext_vector_type(8)));
typedef short bf16x4 __attribute__((ext_vector_type(4)));
typedef float f32x16 __attribute__((ext_vector_type(16)));
typedef float f32x2_t __attribute__((ext_vector_type(2))); typedef __bf16 bf16x2_t __attribute__((ext_vector_type(2)));
__device__ __forceinline__ unsigned cvtpk(float lo, float hi) { f32x2_t v = {lo, hi}; bf16x2_t b = __builtin_convertvector(v, bf16x2_t); return __builtin_bit_cast(unsigned, b); }
#define MFMA32(a, b, c) __builtin_amdgcn_mfma_f32_32x32x16_bf16((a), (b), (c), 0, 0, 0)
constexpr int FX_KS = 272, FX_VS = 136, FX_KB = 64 * FX_KS, FX_VB = 128 * FX_VS;
constexpr int FX_OFF_K = 0, FX_OFF_V = 2 * FX_KB, FX_OFF_C = FX_OFF_V + 2 * FX_VB, FX_LDS = FX_OFF_C + 2 * 256;
constexpr float FX_L2E = 1.4426950408889634f;
constexpr size_t WS_KMAX = 65536, WS_FOXQ = 65536 + 256;
constexpr float FX_THR2 = 30.0f * FX_L2E;
__device__ __forceinline__ void ph_fox_kmax(const Args& a) {
    const int lane = MK_TID & 63, gw = blockIdx.x * 8 + (MK_TID >> 6), NGW = gridDim.x * 8;
    const bf16_t* P = (const bf16_t*)(a.ws + WS_P); unsigned* KM = (unsigned*)(a.ws + WS_KMAX);
    for (int bb = 0; bb < NB; ++bb) { float mx = 0.f;
        for (int t = gw; t < T; t += NGW) { const u32x4* kp = (const u32x4*)(P + ((size_t)bb * T + t) * CD_LD + 2048 + 16 * lane); const u32x4 k0 = kp[0], k1 = kp[1];
            float s = bflo(k0.x) * bflo(k0.x) + bfhi(k0.x) * bfhi(k0.x) + bflo(k0.y) * bflo(k0.y) + bfhi(k0.y) * bfhi(k0.y) + bflo(k0.z) * bflo(k0.z) + bfhi(k0.z) * bfhi(k0.z) + bflo(k0.w) * bflo(k0.w) + bfhi(k0.w) * bfhi(k0.w)
                    + bflo(k1.x) * bflo(k1.x) + bfhi(k1.x) * bfhi(k1.x) + bflo(k1.y) * bflo(k1.y) + bfhi(k1.y) * bfhi(k1.y) + bflo(k1.z) * bflo(k1.z) + bfhi(k1.z) * bfhi(k1.z) + bflo(k1.w) * bflo(k1.w) + bfhi(k1.w) * bfhi(k1.w);
            s += __shfl_xor(s, 1); s += __shfl_xor(s, 2); s += __shfl_xor(s, 4); mx = fmaxf(mx, s); }
        if ((lane & 7) == 0) atomicMax(KM + bb * 8 + (lane >> 3), __float_as_uint(mx)); }
}

__device__ __forceinline__ void ph_fox(const Args& a, MK_LAS unsigned char* lds) {
    const int tid = MK_TID, lane = tid & 63, wave = tid >> 6, r = lane & 31, h = lane >> 5;
    const bf16_t* P = (const bf16_t*)(a.ws + WS_P); bf16_t* O = (bf16_t*)(a.ws + WS_O); const float* cum = (const float*)(a.ws + WS_CUM);
    const int G = (int)gridDim.x, c = (int)blockIdx.x;
    const float sc2 = 0.08838834764831845f * FX_L2E;
    unsigned* qhead = (unsigned*)(a.ws + WS_FOXQ);
    (void)G; (void)c;
    for (;;) {
        if (tid == 0) *(MK_LAS unsigned*)(lds + FX_LDS) = __hip_atomic_fetch_add(qhead, 1u, __ATOMIC_RELAXED, __HIP_MEMORY_SCOPE_AGENT);
        __syncthreads();
        const int L = (int)*(const MK_LAS unsigned*)(lds + FX_LDS);
        __syncthreads();
        if (L >= 1024) break;
        const int qt = 63 - (L >> 4), bh = L & 15, b = bh >> 3, hd = bh & 7, q0 = qt * 256, qw = q0 + 32 * wave, nt = 4 * (qt + 1);
        const size_t qrow = (size_t)b * T + qw + r;
        bf16x8 qf[8];
#pragma unroll
        for (int ks = 0; ks < 8; ++ks) qf[ks] = *(const bf16x8*)(P + qrow * CD_LD + 1024 + hd * 128 + 16 * ks + 8 * h);
        const float cq = cum[qrow * 8 + hd] * FX_L2E;
        float qb;
        {   float qn = 0.f;
#pragma unroll
            for (int ks = 0; ks < 8; ++ks) { const u32x4 w = __builtin_bit_cast(u32x4, qf[ks]);
                qn += bflo(w.x) * bflo(w.x) + bfhi(w.x) * bfhi(w.x) + bflo(w.y) * bflo(w.y) + bfhi(w.y) * bfhi(w.y) + bflo(w.z) * bflo(w.z) + bfhi(w.z) * bfhi(w.z) + bflo(w.w) * bflo(w.w) + bfhi(w.w) * bfhi(w.w); }
            qn += __shfl_xor(qn, 32);
            qb = sqrtf(qn * __uint_as_float(((const unsigned*)(a.ws + WS_KMAX))[bh])) * sc2 * 1.01f + 0.01f; }
        bool wdone = false;
        f32x16 o[4];
#pragma unroll
        for (int dt = 0; dt < 4; ++dt)
#pragma unroll
            for (int i = 0; i < 16; ++i) o[dt][i] = 0.f;
        float mrun = -3.0e38f, lrun = 0.f;
        const bf16_t* Kg = P + (size_t)b * T * CD_LD + 2048 + hd * 128; const bf16_t* Vg = P + (size_t)b * T * CD_LD + 3072 + hd * 128;
        u32x4 kreg[2], vreg[2]; float creg = 0.f;
#pragma unroll
        for (int i = 0; i < 2; ++i) { const int ch = tid + 512 * i; kreg[i] = *(const u32x4*)(Kg + (size_t)(64 * (nt - 1) + (ch >> 4)) * CD_LD + 8 * (ch & 15)); vreg[i] = *(const u32x4*)(Vg + (size_t)(64 * (nt - 1) + (ch & 63)) * CD_LD + 8 * (ch >> 6)); }
        if (tid < 64) creg = cum[((size_t)b * T + 64 * (nt - 1) + tid) * 8 + hd] * FX_L2E;
#define FX_WRITE(buf) do { _Pragma("unroll") for (int i = 0; i < 2; ++i) { const int ch = tid + 512 * i; \
            *(MK_LAS u32x4*)(lds + FX_OFF_K + (buf) * FX_KB + (ch >> 4) * FX_KS + (ch & 15) * 16) = kreg[i]; \
            MK_LAS unsigned short* vp = (MK_LAS unsigned short*)(lds + FX_OFF_V + (buf) * FX_VB + (8 * (ch >> 6)) * FX_VS + (ch & 63) * 2); \
            vp[0 * (FX_VS / 2)] = (unsigned short)(vreg[i].x & 0xffffu); vp[1 * (FX_VS / 2)] = (unsigned short)(vreg[i].x >> 16); vp[2 * (FX_VS / 2)] = (unsigned short)(vreg[i].y & 0xffffu); vp[3 * (FX_VS / 2)] = (unsigned short)(vreg[i].y >> 16); \
            vp[4 * (FX_VS / 2)] = (unsigned short)(vreg[i].z & 0xffffu); vp[5 * (FX_VS / 2)] = (unsigned short)(vreg[i].z >> 16); vp[6 * (FX_VS / 2)] = (unsigned short)(vreg[i].w & 0xffffu); vp[7 * (FX_VS / 2)] = (unsigned short)(vreg[i].w >> 16); } \
            if (tid < 64) *(MK_LAS float*)(lds + FX_OFF_C + (buf) * 256 + tid * 4) = creg; } while (0)
        FX_WRITE(0);
        __syncthreads();
        for (int jj = 0; jj < nt; ++jj) {
            const int j = nt - 1 - jj, buf = jj & 1, k0 = 64 * j;
            if (j > 0) {
#pragma unroll
                for (int i = 0; i < 2; ++i) { const int ch = tid + 512 * i; kreg[i] = *(const u32x4*)(Kg + (size_t)(k0 - 64 + (ch >> 4)) * CD_LD + 8 * (ch & 15)); vreg[i] = *(const u32x4*)(Vg + (size_t)(k0 - 64 + (ch & 63)) * CD_LD + 8 * (ch >> 6)); }
                if (tid < 64) creg = cum[((size_t)b * T + k0 - 64 + tid) * 8 + hd] * FX_L2E;
            }
            const MK_LAS float* Cb = (const MK_LAS float*)(lds + FX_OFF_C + buf * 256);
            if (!wdone) wdone = __all(qb + (cq - Cb[63]) <= mrun - FX_THR2);
            if (!wdone && k0 <= qw + 31) {
                const MK_LAS unsigned char* Kb = lds + FX_OFF_K + buf * FX_KB; const MK_LAS unsigned char* Vb = lds + FX_OFF_V + buf * FX_VB;
                f32x16 st[2];
#pragma unroll
                for (int kt = 0; kt < 2; ++kt) {
#pragma unroll
                    for (int i = 0; i < 16; ++i) st[kt][i] = 0.f;
#pragma unroll
                    for (int ks = 0; ks < 8; ++ks) { const bf16x8 kf = *(const MK_LAS bf16x8*)(Kb + (32 * kt + r) * FX_KS + ks * 32 + h * 16); st[kt] = MFMA32(kf, qf[ks], st[kt]); } }
                const bool diag = __builtin_amdgcn_readfirstlane((int)(k0 + 63 > qw)) != 0;
                float mx = -3.0e38f;
                if (diag) {
#pragma unroll
                for (int kt = 0; kt < 2; ++kt)
#pragma unroll
                    for (int g = 0; g < 4; ++g) { const f32x4 ck = *(const MK_LAS f32x4*)(Cb + 32 * kt + 8 * g + 4 * h);
#pragma unroll
                        for (int i = 0; i < 4; ++i) { float s = st[kt][4 * g + i] * sc2 + (cq - ck[i]);
                            const int key = k0 + 32 * kt + 8 * g + 4 * h + i; if (key > qw + r) s = -3.0e38f;
                            st[kt][4 * g + i] = s; mx = fmaxf(mx, s); } }
                } else {
#pragma unroll
                for (int kt = 0; kt < 2; ++kt)
#pragma unroll
                    for (int g = 0; g < 4; ++g) { const f32x4 ck = *(const MK_LAS f32x4*)(Cb + 32 * kt + 8 * g + 4 * h);
#pragma unroll
                        for (int i = 0; i < 4; ++i) { const float s = st[kt][4 * g + i] * sc2 + (cq - ck[i]); st[kt][4 * g + i] = s; mx = fmaxf(mx, s); } }
                }
                mx = fmaxf(mx, __shfl_xor(mx, 32));
                const float mnew = fmaxf(mrun, mx), corr = __builtin_amdgcn_exp2f(mrun - mnew); mrun = mnew;
                float ls = 0.f;
#pragma unroll
                for (int kt = 0; kt < 2; ++kt)
#pragma unroll
                    for (int i = 0; i < 16; ++i) { const float p = __builtin_amdgcn_exp2f(st[kt][i] - mnew); st[kt][i] = p; ls += p; }
                lrun = lrun * corr + ls;
                if (!__all(corr == 1.0f)) {
#pragma unroll
                for (int dt = 0; dt < 4; ++dt)
#pragma unroll
                    for (int i = 0; i < 16; ++i) o[dt][i] *= corr; }
                bf16x8 pf[2][2];
#pragma unroll
                for (int kt = 0; kt < 2; ++kt)
#pragma unroll
                    for (int s = 0; s < 2; ++s) { u32x4 w; w.x = cvtpk(st[kt][8 * s + 0], st[kt][8 * s + 1]); w.y = cvtpk(st[kt][8 * s + 2], st[kt][8 * s + 3]); w.z = cvtpk(st[kt][8 * s + 4], st[kt][8 * s + 5]); w.w = cvtpk(st[kt][8 * s + 6], st[kt][8 * s + 7]);
                        pf[kt][s] = __builtin_bit_cast(bf16x8, w); }
#pragma unroll
                for (int dt = 0; dt < 4; ++dt)
#pragma unroll
                    for (int kt = 0; kt < 2; ++kt)
#pragma unroll
                        for (int s = 0; s < 2; ++s) { const MK_LAS unsigned char* vp = Vb + (32 * dt + r) * FX_VS + (32 * kt + 16 * s + 4 * h) * 2;
                            const u32x2 lo = *(const MK_LAS u32x2*)vp, hi = *(const MK_LAS u32x2*)(vp + 16); u32x4 w; w.x = lo.x; w.y = lo.y; w.z = hi.x; w.w = hi.y;
                            o[dt] = MFMA32(__builtin_bit_cast(bf16x8, w), pf[kt][s], o[dt]); }
            }
            if (j > 0) FX_WRITE(buf ^ 1);
            if (__syncthreads_and(wdone ? 1 : 0)) break;
        }
#undef FX_WRITE
        const float ltot = lrun + __shfl_xor(lrun, 32), inv = 1.0f / ltot;
        bf16_t* orow = O + qrow * D + 1024 + hd * 128;
#pragma unroll
        for (int dt = 0; dt < 4; ++dt)
#pragma unroll
            for (int g = 0; g < 4; ++g) { u32x2 w; w.x = cvtpk(o[dt][4 * g] * inv, o[dt][4 * g + 1] * inv); w.y = cvtpk(o[dt][4 * g + 2] * inv, o[dt][4 * g + 3] * inv);
                *(u32x2*)(orow + 32 * dt + 8 * g + 4 * h) = w; }
    }
}
#ifndef MK_RWKV_WP
#define MK_RWKV_WP 1
#endif
#define MFMA16(a, b, c) __builtin_amdgcn_mfma_f32_16x16x32_bf16((a), (b), (c), 0, 0, 0)
constexpr size_t WS_W2T = 8 * MiB, WS_A2T = 8 * MiB + 256 * 1024, WS_G2T = 9 * MiB;
constexpr size_t WS_HGS = WS_H, WS_RWQ = WS_H + 64 * MiB, WS_RWM = WS_H + 96 * MiB;
constexpr size_t WS_HGD = 10 * MiB;
constexpr size_t WS_RWLD = WS_SCR, WS_RWAG = WS_SCR + 64 * MiB;
constexpr int RW_AT = 0, RW_RT = RW_AT + 2304, RW_BH = RW_RT + 2304, RW_KH = RW_BH + 2304, RW_BCT = RW_KH + 2304, RW_KCT = RW_BCT + 2560, RW_VT = RW_KCT + 2560,
              RW_AM = RW_VT + 2560, RW_TM = RW_AM + 3072, RW_NF = RW_TM + 768, RW_WC = RW_NF + 1024, RW_RED = RW_WC + 256, RW_RAWX = RW_RED + 1024, RW_RAWL = RW_RAWX + 6528, RW_OUT = RW_RAWL + 6144, RW_GRP = RW_OUT + 2048;
constexpr int RW_SEG = 512, RW_NSEG = T / RW_SEG, RW_NCH = RW_SEG / 16;
constexpr int RP_RAW = 0, RP_TW = 58240, RP_PA = RP_TW + 13312, RP_SG = RP_PA + 13312, RP_MU = RP_SG + 33792, RP_END = RP_MU + 1792;
static_assert(RP_END <= LDS_RING, "rwkv pre lds");
static_assert(RW_GRP * 2 <= LDS_RING, "rwkv lds");
__device__ __forceinline__ bf16x8 mk8(u32x2 lo, u32x2 hi) { u32x4 w; w.x = lo.x; w.y = lo.y; w.z = hi.x; w.w = hi.y; return __builtin_bit_cast(bf16x8, w); }
__device__ __forceinline__ bf16x8 mk8z(u32x2 lo) { u32x4 w; w.x = lo.x; w.y = lo.y; w.z = 0u; w.w = 0u; return __builtin_bit_cast(bf16x8, w); }
__device__ __forceinline__ u32x2 pk4(const f32x4& v) { u32x2 w; w.x = cvtpk(v[0], v[1]); w.y = cvtpk(v[2], v[3]); return w; }
template <int CTRL> __device__ __forceinline__ float dpp_mov(float x) { return __builtin_bit_cast(float, __builtin_amdgcn_mov_dpp(__builtin_bit_cast(int, x), CTRL, 0xf, 0xf, true)); }
__device__ __forceinline__ float red16(float v) { v += dpp_mov<0xB1>(v); v += dpp_mov<0x4E>(v); v += dpp_mov<0x141>(v); v += dpp_mov<0x128>(v); return v; }

__device__ __forceinline__ void rwkv_convert_small(const Args& a) {
    const int gid = blockIdx.x * 512 + MK_TID, NG = gridDim.x * 512;
    bf16_t* w2t = (bf16_t*)(a.ws + WS_W2T); bf16_t* a2t = (bf16_t*)(a.ws + WS_A2T); bf16_t* g2t = (bf16_t*)(a.ws + WS_G2T);
    for (int i = gid; i < 1024 * 96; i += NG) { const int n = i / 96, m = i % 96; w2t[i] = (bf16_t)(cvtpk(a.in[I_RWW2][m * 1024 + n], 0.f) & 0xffffu); a2t[i] = (bf16_t)(cvtpk(a.in[I_RWA2][m * 1024 + n], 0.f) & 0xffffu); }
    for (int i = gid; i < 1024 * 256; i += NG) { const int n = i >> 8, m = i & 255; g2t[i] = (bf16_t)(cvtpk(a.in[I_RWG2][m * 1024 + n], 0.f) & 0xffffu); }
}

template <int ARR> __device__ __forceinline__ void rp_array(const Args& a, MK_LAS unsigned char* lds, size_t row0, int wave, int m, int q) {
    constexpr int NS = (ARR == 2) ? 8 : 3, KW = (ARR == 2) ? 256 : 96, AO = (ARR == 0) ? RP_TW : ((ARR == 1) ? RP_PA : RP_SG), AS = (ARR == 2) ? 528 : 208;
    const bf16_t* wt = (const bf16_t*)(a.ws + ((ARR == 0) ? WS_W2T : ((ARR == 1) ? WS_A2T : WS_G2T)));
    const int ch0 = 128 * wave + 8 * m;
#pragma unroll 1
    for (int rh = 0; rh < 2; ++rh) {
    f32x4 acc[8][2];
    bf16x8 af[2][NS];
#pragma unroll
    for (int rt = 0; rt < 2; ++rt)
#pragma unroll
        for (int s = 0; s < NS; ++s) af[rt][s] = *(const MK_LAS bf16x8*)(lds + AO + (32 * rh + 16 * rt + m) * AS + (32 * s + 8 * q) * 2);
    bf16x8 wn[NS], wn2[NS];
    constexpr bool TILED = (MK_RWKV_WP != 0) && (ARR < 2);
#define RP_CH(ct_) (TILED ? (128 * wave + 16 * (ct_) + m) : (128 * wave + 8 * m + (ct_)))
#pragma unroll
    for (int s = 0; s < NS; ++s) { wn[s] = *(const bf16x8*)(wt + RP_CH(0) * KW + 32 * s + 8 * q); wn2[s] = *(const bf16x8*)(wt + RP_CH(1) * KW + 32 * s + 8 * q); }
#pragma unroll
    for (int ct = 0; ct < 8; ++ct) { bf16x8 wf[NS];
#pragma unroll
        for (int s = 0; s < NS; ++s) { wf[s] = wn[s]; wn[s] = wn2[s]; }
        if (ct < 6) {
#pragma unroll
            for (int s = 0; s < NS; ++s) wn2[s] = *(const bf16x8*)(wt + RP_CH(ct + 2) * KW + 32 * s + 8 * q); }
#pragma unroll
        for (int rt = 0; rt < 2; ++rt) { f32x4 x = (f32x4){0.f, 0.f, 0.f, 0.f};
#pragma unroll
            for (int s = 0; s < NS; ++s) x = MFMA16(af[rt][s], wf[s], x);
            acc[ct][rt] = x; } }
    f32x4 b0 = (f32x4){0.f, 0.f, 0.f, 0.f}, b1 = b0;
    if (ARR == 0) { b0 = *(const f32x4*)(a.in[I_RWW0] + ch0); b1 = *(const f32x4*)(a.in[I_RWW0] + ch0 + 4); }
    if (ARR == 1) { b0 = *(const f32x4*)(a.in[I_RWA0] + ch0); b1 = *(const f32x4*)(a.in[I_RWA0] + ch0 + 4); }
    bf16_t* base = (ARR == 0) ? (bf16_t*)(a.ws + WS_RWLD) + ch0 : ((ARR == 1) ? (bf16_t*)(a.ws + WS_RWAG) + ch0 : (bf16_t*)(a.ws + WS_O) + 1024 + ch0);
    constexpr int LDO = (ARR == 2) ? D : 1024;
    if (TILED) {
#pragma unroll
        for (int ct = 0; ct < 8; ++ct) { const int ch = 128 * wave + 16 * ct + m; const float bias = (ARR == 0) ? a.in[I_RWW0][ch] : a.in[I_RWA0][ch];
#pragma unroll
            for (int rt = 0; rt < 2; ++rt) { f32x4 v;
#pragma unroll
                for (int e = 0; e < 4; ++e) { const float x = acc[ct][rt][e] + bias; v[e] = (ARR == 0) ? -0.8750387749f * fsigmoid(x) : fsigmoid(x); }
                const size_t cidx = (row0 + 32 * rh + 16 * rt) >> 4;
                *(u32x2*)((bf16_t*)(a.ws + WS_RWLD) + ((cidx * 16 + (ch >> 6)) * 2 + ARR) * 1024 + (ch & 63) * 16 + 4 * q) = pk4(v); } }
    } else
#pragma unroll
    for (int rt = 0; rt < 2; ++rt)
#pragma unroll
        for (int e = 0; e < 4; ++e) { const size_t row = row0 + 32 * rh + 16 * rt + 4 * q + e; float v[8];
#pragma unroll
            for (int ct = 0; ct < 8; ++ct) { const float x = acc[ct][rt][e] + (ct < 4 ? b0[ct & 3] : b1[ct & 3]);
                v[ct] = (ARR == 0) ? -0.8750387749f * fsigmoid(x) : ((ARR == 1) ? fsigmoid(x) : x); }
            u32x4 w; w.x = cvtpk(v[0], v[1]); w.y = cvtpk(v[2], v[3]); w.z = cvtpk(v[4], v[5]); w.w = cvtpk(v[6], v[7]);
            *(u32x4*)(base + row * LDO) = w; }
    }
#undef RP_CH
}
template <int ABL = 0> __device__ __forceinline__ void ph_rwkv_pre(const Args& a, MK_LAS unsigned char* lds) {
    const int tid = MK_TID, lane = tid & 63, wave = tid >> 6, m = lane & 15, q = lane >> 4;
    const bf16_t* P = (const bf16_t*)(a.ws + WS_P); bf16_t* O = (bf16_t*)(a.ws + WS_O); bf16_t* LD = (bf16_t*)(a.ws + WS_RWLD); bf16_t* AG = (bf16_t*)(a.ws + WS_RWAG);
    const bf16_t* w2t = (const bf16_t*)(a.ws + WS_W2T); const bf16_t* a2t = (const bf16_t*)(a.ws + WS_A2T); const bf16_t* g2t = (const bf16_t*)(a.ws + WS_G2T);
    if (tid < 448) *(MK_LAS float*)(lds + RP_MU + tid * 4) = a.in[I_RWMU][3072 + tid];
    const int G = (int)gridDim.x, nit = (NTOK / 64 + G - 1) / G;
    for (int it = 0; it < nit; ++it) {
        int u = it * G + (int)blockIdx.x; const bool valid = u < NTOK / 64; if (!valid) u = NTOK / 64 - 1;
        const size_t row0 = (size_t)u * 64; const bool first = ((u * 64) & (T - 1)) == 0;
#pragma unroll 4
        for (int i = 0; i < ((ABL & 4) ? 0 : 8); ++i) { const int j = tid + 512 * i; if (j < 65 * 56) { const int rw = j / 56, cc = j - rw * 56;
                const u32x4 v = (first && rw == 0) ? (u32x4){0u, 0u, 0u, 0u} : *(const u32x4*)(P + (row0 + rw - 1) * AB_LD + RWO + 3072 + 8 * cc);
                *(MK_LAS u32x4*)(lds + RP_RAW + rw * 896 + cc * 16) = v; } }
        __syncthreads();
#pragma unroll 2
        for (int i = 0; i < ((ABL & 2) ? 0 : 56); ++i) { const int idx = tid + 512 * i, tt = idx / 448, col = idx - tt * 448;
            const float cur = bf2f(*(const MK_LAS bf16_t*)(lds + RP_RAW + (tt + 1) * 896 + col * 2)), prv = bf2f(*(const MK_LAS bf16_t*)(lds + RP_RAW + tt * 896 + col * 2));
            const float x = cur + (prv - cur) * *(const MK_LAS float*)(lds + RP_MU + col * 4);
            if (col < 96) *(MK_LAS bf16_t*)(lds + RP_TW + tt * 208 + col * 2) = (bf16_t)(cvtpk(1.0f - 2.0f * __builtin_amdgcn_rcpf(__expf(2.0f * x) + 1.0f), 0.f) & 0xffffu);
            else if (col < 192) *(MK_LAS bf16_t*)(lds + RP_PA + tt * 208 + (col - 96) * 2) = (bf16_t)(cvtpk(x, 0.f) & 0xffffu);
            else *(MK_LAS bf16_t*)(lds + RP_SG + tt * 528 + (col - 192) * 2) = (bf16_t)(cvtpk(fsigmoid(x), 0.f) & 0xffffu); }
        __syncthreads();
        if (valid && !(ABL & 1)) { rp_array<0>(a, lds, row0, wave, m, q); rp_array<1>(a, lds, row0, wave, m, q); rp_array<2>(a, lds, row0, wave, m, q); }
        __syncthreads();
    }
}
template <int MODE, int ABL = 0>
__device__ __forceinline__ void ph_rwkv(const Args& a, MK_LAS unsigned char* lds, unsigned* qhead = nullptr) {
    const int tid = MK_TID, lane = tid & 63, wave = tid >> 6, grp = wave >> 2, wq = wave & 3, m = lane & 15, q = lane >> 4, gtid = tid & 255;
    MK_LAS unsigned char* gl = lds + grp * RW_GRP;
    const bf16_t* P = (const bf16_t*)(a.ws + WS_P); bf16_t* O = (bf16_t*)(a.ws + WS_O); const float* mu = a.in[I_RWMU];
    const bf16_t* LD = (const bf16_t*)(a.ws + WS_RWLD); const bf16_t* AG = (const bf16_t*)(a.ws + WS_RWAG);
    float* RWQ = (float*)(a.ws + WS_RWQ); float* RWM = (float*)(a.ws + WS_RWM);
    constexpr int NU = 32 * RW_NSEG, NCT = (MODE == 0) ? 2 : 1, NLP = (MODE == 0) ? 256 : 384;
    const int G = (int)gridDim.x, nit = (NU / 2 + G - 1) / G;
    for (int it = 0; qhead != nullptr || it < nit; ++it) {
        int ub = it * G + (int)blockIdx.x;
        if (qhead != nullptr) { MK_LAS unsigned* slot = (MK_LAS unsigned*)(lds + LDS_MISC + 1024); __syncthreads(); if (tid == 0) *slot = __hip_atomic_fetch_add(qhead, 1u, __ATOMIC_RELAXED, __HIP_MEMORY_SCOPE_AGENT); __syncthreads(); ub = (int)*slot; if (ub >= NU / 2) break; }
        const bool valid = ub < NU / 2; if (!valid) ub = NU / 2 - 1;
        const int u = ub * 2 + grp;
        const int stream = u / RW_NSEG, seg = u - stream * RW_NSEG, b = stream >> 4, hh = stream & 15, ch = hh * 64 + 16 * wq + m;
        const float mu_r = mu[ch], mu_k = mu[1024 + ch], mu_v = mu[2048 + ch];
        const float k_k = a.in[I_RWKK][ch], k_a = a.in[I_RWKA][ch], r_k = a.in[I_RWRK][ch], ln_w = a.in[I_RWLNW][ch], ln_b = a.in[I_RWLNB][ch];
        f32x4 zt[NCT][4];
        if (MODE == 0) {
#pragma unroll
            for (int jt = 0; jt < 4; ++jt)
#pragma unroll
                for (int e = 0; e < 4; ++e) { zt[NCT - 1][jt][e] = ((16 * jt + 4 * q + e) == (16 * wq + m)) ? 1.0f : 0.0f; zt[0][jt][e] = 0.0f; }
        } else {
            const float* zs = RWQ + (size_t)u * 4096;
#pragma unroll
            for (int jt = 0; jt < 4; ++jt)
#pragma unroll
                for (int e = 0; e < 4; ++e) zt[0][jt][e] = zs[(16 * jt + 4 * q + e) * 64 + 16 * wq + m];
        }
        u32x4 pfX[2], pfL[2];
        const size_t rseg = (size_t)b * T + seg * RW_SEG;
#define RW_FETCH(t0c) do { const bool first = (seg == 0 && (t0c) == 0); \
            _Pragma("unroll") for (int i = 0; i < 2; ++i) { const int j = gtid + 256 * i; const int rw = j / 24, cc = j - rw * 24; const bool ok = (j < 408) && !(first && rw == 0); \
                pfX[i] = ok ? *(const u32x4*)(P + (rseg + (t0c) + rw - 1) * AB_LD + RWO + (cc >> 3) * 1024 + hh * 64 + 8 * (cc & 7)) : (u32x4){0u, 0u, 0u, 0u}; } \
            _Pragma("unroll") for (int i = 0; i < 2; ++i) { const int j = gtid + 256 * i; if (j < NLP) { const int arr = j >> 7, rem = j & 127, tt = rem >> 3, c8 = rem & 7; \
                const bf16_t* src = (arr == 0) ? LD + (rseg + (t0c) + tt) * 1024 + hh * 64 + 8 * c8 : ((arr == 1) ? AG + (rseg + (t0c) + tt) * 1024 + hh * 64 + 8 * c8 : O + (rseg + (t0c) + tt) * D + 1024 + hh * 64 + 8 * c8); \
                pfL[i] = *(const u32x4*)src; } } } while (0)
        RW_FETCH(0);
        for (int chunk = 0; chunk < RW_NCH; ++chunk) {
            const int t0 = seg * RW_SEG + chunk * 16; const size_t row0 = (size_t)b * T + t0;
#pragma unroll
            for (int i = 0; i < 2; ++i) { const int j = gtid + 256 * i; if (j < 408) *(MK_LAS u32x4*)(gl + RW_RAWX + j * 16) = pfX[i]; if (j < NLP) *(MK_LAS u32x4*)(gl + RW_RAWL + j * 16) = pfL[i]; }
            if (chunk < RW_NCH - 1) RW_FETCH((chunk + 1) * 16);
            __syncthreads();
            if (MODE == 1 && chunk > 0 && valid && gtid < 128) *(u32x4*)(O + (row0 - 16 + (gtid >> 3)) * D + 1024 + hh * 64 + 8 * (gtid & 7)) = *(const MK_LAS u32x4*)(gl + RW_OUT + gtid * 16);
            float rr[4], km[4], vv[4], ld[4], ag[4], kkr[4], ga[4];
            {   const MK_LAS unsigned char* rx = gl + RW_RAWX + (4 * q) * 384 + (16 * wq + m) * 2;
                float pr = bf2f(*(const MK_LAS bf16_t*)(rx)), pk = bf2f(*(const MK_LAS bf16_t*)(rx + 128)), pv = bf2f(*(const MK_LAS bf16_t*)(rx + 256));
#pragma unroll
                for (int e = 0; e < 4; ++e) { const MK_LAS unsigned char* rc = rx + (e + 1) * 384; const MK_LAS unsigned char* rl = gl + RW_RAWL + (4 * q + e) * 128 + (16 * wq + m) * 2;
                    const float cr = bf2f(*(const MK_LAS bf16_t*)(rc)), ck = bf2f(*(const MK_LAS bf16_t*)(rc + 128)), cv = bf2f(*(const MK_LAS bf16_t*)(rc + 256));
                    rr[e] = cr + (pr - cr) * mu_r; const float kx = ck + (pk - ck) * mu_k; vv[e] = cv + (pv - cv) * mu_v; pr = cr; pk = ck; pv = cv;
                    ld[e] = bf2f(*(const MK_LAS bf16_t*)(rl)); ag[e] = bf2f(*(const MK_LAS bf16_t*)(rl + 2048)); ga[e] = (MODE == 1) ? bf2f(*(const MK_LAS bf16_t*)(rl + 4096)) : 0.f;
                    kkr[e] = kx * k_k; km[e] = kx * (1.0f + (ag[e] - 1.0f) * k_a); }
            }
            if (!(ABL & 16)) {   MK_LAS float* red = (MK_LAS float*)(gl + RW_RED);
#pragma unroll
                for (int e = 0; e < 4; ++e) { const float ss = red16(kkr[e] * kkr[e]); const float sb = red16(rr[e] * km[e] * r_k);
                    if (m == 0) { red[wq * 16 + 4 * q + e] = ss; red[64 + wq * 16 + 4 * q + e] = sb; } } }
            __syncthreads();
            float bon[4] = {0.f, 0.f, 0.f, 0.f};
            if (!(ABL & 8)) {   const MK_LAS float* red = (const MK_LAS float*)(gl + RW_RED);
                float cl[4], run = 0.f;
#pragma unroll
                for (int e = 0; e < 4; ++e) { run += ld[e]; cl[e] = run; }
                { float pre = 0.f; const float x1 = __shfl_up(run, 16), x2 = __shfl_up(run, 32), x3 = __shfl_up(run, 48); if (q >= 1) pre += x1; if (q >= 2) pre += x2; if (q >= 3) pre += x3;
#pragma unroll
                  for (int e = 0; e < 4; ++e) cl[e] += pre; }
                const float CL = __shfl(cl[3], 48 + m);
                f32x4 bc4, kc4, v4;
#pragma unroll
                for (int e = 0; e < 4; ++e) { const int tt = 4 * q + e;
                    const float ssum = red[tt] + red[16 + tt] + red[32 + tt] + red[48 + tt]; bon[e] = red[64 + tt] + red[80 + tt] + red[96 + tt] + red[112 + tt];
                    const float kk = kkr[e] * __builtin_amdgcn_rsqf(fmaxf(ssum, 1e-24f)), av = -kk, bv = kk * ag[e];
                    const float eW = __builtin_amdgcn_exp2f(cl[e]), eWp = __builtin_amdgcn_exp2f(cl[e] - ld[e]), eInv = __builtin_amdgcn_exp2f(-cl[e]), eC = __builtin_amdgcn_exp2f(CL - cl[e]);
                    const int off = tt * 144 + (16 * wq + m) * 2;
                    *(MK_LAS bf16_t*)(gl + RW_AT + off) = (bf16_t)(cvtpk(av * eWp, 0.f) & 0xffffu); *(MK_LAS bf16_t*)(gl + RW_RT + off) = (bf16_t)(cvtpk(rr[e] * eW, 0.f) & 0xffffu);
                    *(MK_LAS bf16_t*)(gl + RW_BH + off) = (bf16_t)(cvtpk(bv * eInv, 0.f) & 0xffffu); *(MK_LAS bf16_t*)(gl + RW_KH + off) = (bf16_t)(cvtpk(km[e] * eInv, 0.f) & 0xffffu);
                    bc4[e] = bv * eC; kc4[e] = km[e] * eC; v4[e] = vv[e]; }
                const int offT = (16 * wq + m) * 40 + 4 * q * 2;
                *(MK_LAS u32x2*)(gl + RW_BCT + offT) = pk4(bc4); *(MK_LAS u32x2*)(gl + RW_KCT + offT) = pk4(kc4); *(MK_LAS u32x2*)(gl + RW_VT + offT) = pk4(v4);
                if (q == 3) *(MK_LAS float*)(gl + RW_WC + (16 * wq + m) * 4) = __builtin_amdgcn_exp2f(CL);
            }
            __syncthreads();
            if (!(ABL & 4)) {   const int xo = (wq < 2) ? RW_AT : RW_RT, yo = (wq & 1) ? RW_KH : RW_BH; f32x4 acc = (f32x4){0.f, 0.f, 0.f, 0.f};
#pragma unroll
                for (int s = 0; s < 2; ++s) acc = MFMA16(*(const MK_LAS bf16x8*)(gl + xo + m * 144 + (32 * s + 8 * q) * 2), *(const MK_LAS bf16x8*)(gl + yo + m * 144 + (32 * s + 8 * q) * 2), acc);
#pragma unroll
                for (int e = 0; e < 4; ++e) { const int tt = 4 * q + e; const bool keep = (wq < 2) ? (m < tt) : (m <= tt); const float x = keep ? acc[e] : 0.f;
                    *(MK_LAS bf16_t*)(gl + RW_AM + wq * 768 + tt * 48 + m * 2) = (bf16_t)(cvtpk(x, 0.f) & 0xffffu);
                    if (wq == 0) *(MK_LAS float*)(gl + RW_NF + (tt * 16 + m) * 4) = x; } }
            __syncthreads();
#define RW_APERM(base, s) mk8(*(const MK_LAS u32x2*)(gl + (base) + m * 144 + (32 * (s) + 4 * q) * 2), *(const MK_LAS u32x2*)(gl + (base) + m * 144 + (32 * (s) + 16 + 4 * q) * 2))
#define RW_A16(base) mk8z(*(const MK_LAS u32x2*)(gl + (base) + m * 48 + 4 * q * 2))
            f32x4 y = (f32x4){0.f, 0.f, 0.f, 0.f}; f32x4 rhs[NCT];
            if (!(ABL & 2)) {
                const bf16x8 vf = mk8z(*(const MK_LAS u32x2*)(gl + RW_VT + (16 * wq + m) * 40 + 4 * q * 2));
                const bf16x8 at0 = RW_APERM(RW_AT, 0), at1 = RW_APERM(RW_AT, 1);
#pragma unroll
                for (int ct = 0; ct < NCT; ++ct) { const bool hasv = (MODE == 1) || (ct == 0);
                    const bf16x8 zp0 = mk8(pk4(zt[ct][0]), pk4(zt[ct][1])), zp1 = mk8(pk4(zt[ct][2]), pk4(zt[ct][3]));
                    f32x4 r4 = (f32x4){0.f, 0.f, 0.f, 0.f};
                    r4 = MFMA16(at0, zp0, r4); r4 = MFMA16(at1, zp1, r4);
                    if (hasv) r4 = MFMA16(RW_A16(RW_AM + 768), vf, r4);
                    rhs[ct] = r4;
                    if (MODE == 1) { y = MFMA16(RW_APERM(RW_RT, 0), zp0, y); y = MFMA16(RW_APERM(RW_RT, 1), zp1, y); y = MFMA16(RW_A16(RW_AM + 3 * 768), vf, y); }
#pragma unroll
                    for (int jt = 0; jt < 4; ++jt) { const f32x4 wc4 = *(const MK_LAS f32x4*)(gl + RW_WC + (16 * jt + 4 * q) * 4); f32x4 z = zt[ct][jt] * wc4;
                        if (hasv) z = MFMA16(mk8z(*(const MK_LAS u32x2*)(gl + RW_KCT + (16 * jt + m) * 40 + 4 * q * 2)), vf, z);
                        zt[ct][jt] = z; } }
            }
            if (!(ABL & 1) && wq == 0 && q == 0) {
                float tc[16];
                if (MODE == 0) { tc[0] = (m == 0) ? 1.f : 0.f;
#pragma unroll
                    for (int t = 1; t < 16; ++t) { float acc = 0.f;
#pragma unroll
                        for (int j = 0; j < t; ++j) acc += *(const MK_LAS float*)(gl + RW_NF + (t * 16 + j) * 4) * tc[j];
                        tc[t] = (m < t) ? acc : ((m == t) ? 1.f : 0.f); }
                } else {
                float ac[16];
#pragma unroll
                for (int t = 0; t < 16; ++t) ac[t] = 0.f;
                tc[0] = (m == 0) ? 1.f : 0.f;
#pragma unroll
                for (int j = 0; j < 15; ++j) {
#pragma unroll
                    for (int t = j + 1; t < 16; ++t) ac[t] += *(const MK_LAS float*)(gl + RW_NF + (t * 16 + j) * 4) * tc[j];
                    tc[j + 1] = (m < j + 1) ? ac[j + 1] : ((m == j + 1) ? 1.f : 0.f); }
                }
#pragma unroll
                for (int t = 0; t < 16; ++t) *(MK_LAS bf16_t*)(gl + RW_TM + t * 48 + m * 2) = (bf16_t)(cvtpk(tc[t], 0.f) & 0xffffu);
            }
            __syncthreads();
            if (!(ABL & 2)) {
                const bf16x8 tmf = RW_A16(RW_TM);
#pragma unroll
                for (int ct = 0; ct < NCT; ++ct) {
                    f32x4 uu = (f32x4){0.f, 0.f, 0.f, 0.f};
                    uu = MFMA16(tmf, mk8z(pk4(rhs[ct])), uu);
                    const bf16x8 ub8 = mk8z(pk4(uu));
                    if (MODE == 1) y = MFMA16(RW_A16(RW_AM + 2 * 768), ub8, y);
#pragma unroll
                    for (int jt = 0; jt < 4; ++jt) zt[ct][jt] = MFMA16(mk8z(*(const MK_LAS u32x2*)(gl + RW_BCT + (16 * jt + m) * 40 + 4 * q * 2)), ub8, zt[ct][jt]); }
            }
#undef RW_APERM
#undef RW_A16
            if (MODE == 1 && !(ABL & 32)) {
                MK_LAS float* red = (MK_LAS float*)(gl + RW_RED);
#pragma unroll
                for (int e = 0; e < 4; ++e) { const float s1 = red16(y[e]), s2 = red16(y[e] * y[e]); if (m == 0) { red[128 + wq * 16 + 4 * q + e] = s1; red[192 + wq * 16 + 4 * q + e] = s2; } }
                __syncthreads();
#pragma unroll
                for (int e = 0; e < 4; ++e) { const int tt = 4 * q + e;
                    const float s1 = red[128 + tt] + red[144 + tt] + red[160 + tt] + red[176 + tt], s2 = red[192 + tt] + red[208 + tt] + red[224 + tt] + red[240 + tt];
                    const float mean = s1 * (1.0f / 64.0f), var = fmaxf(s2 * (1.0f / 64.0f) - mean * mean, 0.f), rstd = rsqrtf(var + 64e-5f);
                    const float outv = ((y[e] - mean) * rstd * ln_w + ln_b + bon[e] * vv[e]) * ga[e];
                    *(MK_LAS bf16_t*)(gl + RW_OUT + tt * 128 + (16 * wq + m) * 2) = (bf16_t)(cvtpk(outv, 0.f) & 0xffffu); }
            }
        }
#undef RW_FETCH
        if (MODE == 1) { __syncthreads();
            if (valid && gtid < 128) *(u32x4*)(O + ((size_t)b * T + seg * RW_SEG + (RW_SEG - 16) + (gtid >> 3)) * D + 1024 + hh * 64 + 8 * (gtid & 7)) = *(const MK_LAS u32x4*)(gl + RW_OUT + gtid * 16); }
        if (MODE == 0 && valid) {
#pragma unroll
            for (int ct = 0; ct < NCT; ++ct) { float* dst = (ct == 0 ? RWQ : RWM) + (size_t)u * 4096;
#pragma unroll
                for (int jt = 0; jt < 4; ++jt)
#pragma unroll
                    for (int e = 0; e < 4; ++e) dst[(16 * jt + 4 * q + e) * 64 + 16 * wq + m] = zt[ct][jt][e]; } }
        __syncthreads();
    }
}

__device__ __forceinline__ void ph_rwkv_chain(const Args& a) {
    const int tid = MK_TID, lane = tid & 63, wave = tid >> 6, grp = wave >> 2, wq = wave & 3, m = lane & 15, q = lane >> 4;
    const int stream = (int)blockIdx.x * 2 + grp; if (stream >= 32) return;
    float* RWQ = (float*)(a.ws + WS_RWQ); const float* RWM = (const float*)(a.ws + WS_RWM);
    f32x4 zt[4];
#pragma unroll
    for (int jt = 0; jt < 4; ++jt) zt[jt] = (f32x4){0.f, 0.f, 0.f, 0.f};
    f32x4 mx[4][2][2], qn[4];
#define RB_LOAD(sg) do { const size_t u_ = (size_t)stream * RW_NSEG + (sg); const float* ms_ = RWM + u_ * 4096; const float* qs_ = RWQ + u_ * 4096; \
        _Pragma("unroll") for (int jt = 0; jt < 4; ++jt) { _Pragma("unroll") for (int s = 0; s < 2; ++s) { const float* mr = ms_ + (16 * jt + m) * 64 + 32 * s + 4 * q; mx[jt][s][0] = *(const f32x4*)mr; mx[jt][s][1] = *(const f32x4*)(mr + 16); } \
            _Pragma("unroll") for (int e = 0; e < 4; ++e) qn[jt][e] = qs_[(16 * jt + 4 * q + e) * 64 + 16 * wq + m]; } } while (0)
    RB_LOAD(0);
    for (int seg = 0; seg < RW_NSEG; ++seg) { const size_t u = (size_t)stream * RW_NSEG + seg; float* qs = RWQ + u * 4096;
        f32x4 zn[4]; bf16x8 mh[4][2], ml[4][2];
#pragma unroll
        for (int jt = 0; jt < 4; ++jt) { zn[jt] = qn[jt];
#pragma unroll
            for (int s = 0; s < 2; ++s) { const f32x4 x0 = mx[jt][s][0], x1 = mx[jt][s][1]; const u32x2 a0 = pk4(x0), a1 = pk4(x1); f32x4 h0, h1;
                h0[0] = bflo(a0.x); h0[1] = bfhi(a0.x); h0[2] = bflo(a0.y); h0[3] = bfhi(a0.y); h1[0] = bflo(a1.x); h1[1] = bfhi(a1.x); h1[2] = bflo(a1.y); h1[3] = bfhi(a1.y);
                mh[jt][s] = mk8(a0, a1); ml[jt][s] = mk8(pk4(x0 - h0), pk4(x1 - h1)); } }
#pragma unroll
        for (int jt = 0; jt < 4; ++jt)
#pragma unroll
            for (int e = 0; e < 4; ++e) qs[(16 * jt + 4 * q + e) * 64 + 16 * wq + m] = zt[jt][e];
        if (seg == RW_NSEG - 1) break;
        if (seg < RW_NSEG - 2) RB_LOAD(seg + 1);
        bf16x8 zh[2], zl[2];
#pragma unroll
        for (int s = 0; s < 2; ++s) { f32x4 h0, h1; const u32x2 a0 = pk4(zt[2 * s]), a1 = pk4(zt[2 * s + 1]);
            h0[0] = bflo(a0.x); h0[1] = bfhi(a0.x); h0[2] = bflo(a0.y); h0[3] = bfhi(a0.y); h1[0] = bflo(a1.x); h1[1] = bfhi(a1.x); h1[2] = bflo(a1.y); h1[3] = bfhi(a1.y);
            zh[s] = mk8(a0, a1); zl[s] = mk8(pk4(zt[2 * s] - h0), pk4(zt[2 * s + 1] - h1)); }
#pragma unroll
        for (int jt = 0; jt < 4; ++jt)
#pragma unroll
            for (int s = 0; s < 2; ++s) { zn[jt] = MFMA16(mh[jt][s], zh[s], zn[jt]); zn[jt] = MFMA16(mh[jt][s], zl[s], zn[jt]); zn[jt] = MFMA16(ml[jt][s], zh[s], zn[jt]); }
#pragma unroll
        for (int jt = 0; jt < 4; ++jt) zt[jt] = zn[jt];
    }
#undef RB_LOAD
}
constexpr int HG_Q1 = 0, HG_Q3 = 17408, HG_K3 = 34816, HG_K2T = 78336, HG_VT = 96768, HG_ATT = 115200, HG_TOT = 124416, HG_STAT = 126464, HG_DEC = 128512, HG_END = 129024;
static_assert(HG_END <= LDS_RING, "hgrn2 lds");
constexpr int HG_RAW = HG_Q3;
static_assert(HG_RAW + 64 * 768 <= HG_K2T, "hgrn2 raw staging");
template <int MODE>
__device__ __forceinline__ void ph_hgrn2(const Args& a, MK_LAS unsigned char* lds, int first_block = 0, unsigned* qhead = nullptr) {
    const int tid = MK_TID, lane = tid & 63, wave = tid >> 6, m = lane & 15, q = lane >> 4, chn = tid & 127, part = tid >> 7;
    const bf16_t* P = (const bf16_t*)(a.ws + WS_P); bf16_t* O = (bf16_t*)(a.ws + WS_O);
    float* HGS = (float*)(a.ws + WS_HGS); float* HGD = (float*)(a.ws + WS_HGD);
    if ((int)blockIdx.x < first_block) return;
    constexpr int NU = 1024; const int G = (int)gridDim.x - first_block, nit = (NU + G - 1) / G;
    for (int it = 0; qhead != nullptr || it < nit; ++it) {
        int u = it * G + (int)blockIdx.x - first_block;
        if (qhead != nullptr) { MK_LAS unsigned* slot = (MK_LAS unsigned*)(lds + LDS_MISC + 1024); __syncthreads(); if (tid == 0) *slot = __hip_atomic_fetch_add(qhead, 1u, __ATOMIC_RELAXED, __HIP_MEMORY_SCOPE_AGENT); __syncthreads(); u = (int)*slot; if (u >= NU) break; }
        const bool valid = u < NU; if (!valid) u = NU - 1;
        const int stream = u >> 6, seg = u & 63, b = stream >> 3, hh = stream & 7, cg = hh * 128 + chn;
        float lb; { const float l0 = a.in[I_HGLB][cg], l1 = a.in[I_HGLB][1024 + cg], mx = fmaxf(l0, l1), e0 = __expf(l0 - mx), e1 = __expf(l1 - mx); lb = e0 / (e0 + e1); }
        const int dvc = hh * 128 + 16 * wave + m;
        const float nw = a.in[I_HGNW][dvc];
        f32x4 st[8];
        if (MODE == 0) {
#pragma unroll
            for (int kt = 0; kt < 8; ++kt) st[kt] = (f32x4){0.f, 0.f, 0.f, 0.f};
        } else { int lofs = (4 * q) * 128 + 16 * wave + m; asm volatile("" : "+v"(lofs));
            const float* ss = HGS + (size_t)u * 16384 + lofs;
#pragma unroll
            for (int kt = 0; kt < 8; ++kt)
#pragma unroll
                for (int e = 0; e < 4; ++e) st[kt][e] = ss[(16 * kt + e) * 128]; }
        float segsum = 0.f;
        constexpr int NPT = (MODE == 1) ? 48 : 32, NPF = 64 * NPT / 512; u32x4 pf[NPF];
        const bf16_t* Pseg = P + ((size_t)b * T + seg * 256) * AB_LD + hh * 128;
#define HG_FETCH(t0c) do { int tq_ = tid; asm volatile("" : "+v"(tq_)); _Pragma("unroll") for (int i = 0; i < NPF; ++i) { const int j = tq_ + 512 * i, tt = j / NPT, rem = j - tt * NPT, arr = (rem >> 4) + ((MODE == 1) ? 0 : 1), c16 = rem & 15; \
            pf[i] = *(const u32x4*)(Pseg + (size_t)((t0c) + tt) * AB_LD + arr * 1024 + 8 * c16); } } while (0)
        HG_FETCH(0);
        for (int chunk = 0; chunk < 4; ++chunk) {
            const int t0 = seg * 256 + chunk * 64; const size_t row0 = (size_t)b * T + t0;
            { int tq_ = tid; asm volatile("" : "+v"(tq_));
#pragma unroll
            for (int i = 0; i < NPF; ++i) { const int j = tq_ + 512 * i, tt = j / NPT, rem = j - tt * NPT, arr = (rem >> 4) + ((MODE == 1) ? 0 : 1), c16 = rem & 15;
                *(MK_LAS u32x4*)(lds + HG_RAW + tt * 768 + arr * 256 + c16 * 16) = pf[i]; } }
            __syncthreads();
            float cl[16], kd[16], qs[16];
            {   float run = 0.f;
#pragma unroll
                for (int x = 0; x < 16; ++x) { const MK_LAS unsigned char* rw = lds + HG_RAW + (16 * part + x) * 768 + chn * 2; const float fl = bf2f(*(const MK_LAS bf16_t*)(rw + 256));
                    const float f = lb + (1.0f - lb) * fsigmoid(fl); run += __builtin_amdgcn_logf(f);     cl[x] = run; kd[x] = 1.0f - f;
                    if (MODE == 1) qs[x] = siluf(bf2f(*(const MK_LAS bf16_t*)rw)); }
                *(MK_LAS float*)(lds + HG_TOT + (part * 128 + chn) * 4) = run; }
            u32x4 vw[2];
            {   float vv[16];
#pragma unroll
                for (int x = 0; x < 16; ++x) vv[x] = bf2f(*(const MK_LAS bf16_t*)(lds + HG_RAW + (16 * part + x) * 768 + 512 + chn * 2));
                vw[0].x = cvtpk(vv[0], vv[1]); vw[0].y = cvtpk(vv[2], vv[3]); vw[0].z = cvtpk(vv[4], vv[5]); vw[0].w = cvtpk(vv[6], vv[7]);
                vw[1].x = cvtpk(vv[8], vv[9]); vw[1].y = cvtpk(vv[10], vv[11]); vw[1].z = cvtpk(vv[12], vv[13]); vw[1].w = cvtpk(vv[14], vv[15]); }
            __syncthreads();
            {   const float t0s = *(const MK_LAS float*)(lds + HG_TOT + (0 * 128 + chn) * 4), t1s = *(const MK_LAS float*)(lds + HG_TOT + (1 * 128 + chn) * 4), t2s = *(const MK_LAS float*)(lds + HG_TOT + (2 * 128 + chn) * 4), t3s = *(const MK_LAS float*)(lds + HG_TOT + (3 * 128 + chn) * 4);
                const float r1 = t0s, r2 = t0s + t1s, r3 = r2 + t2s, Bc = r3 + t3s;
                const float rp = (part == 0) ? 0.f : (part == 1 ? r1 : (part == 2 ? r2 : r3));
                if (part == 0) { *(MK_LAS float*)(lds + HG_DEC + chn * 4) = __builtin_amdgcn_exp2f(Bc); segsum += Bc; }
                float k2[16], kb[16];
                if (MODE == 1) { const float eB = __builtin_amdgcn_exp2f(Bc - rp);
#pragma unroll
                    for (int x = 0; x < 16; ++x) { kb[x] = kd[x] * __builtin_amdgcn_exp2f(-cl[x]); k2[x] = kb[x] * eB; }
                } else {
#pragma unroll
                    for (int x = 0; x < 16; ++x) k2[x] = kd[x] * __builtin_amdgcn_exp2f(Bc - (rp + cl[x])); }
                u32x4 kw[2];
                kw[0].x = cvtpk(k2[0], k2[1]); kw[0].y = cvtpk(k2[2], k2[3]); kw[0].z = cvtpk(k2[4], k2[5]); kw[0].w = cvtpk(k2[6], k2[7]);
                kw[1].x = cvtpk(k2[8], k2[9]); kw[1].y = cvtpk(k2[10], k2[11]); kw[1].z = cvtpk(k2[12], k2[13]); kw[1].w = cvtpk(k2[14], k2[15]);
                *(MK_LAS u32x4*)(lds + HG_K2T + chn * 144 + part * 32) = kw[0]; *(MK_LAS u32x4*)(lds + HG_K2T + chn * 144 + part * 32 + 16) = kw[1];
                *(MK_LAS u32x4*)(lds + HG_VT + chn * 144 + part * 32) = vw[0]; *(MK_LAS u32x4*)(lds + HG_VT + chn * 144 + part * 32 + 16) = vw[1];
                if (MODE == 1) {
                    const float eR = __builtin_amdgcn_exp2f(rp);
#pragma unroll
                    for (int x = 0; x < 16; ++x) { const int tt = 16 * part + x; const float q3 = qs[x] * __builtin_amdgcn_exp2f(cl[x]);
                        *(MK_LAS bf16_t*)(lds + HG_Q1 + tt * 272 + chn * 2) = (bf16_t)(cvtpk(q3 * eR, 0.f) & 0xffffu);
                        *(MK_LAS bf16_t*)(lds + HG_Q3 + tt * 272 + chn * 2) = (bf16_t)(cvtpk(q3, 0.f) & 0xffffu);
                        if ((x & 3) == 3) __builtin_amdgcn_sched_barrier(0); }
                    for (int i2 = part; i2 < 4; ++i2) { const float ri = (i2 == 0) ? 0.f : (i2 == 1 ? r1 : (i2 == 2 ? r2 : r3)); const int off = (i2 == 0) ? 0 : (i2 == 1 ? 16 : (i2 == 2 ? 48 : 96));
                        const float eV = __builtin_amdgcn_exp2f(ri - rp);
#pragma unroll
                        for (int x = 0; x < 16; ++x) { *(MK_LAS bf16_t*)(lds + HG_K3 + (off + 16 * part + x) * 272 + chn * 2) = (bf16_t)(cvtpk(kb[x] * eV, 0.f) & 0xffffu);
                            if ((x & 3) == 3) __builtin_amdgcn_sched_barrier(0); } }
                }
            }
            __syncthreads();
            if (chunk < 3) HG_FETCH((chunk + 1) * 64);
            f32x4 o[4];
            if (MODE == 1) {
#pragma unroll
                for (int x = 0; x < 2; ++x) { const int blk = wave * 2 + x, bi = blk >> 2, bj = blk & 3; f32x4 acc = (f32x4){0.f, 0.f, 0.f, 0.f};
                    if (bj <= bi) { const int off = (bi == 0) ? 0 : (bi == 1 ? 16 : (bi == 2 ? 48 : 96));
#pragma unroll
                        for (int ks = 0; ks < 4; ++ks) acc = MFMA16(*(const MK_LAS bf16x8*)(lds + HG_Q3 + (16 * bi + m) * 272 + (32 * ks + 8 * q) * 2), *(const MK_LAS bf16x8*)(lds + HG_K3 + (off + 16 * bj + m) * 272 + (32 * ks + 8 * q) * 2), acc); }
#pragma unroll
                    for (int e = 0; e < 4; ++e) { const bool keep = (bj < bi) || (bj == bi && m <= 4 * q + e);
                        *(MK_LAS bf16_t*)(lds + HG_ATT + (16 * bi + 4 * q + e) * 144 + (16 * bj + m) * 2) = (bf16_t)(cvtpk(keep ? acc[e] : 0.f, 0.f) & 0xffffu); } }
                __syncthreads();
                bf16x8 sp[4];
#pragma unroll
                for (int s = 0; s < 4; ++s) sp[s] = mk8(pk4(st[2 * s]), pk4(st[2 * s + 1]));
#pragma unroll
                for (int ti = 0; ti < 4; ++ti) { f32x4 acc = (f32x4){0.f, 0.f, 0.f, 0.f};
#pragma unroll
                    for (int s = 0; s < 4; ++s) acc = MFMA16(mk8(*(const MK_LAS u32x2*)(lds + HG_Q1 + (16 * ti + m) * 272 + (32 * s + 4 * q) * 2), *(const MK_LAS u32x2*)(lds + HG_Q1 + (16 * ti + m) * 272 + (32 * s + 16 + 4 * q) * 2)), sp[s], acc);
#pragma unroll
                    for (int ks = 0; ks < 2; ++ks) if (ks <= (ti >> 1)) acc = MFMA16(*(const MK_LAS bf16x8*)(lds + HG_ATT + (16 * ti + m) * 144 + (32 * ks + 8 * q) * 2), *(const MK_LAS bf16x8*)(lds + HG_VT + (16 * wave + m) * 144 + (32 * ks + 8 * q) * 2), acc);
                    o[ti] = acc; }
            }
            {   const bf16x8 vf0 = *(const MK_LAS bf16x8*)(lds + HG_VT + (16 * wave + m) * 144 + (8 * q) * 2), vf1 = *(const MK_LAS bf16x8*)(lds + HG_VT + (16 * wave + m) * 144 + (32 + 8 * q) * 2);
#pragma unroll
                for (int kt = 0; kt < 8; ++kt) { const f32x4 d4 = *(const MK_LAS f32x4*)(lds + HG_DEC + (16 * kt + 4 * q) * 4); f32x4 z = st[kt] * d4;
                    z = MFMA16(*(const MK_LAS bf16x8*)(lds + HG_K2T + (16 * kt + m) * 144 + (8 * q) * 2), vf0, z);
                    z = MFMA16(*(const MK_LAS bf16x8*)(lds + HG_K2T + (16 * kt + m) * 144 + (32 + 8 * q) * 2), vf1, z); st[kt] = z; } }
            if (MODE == 1) {
#pragma unroll
                for (int ti = 0; ti < 4; ++ti)
#pragma unroll
                    for (int e = 0; e < 4; ++e) { const float s2 = red16(o[ti][e] * o[ti][e]); if (m == 0) *(MK_LAS float*)(lds + HG_STAT + (wave * 64 + 16 * ti + 4 * q + e) * 4) = s2; }
                __syncthreads();
#pragma unroll
                for (int ti = 0; ti < 4; ++ti)
#pragma unroll
                    for (int e = 0; e < 4; ++e) { const int tt = 16 * ti + 4 * q + e; float s2 = 0.f;
#pragma unroll
                        for (int w2 = 0; w2 < 8; ++w2) s2 += *(const MK_LAS float*)(lds + HG_STAT + (w2 * 64 + tt) * 4);
                        const float rstd = rsqrtf(s2 * (1.0f / 128.0f) + NORM_EPS);
                        *(MK_LAS bf16_t*)(lds + HG_Q1 + tt * 256 + (16 * wave + m) * 2) = (bf16_t)(cvtpk(o[ti][e] * rstd * nw, 0.f) & 0xffffu); }
                __syncthreads();
#pragma unroll
                for (int i = 0; i < 2; ++i) { const int pc = tid + 512 * i, tt = pc >> 4, c8 = pc & 15; const size_t row = row0 + tt;
                    const u32x4 ov = *(const MK_LAS u32x4*)(lds + HG_Q1 + tt * 256 + c8 * 16), gv = *(const u32x4*)(P + row * AB_LD + 3072 + hh * 128 + 8 * c8);
                    u32x4 w; w.x = cvtpk(bflo(ov.x) * siluf(bflo(gv.x)), bfhi(ov.x) * siluf(bfhi(gv.x))); w.y = cvtpk(bflo(ov.y) * siluf(bflo(gv.y)), bfhi(ov.y) * siluf(bfhi(gv.y)));
                    w.z = cvtpk(bflo(ov.z) * siluf(bflo(gv.z)), bfhi(ov.z) * siluf(bfhi(gv.z))); w.w = cvtpk(bflo(ov.w) * siluf(bflo(gv.w)), bfhi(ov.w) * siluf(bfhi(gv.w)));
                    if (valid) *(u32x4*)(O + row * D + hh * 128 + 8 * c8) = w; }
            }
            __syncthreads();
        }
#undef HG_FETCH
        if (MODE == 0 && valid) { int lofs = (4 * q) * 128 + 16 * wave + m; asm volatile("" : "+v"(lofs)); float* ss = HGS + (size_t)u * 16384 + lofs;
#pragma unroll
            for (int kt = 0; kt < 8; ++kt)
#pragma unroll
                for (int e = 0; e < 4; ++e) ss[(16 * kt + e) * 128] = st[kt][e];
            if (part == 0) HGD[(size_t)u * 128 + chn] = __builtin_amdgcn_exp2f(segsum); }
    }
}
__device__ __forceinline__ void ph_hgrn2_chain(const Args& a, int first_block) {
    float* HGS = (float*)(a.ws + WS_HGS); const float* HGD = (const float*)(a.ws + WS_HGD);
    const int gid = ((int)blockIdx.x - first_block) * 512 + MK_TID, NG = ((int)gridDim.x - first_block) * 512;
    for (int idx = gid; idx < 16 * 16384; idx += NG) { const int stream = idx >> 14, el = idx & 16383, dk = el >> 7; float run = 0.f;
        for (int c0 = 0; c0 < 64; c0 += 16) { float tv[16], dv[16];
#pragma unroll
            for (int i = 0; i < 16; ++i) { const size_t u = (size_t)stream * 64 + c0 + i; tv[i] = HGS[u * 16384 + el]; dv[i] = HGD[u * 128 + dk]; }
#pragma unroll
            for (int i = 0; i < 16; ++i) { const size_t u = (size_t)stream * 64 + c0 + i; HGS[u * 16384 + el] = run; run = dv[i] * run + tv[i]; } } }
}
constexpr size_t WS_S5BBT = 11 * MiB, WS_S5CP = 11 * MiB + 512 * 1024, WS_S5AB = 12 * MiB, WS_S5AL = 12 * MiB + 64 * 1024, WS_S5X = WS_SCR; constexpr size_t WS_S5Q = 65536 + 512;
__device__ __forceinline__ void s5_param_prep(const Args& a) {
    const int gid0 = blockIdx.x * 512 + MK_TID;
    if (gid0 >= 64 * 64 * 16) return;
    const int gid = gid0 >> 4, c = gid0 & 15, g = gid >> 6, p = gid & 63;
    const float lr = fminf(a.in[I_S5LR][gid], -1e-4f), li = a.in[I_S5LI][gid], dt = expf(a.in[I_S5DT][g]);
    const float mag = expf(lr * dt), abr = mag * cosf(li * dt), abi = mag * sinf(li * dt);
    const float nr = abr - 1.0f, ni = abi, den = lr * lr + li * li, zr = (nr * lr + ni * li) / den, zi = (ni * lr - nr * li) / den;
    float* AB = (float*)(a.ws + WS_S5AB); float* AL = (float*)(a.ws + WS_S5AL); bf16_t* BBT = (bf16_t*)(a.ws + WS_S5BBT); bf16_t* CP = (bf16_t*)(a.ws + WS_S5CP);
    if (c == 0) { AB[gid * 2] = abr; AB[gid * 2 + 1] = abi;
        float pr = abr, pi = abi;
#pragma unroll
        for (int i = 0; i < 8; ++i) { const float nr2 = pr * pr - pi * pi, ni2 = 2.0f * pr * pi; pr = nr2; pi = ni2; }
        AL[gid * 2] = pr; AL[gid * 2 + 1] = pi; }
    { const float br = a.in[I_S5BR][gid * 16 + c], bi = a.in[I_S5BI][gid * 16 + c];
        BBT[(g * 128 + p) * 16 + c] = (bf16_t)(cvtpk(zr * br - zi * bi, 0.f) & 0xffffu); BBT[(g * 128 + 64 + p) * 16 + c] = (bf16_t)(cvtpk(zr * bi + zi * br, 0.f) & 0xffffu);
        CP[(g * 16 + c) * 128 + p] = (bf16_t)(cvtpk(a.in[I_S5CR][(g * 16 + c) * 64 + p], 0.f) & 0xffffu); CP[(g * 16 + c) * 128 + 64 + p] = (bf16_t)(cvtpk(-a.in[I_S5CI][(g * 16 + c) * 64 + p], 0.f) & 0xffffu); }
}
template <int MODE_>
__device__ __forceinline__ void ph_s5(const Args& a, MK_LAS unsigned char* lds) {
    constexpr int MODE = (MODE_ >= 1) ? 1 : 0;
    const int tid = MK_TID, lane = tid & 63, wave = tid >> 6, m = lane & 15, q = lane >> 4, gw = blockIdx.x * 8 + wave, NGW = gridDim.x * 8;
    const bf16_t* P = (const bf16_t*)(a.ws + WS_P); bf16_t* Z = (bf16_t*)(a.ws + ((MODE_ >= 2) ? (WS_P + 360 * MiB) : WS_H)); float* SX = (float*)(a.ws + WS_S5X);
    const bf16_t* BBT = (const bf16_t*)(a.ws + WS_S5BBT); const bf16_t* CP = (const bf16_t*)(a.ws + WS_S5CP); const float* AB = (const float*)(a.ws + WS_S5AB);
    MK_LAS float* Lbu = (MK_LAS float*)(lds + wave * 12800); MK_LAS unsigned char* Lx = lds + wave * 12800 + 8448;
    const bf16x8 zero8 = (bf16x8){0, 0, 0, 0, 0, 0, 0, 0};
    if (MODE == 1 && MK_S5_ACQ) { __builtin_amdgcn_fence(__ATOMIC_ACQUIRE, "agent"); asm volatile("s_waitcnt vmcnt(0)" ::: "memory"); }
    unsigned* qhead = (unsigned*)(a.ws + WS_S5Q + ((MODE_ >= 2) ? 64 : 0));
    int pend = -1; float xr = 0.f, xi = 0.f;
    for (int u0 = gw;; u0 += NGW) {
        int u = u0; bool cont = false;
        if (MODE == 1 && MK_S5_DYN) {
            if (MK_S5_PAIR && pend >= 0) { u = pend; pend = ((u + 1) & (MK_S5_PAIR - 1)) ? u + 1 : -1; cont = true; }
            else { unsigned c_ = 0u; if (lane == 0) c_ = __hip_atomic_fetch_add(qhead, 1u, __ATOMIC_RELAXED, __HIP_MEMORY_SCOPE_AGENT); u = __builtin_amdgcn_readfirstlane((int)c_); if (MK_S5_PAIR) { u *= MK_S5_PAIR; pend = (MK_S5_PAIR > 1) ? u + 1 : -1; } } }
        if (u >= 8192) break;
        const int seg = u & 63, s = u >> 6, b = s >> 6, g = s & 63;
        bf16x8 bbf[8], cpf[4];
#pragma unroll
        for (int ct = 0; ct < 8; ++ct) { bbf[ct] = zero8; if (q < 2) bbf[ct] = (MODE == 1 && MK_S5_NTP) ? __builtin_nontemporal_load((const bf16x8*)(BBT + (g * 128 + 16 * ct + m) * 16 + 8 * q)) : *(const bf16x8*)(BBT + (g * 128 + 16 * ct + m) * 16 + 8 * q); }
        if (MODE == 1) {
#pragma unroll
            for (int ks = 0; ks < 4; ++ks) cpf[ks] = MK_S5_NTP ? __builtin_nontemporal_load((const bf16x8*)(CP + (g * 16 + m) * 128 + 32 * ks + 8 * q)) : *(const bf16x8*)(CP + (g * 16 + m) * 128 + 32 * ks + 8 * q); }
        const float abr = (MODE == 1 && MK_S5_NTP) ? __builtin_nontemporal_load(AB + (g * 64 + lane) * 2) : AB[(g * 64 + lane) * 2], abi = (MODE == 1 && MK_S5_NTP) ? __builtin_nontemporal_load(AB + (g * 64 + lane) * 2 + 1) : AB[(g * 64 + lane) * 2 + 1], dch = a.in[I_S5D][g * 16 + m];
        if (!cont) { xr = 0.f; xi = 0.f; }
        if (MODE == 1 && !cont) {
            const float alr = MK_S5_NTP ? __builtin_nontemporal_load((const float*)(a.ws + WS_S5AL) + (g * 64 + lane) * 2) : ((const float*)(a.ws + WS_S5AL))[(g * 64 + lane) * 2], ali = MK_S5_NTP ? __builtin_nontemporal_load((const float*)(a.ws + WS_S5AL) + (g * 64 + lane) * 2 + 1) : ((const float*)(a.ws + WS_S5AL))[(g * 64 + lane) * 2 + 1];
            for (int c0 = 0; c0 < ((MODE_ == 2) ? 0 : seg); c0 += 16) { float tr[16], ti[16]; const int n = (seg - c0) < 16 ? (seg - c0) : 16;
#pragma unroll
                for (int i = 0; i < 16; ++i) { const size_t uu = (size_t)s * 64 + c0 + (i < n ? i : 0); if (MODE_ == 4 || MK_S5_SC1) { tr[i] = __hip_atomic_load(SX + uu * 128 + lane, __ATOMIC_RELAXED, MK_S5_SCOPE); ti[i] = __hip_atomic_load(SX + uu * 128 + 64 + lane, __ATOMIC_RELAXED, MK_S5_SCOPE); } else { tr[i] = SX[uu * 128 + lane]; ti[i] = SX[uu * 128 + 64 + lane]; } }
#pragma unroll
                for (int i = 0; i < 16; ++i) if (i < n) { const float nxr = alr * xr - ali * xi + tr[i], nxi = alr * xi + ali * xr + ti[i]; xr = nxr; xi = nxi; } } }
        const size_t rowu = (size_t)b * T + seg * 256;
        bf16x8 ufn = zero8; if (q < 2) ufn = (MODE == 1 && MK_S5_NT) ? __builtin_nontemporal_load((const bf16x8*)(P + (rowu + m) * CD_LD + g * 16 + 8 * q)) : *(const bf16x8*)(P + (rowu + m) * CD_LD + g * 16 + 8 * q);
        for (int tile = 0; tile < 16; ++tile) {
            const size_t row0 = rowu + tile * 16;
            const bf16x8 uf = ufn;
            if (tile < 15 && q < 2) ufn = (MODE == 1 && MK_S5_NT) ? __builtin_nontemporal_load((const bf16x8*)(P + (row0 + 16 + m) * CD_LD + g * 16 + 8 * q)) : *(const bf16x8*)(P + (row0 + 16 + m) * CD_LD + g * 16 + 8 * q);
            float uvv[4];
            if (MODE == 1) {
#pragma unroll
                for (int e = 0; e < 4; ++e) uvv[e] = bf2f(MK_S5_NT ? __builtin_nontemporal_load(P + (row0 + 4 * q + e) * CD_LD + g * 16 + m) : P[(row0 + 4 * q + e) * CD_LD + g * 16 + m]); }
#pragma unroll
            for (int ct = 0; ct < 8; ++ct) { f32x4 acc = (f32x4){0.f, 0.f, 0.f, 0.f}; acc = MFMA16(uf, bbf[ct], acc);
#pragma unroll
                for (int e = 0; e < 4; ++e) Lbu[(4 * q + e) * 132 + 16 * ct + m] = acc[e]; }
            asm volatile("s_waitcnt lgkmcnt(0)" ::: "memory");
#pragma unroll
            for (int tt = 0; tt < 16; ++tt) { const float br = Lbu[tt * 132 + lane], bi = Lbu[tt * 132 + 64 + lane];
                const float nxr = abr * xr - abi * xi + br, nxi = abr * xi + abi * xr + bi; xr = nxr; xi = nxi;
                if (MODE == 1) { *(MK_LAS bf16_t*)(Lx + tt * 272 + lane * 2) = (bf16_t)(cvtpk(xr, 0.f) & 0xffffu); *(MK_LAS bf16_t*)(Lx + tt * 272 + (64 + lane) * 2) = (bf16_t)(cvtpk(xi, 0.f) & 0xffffu); } }
            asm volatile("s_waitcnt lgkmcnt(0)" ::: "memory");
            if (MODE == 1) { f32x4 y = (f32x4){0.f, 0.f, 0.f, 0.f};
#pragma unroll
                for (int ks = 0; ks < 4; ++ks) y = MFMA16(*(const MK_LAS bf16x8*)(Lx + m * 272 + (32 * ks + 8 * q) * 2), cpf[ks], y);
#pragma unroll
                for (int e = 0; e < 4; ++e) { const size_t row = row0 + 4 * q + e;
                    Z[row * 1024 + g * 16 + m] = (bf16_t)(cvtpk(gelu_tanh(y[e] + dch * uvv[e]), 0.f) & 0xffffu); }
                asm volatile("s_waitcnt lgkmcnt(0)" ::: "memory"); }
        }
        if (MODE == 0) { if (MK_S5_SC1ST) { __hip_atomic_store(SX + (size_t)u * 128 + lane, xr, __ATOMIC_RELAXED, __HIP_MEMORY_SCOPE_AGENT); __hip_atomic_store(SX + (size_t)u * 128 + 64 + lane, xi, __ATOMIC_RELAXED, __HIP_MEMORY_SCOPE_AGENT); } else { SX[(size_t)u * 128 + lane] = xr; SX[(size_t)u * 128 + 64 + lane] = xi; } }
    }
}
__device__ __forceinline__ void ph_s5_chain(const Args& a) {
    const int idx = blockIdx.x * 64 + (MK_TID & 63); if (idx >= 8192) return;
    const int s = idx >> 6, p = idx & 63, g = s & 63; float* SX = (float*)(a.ws + WS_S5X); const float* AL = (const float*)(a.ws + WS_S5AL);
    const float alr = AL[(g * 64 + p) * 2], ali = AL[(g * 64 + p) * 2 + 1]; float xr = 0.f, xi = 0.f;
    for (int s0 = 0; s0 < 64; s0 += 16) { float tr[16], ti[16];
#pragma unroll
        for (int i = 0; i < 16; ++i) { const size_t u = (size_t)s * 64 + s0 + i; tr[i] = SX[u * 128 + p]; ti[i] = SX[u * 128 + 64 + p]; }
#pragma unroll
        for (int i = 0; i < 16; ++i) { const size_t u = (size_t)s * 64 + s0 + i; SX[u * 128 + p] = xr; SX[u * 128 + 64 + p] = xi; const float nxr = alr * xr - ali * xi + tr[i], nxi = alr * xi + ali * xr + ti[i]; xr = nxr; xi = nxi; } }
}
__device__ __forceinline__ void ph_fox_cumsum(const Args& a, MK_LAS unsigned char* lds) {
    const int lane = MK_TID & 63, wave = MK_TID >> 6, s = blockIdx.x, b = s >> 3, hd = s & 7;
    const float* logf = (const float*)(a.ws + WS_LOGF); float* cum = (float*)(a.ws + WS_CUM);
    MK_LAS double* tot = (MK_LAS double*)(lds + 8 * 12800);
    float v[32]; double sum = 0.0;
#pragma unroll
    for (int i = 0; i < 32; ++i) { v[i] = logf[((size_t)b * T + 2048 * wave + 64 * i + lane) * 8 + hd]; sum += (double)v[i]; }
#pragma unroll
    for (int o = 32; o > 0; o >>= 1) sum += __shfl_xor(sum, o);
    if (lane == 0) tot[wave] = sum;
    __syncthreads();
    double carry = 0.0;
    for (int w2 = 0; w2 < wave; ++w2) carry += tot[w2];
#pragma unroll
    for (int i = 0; i < 32; ++i) { float x = v[i];
#pragma unroll
        for (int o = 1; o < 64; o <<= 1) { const float w = __shfl_up(x, o); if (lane >= o) x += w; }
        cum[((size_t)b * T + 2048 * wave + 64 * i + lane) * 8 + hd] = (float)(carry + (double)x); carry += (double)__shfl(x, 63); }
    __syncthreads();
}
constexpr size_t WS_DELTA = WS_SCR;
constexpr size_t WS_ROWTOK = 15 * MiB;
constexpr size_t WS_WRH = 13 * MiB, WS_WRL = 13 * MiB + 512 * 1024, WS_RSTOK = 14 * MiB, WS_RSP = 14 * MiB + 512 * 1024;
constexpr int NRT = 1;
constexpr int RT_RED = 0, RT_SS = 8 * 32 * 48 * 4, RT_LOG = RT_SS + 8 * 32 * 4, RT_RSTD = RT_LOG + 32 * 36 * 4, RT_END = RT_RSTD + 128;
__device__ __forceinline__ void router_weight_prep(const Args& a) {
    const int gid = blockIdx.x * 512 + MK_TID, NG = gridDim.x * 512;
    bf16_t* WH = (bf16_t*)(a.ws + WS_WRH); bf16_t* WL = (bf16_t*)(a.ws + WS_WRL);
    for (int i = gid; i < 2 * 48 * 2048; i += NG) { const int layer = i / (48 * 2048), rem = i - layer * 48 * 2048, c = rem >> 11, k = rem & 2047;
        float w = 0.f; if (c < 4) w = a.in[I_MWG][((size_t)layer * D + k) * 4 + c]; else if (c < 36) w = a.in[I_MWR][((size_t)layer * D + k) * 32 + (c - 4)];
        w *= a.in[I_FFNW][layer * D + k];
        const unsigned hb = cvtpk(w, 0.f) & 0xffffu; const float hf = __uint_as_float(hb << 16);
        WH[i] = (bf16_t)hb; WL[i] = (bf16_t)(cvtpk(w - hf, 0.f) & 0xffffu); }
}
constexpr int RT_WROW = 272, RT_WARR = 48 * RT_WROW, RT_WBUF = 2 * RT_WARR, RT_LOGO = 2 * RT_WBUF, RT_END2 = RT_LOGO + 8 * 16 * 48 * 4;
static_assert(RT_END2 <= LDS_RING, "router lds");
template <int ABL = 0> __device__ __forceinline__ void ph_router(const Args& a, int layer, MK_LAS unsigned char* lds) {
    const int tid = MK_TID, lane = tid & 63, wave = tid >> 6, m = lane & 15, q = lane >> 4;
    MK_LAS int* Lh = (MK_LAS int*)(lds + LDS_MISC + 64);
    if (tid < 32) Lh[tid] = 0;
    __syncthreads();
    const float* x = (layer == 0) ? a.in[I_X] : a.out; const bf16_t* DL = (const bf16_t*)(a.ws + WS_DELTA); bf16_t* H = (bf16_t*)(a.ws + WS_H);
    const float* wn = a.in[I_FFNW] + layer * D; const float* bg = a.in[I_MBG] + layer * 4; const float* br = a.in[I_MBR] + layer * 32;
    const bf16_t* WH = (const bf16_t*)(a.ws + WS_WRH) + (size_t)layer * 48 * 2048; const bf16_t* WL = (const bf16_t*)(a.ws + WS_WRL) + (size_t)layer * 48 * 2048;
    int* re = (int*)(a.ws + WS_RE); float* rwt = (float*)(a.ws + WS_RWT);
    MK_LAS float* LOGW = (MK_LAS float*)(lds + RT_LOGO + wave * 16 * 48 * 4);
    for (int blk = blockIdx.x; blk < NTOK / 128; blk += gridDim.x) {
        const float* xrow = x + (size_t)(blk * 128 + 16 * wave + m) * D + 8 * q;
        const bf16_t* drow = DL + (size_t)(blk * 128 + 16 * wave + m) * D + 8 * q;
        f32x4 acc[3], xs[4][2], xn[4][2]; u32x4 ds[4], dn[4], wreg[3]; float ss = 0.f;
#pragma unroll
        for (int ct = 0; ct < 3; ++ct) acc[ct] = (f32x4){0.f, 0.f, 0.f, 0.f};
#define RT_WLOAD(c) do { _Pragma("unroll") for (int i = 0; i < 3; ++i) { const int j = tid + 512 * i, arr = j / 768, rem = j - arr * 768, r = rem >> 4, p16 = rem & 15; \
            wreg[i] = *(const u32x4*)((arr ? WL : WH) + (size_t)r * 2048 + 128 * (c) + 8 * p16); } } while (0)
#define RT_WSTORE(buf) do { _Pragma("unroll") for (int i = 0; i < 3; ++i) { const int j = tid + 512 * i, arr = j / 768, rem = j - arr * 768, r = rem >> 4, p16 = rem & 15; \
            *(MK_LAS u32x4*)(lds + (buf) * RT_WBUF + arr * RT_WARR + r * RT_WROW + p16 * 16) = wreg[i]; } } while (0)
#define RT_XLOAD(dst, dd, c) do { _Pragma("unroll") for (int s = 0; s < 4; ++s) { const float* xp = xrow + 128 * (c) + 32 * s; dst[s][0] = *(const f32x4*)xp; dst[s][1] = *(const f32x4*)(xp + 4); dd[s] = *(const u32x4*)(drow + 128 * (c) + 32 * s); } } while (0)
        RT_WLOAD(0); RT_XLOAD(xs, ds, 0);
        for (int c = 0; c < 16; ++c) { const int buf = c & 1;
            RT_WSTORE(buf);
            if (c < 15) { RT_WLOAD(c + 1); RT_XLOAD(xn, dn, c + 1); }
            __syncthreads();
            if (!(ABL & 1)) {
#pragma unroll
            for (int s = 0; s < 4; ++s) { f32x4 v0 = xs[s][0], v1 = xs[s][1]; { const u32x4 dd = ds[s]; v0[0] += bflo(dd.x); v0[1] += bfhi(dd.x); v0[2] += bflo(dd.y); v0[3] += bfhi(dd.y); v1[0] += bflo(dd.z); v1[1] += bfhi(dd.z); v1[2] += bflo(dd.w); v1[3] += bfhi(dd.w); }
                ss += (v0[0] * v0[0] + v0[1] * v0[1]) + (v0[2] * v0[2] + v0[3] * v0[3]) + (v1[0] * v1[0] + v1[1] * v1[1]) + (v1[2] * v1[2] + v1[3] * v1[3]);
                const u32x2 h0 = pk4(v0), h1 = pk4(v1); f32x4 f0, f1;
                f0[0] = bflo(h0.x); f0[1] = bfhi(h0.x); f0[2] = bflo(h0.y); f0[3] = bfhi(h0.y); f1[0] = bflo(h1.x); f1[1] = bfhi(h1.x); f1[2] = bflo(h1.y); f1[3] = bfhi(h1.y);
                const bf16x8 xh = mk8(h0, h1), xl = mk8(pk4(v0 - f0), pk4(v1 - f1));
                if (!(ABL & 2)) { const int k = 128 * c + 32 * s + 8 * q; const f32x4 g0 = *(const f32x4*)(wn + k), g1 = *(const f32x4*)(wn + k + 4);
                    const u32x2 p0 = pk4(v0 * g0), p1 = pk4(v1 * g1); u32x4 w; w.x = p0.x; w.y = p0.y; w.z = p1.x; w.w = p1.y;
                    *(u32x4*)(H + (size_t)(blk * 128 + 16 * wave + m) * D + k) = w; }
#pragma unroll
                for (int ct = 0; ct < 3; ++ct) { const MK_LAS unsigned char* wp = lds + buf * RT_WBUF + (16 * ct + m) * RT_WROW + (32 * s + 8 * q) * 2;
                    const bf16x8 wh = *(const MK_LAS bf16x8*)wp, wl = *(const MK_LAS bf16x8*)(wp + RT_WARR);
                    acc[ct] = MFMA16(xh, wh, acc[ct]); acc[ct] = MFMA16(xl, wh, acc[ct]); acc[ct] = MFMA16(xh, wl, acc[ct]); } } }
#pragma unroll
            for (int s = 0; s < 4; ++s) { xs[s][0] = xn[s][0]; xs[s][1] = xn[s][1]; ds[s] = dn[s]; }
        }
#undef RT_WLOAD
#undef RT_WSTORE
#undef RT_XLOAD
        ss += __shfl_xor(ss, 16); ss += __shfl_xor(ss, 32);
        const float rstd = rsqrtf(ss * (1.0f / D) + NORM_EPS);
#pragma unroll
        for (int e = 0; e < 4; ++e) { const float rs = __shfl(rstd, 4 * q + e);
#pragma unroll
            for (int ct = 0; ct < 3; ++ct) LOGW[(4 * q + e) * 48 + 16 * ct + m] = acc[ct][e] * rs; }
        asm volatile("s_waitcnt lgkmcnt(0)" ::: "memory");
        if (!(ABL & 4) && q == 0) { const MK_LAS float* lg = LOGW + m * 48; const int tok = blk * 128 + 16 * wave + m;
            float gl4[4];
#pragma unroll
            for (int c2 = 0; c2 < 4; ++c2) gl4[c2] = lg[c2] + bg[c2];
            int gi = 0; float gm = gl4[0];
#pragma unroll
            for (int c2 = 1; c2 < 4; ++c2) if (gl4[c2] > gm) { gm = gl4[c2]; gi = c2; }
            float gs = 0.f;
#pragma unroll
            for (int c2 = 0; c2 < 4; ++c2) gs += __expf(gl4[c2] - gm);
            const float gw = 1.0f / gs; const MK_LAS float* el = lg + 4 + gi * 8; const float* bre = br + gi * 8;
            float ev[8];
#pragma unroll
            for (int c2 = 0; c2 < 8; ++c2) ev[c2] = el[c2] + bre[c2];
            int i0 = 0; float v0 = ev[0];
#pragma unroll
            for (int c2 = 1; c2 < 8; ++c2) if (ev[c2] > v0) { v0 = ev[c2]; i0 = c2; }
            int i1 = -1; float v1 = -3.0e38f;
#pragma unroll
            for (int c2 = 0; c2 < 8; ++c2) if (c2 != i0 && ev[c2] > v1) { v1 = ev[c2]; i1 = c2; }
            const float ex = __expf(v1 - v0), w0 = gw / (1.0f + ex), w1 = gw * ex / (1.0f + ex);
            const int e0 = gi * 8 + i0, e1 = gi * 8 + i1; re[2 * tok] = e0; re[2 * tok + 1] = e1; rwt[2 * tok] = w0; rwt[2 * tok + 1] = w1;
            atomicAdd((int*)(Lh + e0), 1); atomicAdd((int*)(Lh + e1), 1); }
        if (q == 0) ((float*)(a.ws + WS_RSTOK))[blk * 128 + 16 * wave + m] = rstd;
        __syncthreads();
        if (tid < 32) { ((int*)(a.ws + WS_HIST))[blk * 32 + tid] = Lh[tid]; Lh[tid] = 0; }
        __syncthreads();
    }
}
__device__ __forceinline__ void ph_scatter(const Args& a, MK_LAS unsigned char* lds) {
    const int tid = MK_TID, lane = tid & 63, wave = tid >> 6;
    MK_LAS int* Lbase = (MK_LAS int*)(lds + LDS_MISC + 64); MK_LAS int* Lcur = Lbase + 32; MK_LAS int* Ltot = Lcur + 32; MK_LAS int* Loff = Ltot + 32;
    const int* hist = (const int*)(a.ws + WS_HIST); const int* re = (const int*)(a.ws + WS_RE); int* pos = (int*)(a.ws + WS_POS);
    const bf16_t* H = (const bf16_t*)(a.ws + WS_H); bf16_t* HP = (bf16_t*)(a.ws + WS_P);
    for (int blk = blockIdx.x; blk < NTOK / 128; blk += gridDim.x) {
        if (tid < 32) { Ltot[tid] = 0; Lbase[tid] = 0; Lcur[tid] = 0; }
        __syncthreads();
        {   const int e = tid & 31; int hv[16], tot = 0, bef = 0;
#pragma unroll
            for (int j = 0; j < 16; ++j) hv[j] = hist[((tid >> 5) + 16 * j) * 32 + e];
#pragma unroll
            for (int j = 0; j < 16; ++j) { tot += hv[j]; bef += (((tid >> 5) + 16 * j) < blk) ? hv[j] : 0; }
            atomicAdd((int*)(Ltot + e), tot); atomicAdd((int*)(Lbase + e), bef); }
        __syncthreads();
        if (tid == 0) { int off = 0; for (int e = 0; e < 32; ++e) { Loff[e] = off; off += ((Ltot[e] + 255) >> 8) << 8; }
            if (blk == 0) *(int*)(a.ws + WS_NT) = off >> 8; }
        __syncthreads();
        if (blk == 0 && tid < 32) { int* te = (int*)(a.ws + WS_TILEE); const int e = tid, t0 = Loff[e] >> 8, nt = (Ltot[e] + 255) >> 8; for (int q = 0; q < nt; ++q) te[t0 + q] = e; }
        {
            const int mb = blk * 128 + 16 * wave; int p0 = 0, p1 = 0;
            if (lane < 16) { const int m = mb + lane; const int e0 = re[2 * m], e1 = re[2 * m + 1];
                p0 = Loff[e0] + Lbase[e0] + atomicAdd((int*)(Lcur + e0), 1); p1 = Loff[e1] + Lbase[e1] + atomicAdd((int*)(Lcur + e1), 1);
                pos[2 * m] = p0; pos[2 * m + 1] = p1; { int* rowtok = (int*)(a.ws + WS_ROWTOK); rowtok[p0] = m; rowtok[p1] = m; } const float rs = ((const float*)(a.ws + WS_RSTOK))[m]; float* rsp = (float*)(a.ws + WS_RSP); rsp[p0] = rs; rsp[p1] = rs; }
            (void)H; (void)HP;
        }
        __syncthreads();
    }
}
__device__ __forceinline__ void ph_combine(const Args& a, int mode, MK_LAS unsigned char* lds) {
    const int lane = MK_TID & 63, gw = blockIdx.x * 8 + (MK_TID >> 6), NGW = gridDim.x * 8;
    const bf16_t* Y = (const bf16_t*)(a.ws + WS_P); const int* pos = (const int*)(a.ws + WS_POS); const float* rwt = (const float*)(a.ws + WS_RWT);
    bf16_t* H = (bf16_t*)(a.ws + WS_H); float* logf = (float*)(a.ws + WS_LOGF);
    MK_LAS f32x4* LW = (MK_LAS f32x4*)lds;
    if (mode == 0) {
        for (int s2 = MK_TID; s2 < 64 * 64; s2 += 512) { const int slot = s2 >> 6, l = s2 & 63, j = slot >> 3, i4 = (slot >> 1) & 3, half = slot & 1; const int k = 4 * (l + 64 * j) + i4;
            LW[s2] = *(const f32x4*)(a.in[I_CDIN] + (size_t)k * CD_COLS + 4096 + 4 * half); }
        __syncthreads(); }
    int pp0 = 0, pp1 = 0; float pw0 = 0.f, pw1 = 0.f;
    { const int mm = gw + lane * NGW; if (lane < 16 && mm < NTOK) { pp0 = pos[2 * mm]; pp1 = pos[2 * mm + 1]; pw0 = rwt[2 * mm]; pw1 = rwt[2 * mm + 1]; } }
    int ti = 0;
    for (int m = gw; m < NTOK; m += NGW, ++ti) {
        float* xr = a.out + (size_t)m * D; const float* xb = ((mode == 0) ? a.in[I_X] : a.out) + (size_t)m * D; const bf16_t* dr = (const bf16_t*)(a.ws + WS_DELTA) + (size_t)m * D; int p0, p1; float w0, w1;
        if (ti < 16) { p0 = __shfl(pp0, ti); p1 = __shfl(pp1, ti); w0 = __shfl(pw0, ti); w1 = __shfl(pw1, ti); } else { p0 = pos[2 * m]; p1 = pos[2 * m + 1]; w0 = rwt[2 * m]; w1 = rwt[2 * m + 1]; }
        const bf16_t* y0 = Y + (size_t)p0 * D; const bf16_t* y1 = Y + (size_t)p1 * D; f32x4 v[8];
#pragma unroll
        for (int j = 0; j < 8; ++j) { const int k = 4 * (lane + 64 * j); v[j] = *(const f32x4*)(xb + k); const u32x2 a0 = *(const u32x2*)(y0 + k), a1 = *(const u32x2*)(y1 + k), dd = *(const u32x2*)(dr + k);
            v[j][0] += bflo(dd.x); v[j][1] += bfhi(dd.x); v[j][2] += bflo(dd.y); v[j][3] += bfhi(dd.y);
            v[j][0] += w0 * bflo(a0.x) + w1 * bflo(a1.x); v[j][1] += w0 * bfhi(a0.x) + w1 * bfhi(a1.x); v[j][2] += w0 * bflo(a0.y) + w1 * bflo(a1.y); v[j][3] += w0 * bfhi(a0.y) + w1 * bfhi(a1.y); }
        const float rstd = row_rstd(v);
        if (mode == 0) {
#pragma unroll
            for (int j = 0; j < 8; ++j) *(f32x4*)(xr + 4 * (lane + 64 * j)) = v[j];
            norm_scale(v, rstd, a.in[I_MIXW] + D, lane); store_row_bf16(v, H + (size_t)m * D, lane);
            float fl[8];
#pragma unroll
            for (int q = 0; q < 8; ++q) fl[q] = 0.f;
#pragma unroll
            for (int j = 0; j < 8; ++j)
#pragma unroll
                for (int i4 = 0; i4 < 4; ++i4) { const f32x4 wa = LW[((j * 4 + i4) * 2 + 0) * 64 + lane], wb = LW[((j * 4 + i4) * 2 + 1) * 64 + lane];
#pragma unroll
                    for (int q = 0; q < 4; ++q) { fl[q] += v[j][i4] * wa[q]; fl[4 + q] += v[j][i4] * wb[q]; } }
#pragma unroll
            for (int q = 0; q < 8; ++q) fl[q] = wave_sum(fl[q]);
            if (lane < 8) { float f = fl[0];
#pragma unroll
                for (int q = 1; q < 8; ++q) f = (lane == q) ? fl[q] : f;
                logf[(size_t)m * 8 + lane] = -softplusf(-(f + a.in[I_FOXB][lane])); }
        } else {
            norm_scale(v, rstd, a.in[I_FINW], lane);
#pragma unroll
            for (int j = 0; j < 8; ++j) *(f32x4*)(xr + 4 * (lane + 64 * j)) = v[j];
        }
    }
    if (mode == 0) __syncthreads();
}
__device__ __forceinline__ void ph_s5_naive(const Args& a, MK_LAS unsigned char* lds) {
    const int tid = MK_TID, lane = tid & 63, wave = tid >> 6;
    if (blockIdx.x < 16) {
        constexpr int TS = 16;
        const int s = blockIdx.x * 8 + wave, b = s >> 6, g = s & 63, p = lane;
        const bf16_t* P = (const bf16_t*)(a.ws + WS_P); bf16_t* Z = (bf16_t*)(a.ws + WS_H);
        MK_LAS float* Lu = (MK_LAS float*)lds + wave * (TS * 16 + 2 * TS * 64); MK_LAS float* Lxr = Lu + TS * 16; MK_LAS float* Lxi = Lxr + TS * 64;
        const float lr = fminf(a.in[I_S5LR][g * 64 + p], -1e-4f), li = a.in[I_S5LI][g * 64 + p], dt = expf(a.in[I_S5DT][g]);
        const float mag = expf(lr * dt), abr = mag * cosf(li * dt), abi = mag * sinf(li * dt);
        const float nr = abr - 1.0f, ni = abi, den = lr * lr + li * li, zr = (nr * lr + ni * li) / den, zi = (ni * lr - nr * li) / den;
        float bbr[16], bbi[16];
#pragma unroll
        for (int c = 0; c < 16; ++c) { const float br = a.in[I_S5BR][(g * 64 + p) * 16 + c], bi = a.in[I_S5BI][(g * 64 + p) * 16 + c]; bbr[c] = zr * br - zi * bi; bbi[c] = zr * bi + zi * br; }
        float xr = 0.f, xi = 0.f;
        for (int t0 = 0; t0 < T; t0 += TS) {
#pragma unroll
            for (int q = 0; q < 4; ++q) { const int i = lane + 64 * q, tt = i >> 4, c = i & 15; Lu[i] = bf2f(P[((size_t)b * T + t0 + tt) * CD_LD + g * 16 + c]); }
            asm volatile("s_waitcnt lgkmcnt(0)" ::: "memory");
            for (int tt = 0; tt < TS; ++tt) { float ur = 0.f, ui = 0.f;
#pragma unroll
                for (int c = 0; c < 16; ++c) { const float u = Lu[tt * 16 + c]; ur += bbr[c] * u; ui += bbi[c] * u; }
                const float nxr = abr * xr - abi * xi + ur, nxi = abr * xi + abi * xr + ui; xr = nxr; xi = nxi;
                Lxr[tt * 64 + p] = xr; Lxi[tt * 64 + p] = xi; }
            asm volatile("s_waitcnt lgkmcnt(0)" ::: "memory");
#pragma unroll
            for (int q = 0; q < 4; ++q) { const int i = lane + 64 * q, tt = i >> 4, c = i & 15; float y = 0.f;
                const float* cr = a.in[I_S5CR] + (g * 16 + c) * 64; const float* ci = a.in[I_S5CI] + (g * 16 + c) * 64;
                for (int pp = 0; pp < 64; ++pp) y += cr[pp] * Lxr[tt * 64 + pp] - ci[pp] * Lxi[tt * 64 + pp];
                y += a.in[I_S5D][g * 16 + c] * Lu[i];
                Z[((size_t)b * T + t0 + tt) * 1024 + g * 16 + c] = (bf16_t)(cvt_pk_bf16(gelu_tanh(y), 0.f) & 0xffffu); }
            asm volatile("s_waitcnt lgkmcnt(0)" ::: "memory");
        }
    } else if (blockIdx.x < 32 && wave == 0) {
        const int s = blockIdx.x - 16, b = s >> 3, hd = s & 7;
        const float* logf = (const float*)(a.ws + WS_LOGF); float* cum = (float*)(a.ws + WS_CUM);
        double carry = 0.0;
        for (int t0 = 0; t0 < T; t0 += 64) { const size_t idx = ((size_t)b * T + t0 + lane) * 8 + hd;
            double v = (double)logf[idx];
#pragma unroll
            for (int o = 1; o < 64; o <<= 1) { const double u = __shfl_up(v, o); if (lane >= o) v += u; }
            cum[idx] = (float)(carry + v); carry += __shfl(v, 63); }
    }
}
__device__ __forceinline__ void ph_fox_naive(const Args& a, MK_LAS unsigned char* lds) {
    const int tid = MK_TID, lane = tid & 63, wave = tid >> 6, gw = blockIdx.x * 8 + wave, NGW = gridDim.x * 8;
    const bf16_t* P = (const bf16_t*)(a.ws + WS_P); bf16_t* O = (bf16_t*)(a.ws + WS_O); const float* cum = (const float*)(a.ws + WS_CUM);
    MK_LAS float* Lq = (MK_LAS float*)lds + wave * 128;
    const float scale = 0.08838834764831845f;
    for (int u = gw; u < NB * 8 * T; u += NGW) { const int bh = u / T, t = u % T, b = bh >> 3, hd = bh & 7; const size_t row = (size_t)b * T + t;
        { const unsigned w = *(const unsigned*)(P + row * CD_LD + 1024 + hd * 128 + 2 * lane); Lq[2 * lane] = bflo(w) * scale; Lq[2 * lane + 1] = bfhi(w) * scale; }
        asm volatile("s_waitcnt lgkmcnt(0)" ::: "memory");
        const float ct = cum[row * 8 + hd]; float mrun = -3.0e38f, lrun = 0.f, o0 = 0.f, o1 = 0.f;
        for (int j0 = 0; j0 <= t; j0 += 64) { const int key = j0 + lane; const bool valid = key <= t; const size_t krow = (size_t)b * T + (valid ? key : t);
            const u32x4* kp = (const u32x4*)(P + krow * CD_LD + 2048 + hd * 128); float dot = 0.f;
#pragma unroll
            for (int i = 0; i < 16; ++i) { const u32x4 kw = kp[i]; const f32x4 qa = *(const MK_LAS f32x4*)(Lq + 8 * i), qb = *(const MK_LAS f32x4*)(Lq + 8 * i + 4);
                dot += bflo(kw.x) * qa[0] + bfhi(kw.x) * qa[1] + bflo(kw.y) * qa[2] + bfhi(kw.y) * qa[3] + bflo(kw.z) * qb[0] + bfhi(kw.z) * qb[1] + bflo(kw.w) * qb[2] + bfhi(kw.w) * qb[3]; }
            const float sc = valid ? dot + (ct - cum[krow * 8 + hd]) : -3.0e38f;
            const float mnew = fmaxf(mrun, wave_max(sc)); const float pj = valid ? __expf(sc - mnew) : 0.f; const float corr = __expf(mrun - mnew);
            lrun = lrun * corr + wave_sum(pj); o0 *= corr; o1 *= corr; mrun = mnew;
            const int nk = (t - j0 + 1) < 64 ? (t - j0 + 1) : 64;
            for (int jj = 0; jj < nk; ++jj) { const float pb = __shfl(pj, jj); const unsigned vw = *(const unsigned*)(P + ((size_t)b * T + j0 + jj) * CD_LD + 3072 + hd * 128 + 2 * lane);
                o0 += pb * bflo(vw); o1 += pb * bfhi(vw); } }
        const float inv = 1.0f / lrun;
        *(unsigned*)(O + row * D + 1024 + hd * 128 + 2 * lane) = cvt_pk_bf16(o0 * inv, o1 * inv);
        asm volatile("s_waitcnt lgkmcnt(0)" ::: "memory");
    }
}
#if MK_RWKV_WP
#define RWKV_RA(b_, l_) ph_rwkv_wp<0>(b_, l_)
#define RWKV_RB(b_) ph_rwkv_wp_chain(b_)
#define RWKV_RC(b_, l_) ph_rwkv_wp<1>(b_, l_)
#else
#define RWKV_RA(b_, l_) ph_rwkv<0>(b_, l_)
#define RWKV_RB(b_) ph_rwkv_chain(b_)
#define RWKV_RC(b_, l_) ph_rwkv<1>(b_, l_)
#endif
enum { PH_PRO = 0, PH_INPROJ0, PH_MIXA0, PH_MIXA1, PH_MIXB0, PH_MIXC0, PH_OUTPROJ0, PH_ROUTE0, PH_SCAT0, PH_GU0, PH_DN0, PH_COMB0, PH_INPROJ1, PH_S5A, PH_FOX, PH_GLU, PH_OUTPROJ1, PH_ROUTE1, PH_SCAT1, PH_GU1, PH_DN1, PH_FINAL, NPH };

#if defined(MK_SELFCHK) || defined(MK_GSTRESS)
constexpr size_t WS_CKS = 128 * 1024, WS_BAD = 130 * 1024;
__device__ __forceinline__ void cks_range(const unsigned char* p, size_t nbytes, unsigned* dst) {
    const u32x4* q = (const u32x4*)p; const size_t n = nbytes / 16; unsigned s = 0u;
    for (size_t i = (size_t)blockIdx.x * 512 + MK_TID; i < n; i += (size_t)gridDim.x * 512) { const u32x4 v = q[i]; s += (v.x + 3u * v.y + 5u * v.z + 7u * v.w) * (unsigned)(2 * i + 1); }
#pragma unroll
    for (int o = 32; o > 0; o >>= 1) s += __shfl_xor(s, o);
    if ((MK_TID & 63) == 0) atomicAdd(dst, s);
}

constexpr size_t WS_TCKS = 132 * 1024;
__device__ __forceinline__ void cks_out_tiles(const Args& a, int slot) {
    unsigned* tc = (unsigned*)(a.ws + WS_TCKS) + slot * 1024;
    for (int t = blockIdx.x; t < 1024; t += gridDim.x) { const int pm = t >> 3, pn = t & 7; unsigned s = 0u;
        for (int i = MK_TID; i < 256 * 64; i += 512) { const int r = i >> 6, c4 = i & 63; const u32x4 v = *(const u32x4*)(a.out + (size_t)(pm * 256 + r) * D + pn * 256 + 4 * c4);
            s += (v.x + 3u * v.y + 5u * v.z + 7u * v.w) * (unsigned)(2 * i + 1); }
#pragma unroll
        for (int o = 32; o > 0; o >>= 1) s += __shfl_xor(s, o);
        if ((MK_TID & 63) == 0) atomicAdd(tc + t, s); }
}

constexpr size_t WS_UCKS = 192 * 1024;
__device__ __forceinline__ void cks_z_units(const Args& a, int slot) {
    unsigned* uc = (unsigned*)(a.ws + WS_UCKS) + slot * 8192;
#ifdef MK_S5_PROBE
    const bf16_t* Z = (const bf16_t*)(a.ws + WS_P + 360 * MiB);
#else
    const bf16_t* Z = (const bf16_t*)(a.ws + WS_H);
#endif
    const int lane = MK_TID & 63, gw = blockIdx.x * 8 + (MK_TID >> 6), NGW = gridDim.x * 8;
    for (int u = gw; u < 8192; u += NGW) { const int seg = u & 63, s2 = u >> 6, b2 = s2 >> 6, g = s2 & 63; unsigned sum = 0u;
        for (int i = 0; i < 32; ++i) { const int idx = i * 64 + lane, r = idx >> 3, d = idx & 7;
            const unsigned v = *(const unsigned*)(Z + ((size_t)b2 * T + seg * 256 + r) * 1024 + g * 16 + 2 * d); sum += v * (unsigned)(2 * idx + 1); }
#pragma unroll
        for (int o = 32; o > 0; o >>= 1) sum += __shfl_xor(sum, o);
        if (lane == 0) uc[u] = sum; }
}
__device__ __forceinline__ void ph_cks(const Args& a, int k, int slot) {
    unsigned* dst = (unsigned*)(a.ws + WS_CKS) + slot * 32 + k; unsigned char* ws = a.ws;
#define CR(lo_, hi_) cks_range(ws + (size_t)((lo_) * 1048576.0), (size_t)(((hi_) - (lo_)) * 1048576.0), dst)
#define COUT cks_range((const unsigned char*)a.out, (size_t)NTOK * D * 4, dst)
    switch (k) {
    case PH_PRO: CR(8, 14); CR(16, 400); break;
    case PH_INPROJ0: CR(528, 1008); break;
    case PH_MIXA0: CR(272, 336); CR(10, 10.5); CR(1008, 1136); CR(400, 528); break;
    case PH_MIXA1: CR(272, 400); break;
    case PH_MIXB0: CR(336, 368); CR(400, 528); break;
    case PH_MIXC0: CR(400, 528); break;
    case PH_OUTPROJ0: COUT; cks_out_tiles(a, slot); break;
    case PH_ROUTE0: case PH_ROUTE1: CR(272, 400); CR(2, 2.25); CR(3, 3.25); CR(1, 1.03125); CR(14, 14.125); break;
    case PH_SCAT0: case PH_SCAT1: CR(1.0625, 1.09375); break;
    case PH_COMB0: COUT; CR(272, 400); CR(5, 6); CR(80, 272); break;
    case PH_INPROJ1: CR(528, 784); break;
    case PH_S5A: CR(6, 7); CR(1008, 1012); CR(0.0625, 0.06256103515625); break;
    case PH_FOX: CR(400, 528); cks_range(ws + 272 * MiB, 64 * MiB, (unsigned*)(a.ws + WS_CKS) + slot * 32 + PH_DN0); break;
    case PH_GLU: CR(400, 528); break;
    case PH_OUTPROJ1: COUT; break;
    case PH_FINAL: COUT; break;
    default: break; }
#undef CR
#undef COUT
}
__device__ __forceinline__ void ph_poison(const Args& a) {
    const u32x4 pz = (u32x4){0xAAAAAAAAu, 0xAAAAAAAAu, 0xAAAAAAAAu, 0xAAAAAAAAu};
    { u32x4* q = (u32x4*)(a.ws + 1 * MiB); const size_t n = (WS_END - 1 * MiB) / 16; for (size_t i = (size_t)blockIdx.x * 512 + MK_TID; i < n; i += (size_t)gridDim.x * 512) q[i] = pz; }
    { u32x4* q = (u32x4*)a.out; const size_t n = (size_t)NTOK * D * 4 / 16; for (size_t i = (size_t)blockIdx.x * 512 + MK_TID; i < n; i += (size_t)gridDim.x * 512) q[i] = pz; }
    if (blockIdx.x == 0 && MK_TID < 256) ((unsigned*)(a.ws + 65536))[MK_TID] = 0u;
}
#endif
__device__ __forceinline__ Args load_args() {
    Args b{};
#if defined(__HIP_DEVICE_COMPILE__)
    typedef __attribute__((address_space(4))) const Args* KArgsPtr;
    unsigned long long v = (unsigned long long)__builtin_amdgcn_kernarg_segment_ptr(); asm volatile("" : "+s"(v)); const KArgsPtr k = (KArgsPtr)v;
#pragma unroll
    for (int i = 0; i < 39; ++i) b.in[i] = k->in[i];
    b.out = k->out; b.ws = k->ws; b.ph_lo = k->ph_lo; b.ph_hi = k->ph_hi;
#endif
    return b;
}
#define PHB const Args b = load_args(); unsigned char* const ws = b.ws; (void)ws;
#ifndef MK_ONE_LAUNCH
#define MK_ONE_LAUNCH 0
#endif
#ifndef MK_DUP
#define MK_DUP -1
#endif
__device__ __forceinline__ int probe_reps(bool dup) { int r = 1; if (dup) { r = 2; asm volatile("" : "+s"(r)); } return r; }
template <int ONLY> __global__ void __launch_bounds__(512, 2) fwd(Args a) {
    extern __shared__ __attribute__((aligned(16))) unsigned char lds_raw[];
    MK_LAS unsigned char* lds = (MK_LAS unsigned char*)lds_raw;
    if (MK_TID < 16) ((MK_LAS unsigned*)(lds + LDS_MISC))[MK_TID] = 0u;
    __syncthreads();
    const int lo = a.ph_lo, hi = a.ph_hi & 255;
    XcdBarrier bar; bar.bar = (unsigned*)(a.ws + WS_CTL); bar.x = 0; bar.st = nullptr;
#ifdef MK_GSTRESS
    const int pass_ = a.ph_hi >> 8;
    bar = xcd_barrier_post((unsigned*)(a.ws + WS_CTL), (volatile LAS unsigned*)(lds + LDS_MISC));
#else
    if (hi - lo > 1) bar = xcd_barrier_post((unsigned*)(a.ws + WS_CTL), (volatile LAS unsigned*)(lds + LDS_MISC));
#endif
#define IN(k) ((ONLY < 0 || (k) == ONLY) && lo <= (k) && (k) < hi)
#define REPS(k) ((MK_DUP == (k)) ? 2 : 1)
#ifdef MK_SELFCHK
#define SEAM(k) do { if (IN(k) && IN((k) + 1)) { xcd_barrier(bar); { PHB ph_cks(b, (k), slot_); } xcd_barrier(bar); if ((k) == PH_FOX) { { PHB cks_z_units(b, slot_); } xcd_barrier(bar); } } } while (0)
#else
#define SEAM(k) do { if (IN(k) && IN((k) + 1)) xcd_barrier(bar); } while (0)
#endif
#define H ((bf16_t*)(ws + WS_H))
#define O ((bf16_t*)(ws + WS_O))
#define P ((bf16_t*)(ws + WS_P))
#define HID ((bf16_t*)(ws + WS_HID))
    const int G = (int)gridDim.x, c = (int)blockIdx.x;
#ifdef MK_SELFCHK
    const int pass_ = a.ph_hi >> 8, slot_ = pass_ ? 1 : 0;
#endif

    if (IN(PH_PRO)) for (int rep_ = 0; rep_ < REPS(PH_PRO); ++rep_) { PHB ph_prologue(b, lds); rwkv_convert_small(b); s5_param_prep(b); router_weight_prep(b); } SEAM(PH_PRO);
    if (IN(PH_INPROJ0)) for (int rep_ = 0; rep_ < REPS(PH_INPROJ0); ++rep_) { PHB pg8::Gemm g{H, (const bf16_t*)(ws + WS_ABIN), NTOK, AB_LD, D}; pg8::StaticOrder S; S.init(NTOK, AB_LD, G, c); pg8::EpiStoreBf16 E{P, AB_LD, 0x7fffffff};
        pg8::gemm_phase<pg8::EpiStoreBf16, pg8::StaticOrder, MK_INPROJ_ALIGN, true>(lds, g, S, E); } SEAM(PH_INPROJ0);
#ifdef MK_GSTRESS
    if (hi == 2) { const int slot_ = pass_ ? 1 : 0;
        xcd_barrier(bar); { PHB cks_range(b.ws + WS_P, 480 * MiB, (unsigned*)(b.ws + WS_CKS) + slot_ * 32 + 0); }
        xcd_barrier(bar); { PHB cks_range(b.ws + WS_P, 480 * MiB, (unsigned*)(b.ws + WS_CKS) + slot_ * 32 + 1); }
        xcd_barrier(bar);
        if (blockIdx.x == 0 && MK_TID == 0) { PHB unsigned* ck = (unsigned*)(b.ws + WS_CKS); unsigned* bad = (unsigned*)(b.ws + WS_BAD);
            const unsigned r0 = __hip_atomic_load(ck + 0, __ATOMIC_RELAXED, __HIP_MEMORY_SCOPE_AGENT), a0 = __hip_atomic_load(ck + slot_ * 32 + 0, __ATOMIC_RELAXED, __HIP_MEMORY_SCOPE_AGENT), a1 = __hip_atomic_load(ck + slot_ * 32 + 1, __ATOMIC_RELAXED, __HIP_MEMORY_SCOPE_AGENT);
            unsigned code = 0u; if (a0 != a1) code = 2u; else if (a0 != r0) code = 1u;
            if (code != 0u && __hip_atomic_load(bad, __ATOMIC_RELAXED, __HIP_MEMORY_SCOPE_AGENT) == 0u) __hip_atomic_store(bad, code, __ATOMIC_RELAXED, __HIP_MEMORY_SCOPE_AGENT);
            if (slot_) { __hip_atomic_store(ck + 32, 0u, __ATOMIC_RELAXED, __HIP_MEMORY_SCOPE_AGENT); __hip_atomic_store(ck + 33, 0u, __ATOMIC_RELAXED, __HIP_MEMORY_SCOPE_AGENT); } } }
#endif
    if (IN(PH_MIXA0)) for (int rep_ = 0; rep_ < REPS(PH_MIXA0); ++rep_) { PHB ph_hgrn2<0>(b, lds); ph_rwkv_pre<0>(b, lds); } SEAM(PH_MIXA0);
    if (IN(PH_MIXA1)) for (int rep_ = 0; rep_ < REPS(PH_MIXA1); ++rep_) { PHB RWKV_RA(b, lds); if (rep_ == 0) ph_hgrn2_chain(b, 0); } SEAM(PH_MIXA1);
    if (IN(PH_MIXB0)) for (int rep_ = 0; rep_ < REPS(PH_MIXB0); ++rep_) { PHB if (rep_ == 0 && blockIdx.x < 16) RWKV_RB(b); ph_hgrn2<1>(b, lds, 16); } SEAM(PH_MIXB0);
    if (IN(PH_MIXC0)) for (int rep_ = 0; rep_ < REPS(PH_MIXC0); ++rep_) { PHB RWKV_RC(b, lds); } SEAM(PH_MIXC0);
    if (IN(PH_OUTPROJ0)) for (int rep_ = 0; rep_ < REPS(PH_OUTPROJ0); ++rep_) { PHB pg8::Gemm g{O, (const bf16_t*)(ws + WS_ABOUT), NTOK, D, D}; pg8::StaticOrder S; S.init(NTOK, D, G, c); pg8::EpiStoreBf16 E{(bf16_t*)(ws + WS_DELTA), D, 0x7fffffff};
        pg8::gemm_phase<pg8::EpiStoreBf16, pg8::StaticOrder, true, true>(lds, g, S, E); } SEAM(PH_OUTPROJ0);
    if (IN(PH_ROUTE0)) for (int rep_ = 0; rep_ < REPS(PH_ROUTE0); ++rep_) { PHB ph_router<0>(b, 0, lds); } SEAM(PH_ROUTE0);
    if (IN(PH_SCAT0)) for (int rep_ = 0; rep_ < REPS(PH_SCAT0); ++rep_) { PHB ph_scatter(b, lds); } SEAM(PH_SCAT0);
    if (IN(PH_GU0)) for (int rep_ = 0; rep_ < REPS(PH_GU0); ++rep_) { PHB const int nt = *(const int*)(ws + WS_NT); pg8::Gemm g{H, (const bf16_t*)(ws + WS_GU), ROWS_MAX, NEXP * 1024, D}; pg8::MoeGatherOrder S{(const int*)(ws + WS_TILEE), nt * 4, 4, G, c, (const int*)(ws + WS_ROWTOK), NTOK}; pg8::EpiSwiGlu E{HID, (const float*)(ws + WS_RSP)};
        pg8::gemm_phase<pg8::EpiSwiGlu, pg8::MoeGatherOrder, true, true, true>(lds, g, S, E); } SEAM(PH_GU0);
    if (IN(PH_DN0)) for (int rep_ = 0; rep_ < REPS(PH_DN0); ++rep_) { PHB const int nt = *(const int*)(ws + WS_NT); pg8::Gemm g{HID, (const bf16_t*)(ws + WS_DN), ROWS_MAX, NEXP * D, FF}; pg8::MoeOrder S{(const int*)(ws + WS_TILEE), nt * 8, 8, G, c}; pg8::EpiStoreBf16 E{P, D, 7};
        pg8::gemm_phase<pg8::EpiStoreBf16, pg8::MoeOrder, true, true>(lds, g, S, E); } SEAM(PH_DN0);
    if (IN(PH_COMB0)) for (int rep_ = 0; rep_ < REPS(PH_COMB0); ++rep_) { PHB ph_combine(b, 0, lds); convert_items<2>(b, (MK_LAS float*)lds); } SEAM(PH_COMB0);
    if (IN(PH_INPROJ1)) for (int rep_ = 0; rep_ < REPS(PH_INPROJ1); ++rep_) { PHB pg8::Gemm g{H, (const bf16_t*)(ws + WS_CDIN), NTOK, CD_LD, D}; pg8::StaticOrder S; S.init(NTOK, CD_LD, G, c); pg8::EpiStoreBf16 E{P, CD_LD, 0x7fffffff};
        pg8::gemm_phase<pg8::EpiStoreBf16, pg8::StaticOrder, MK_INPROJ_ALIGN, true>(lds, g, S, E); } SEAM(PH_INPROJ1);
    if (IN(PH_S5A)) for (int rep_ = 0; rep_ < REPS(PH_S5A); ++rep_) { PHB if (blockIdx.x < 16) ph_fox_cumsum(b, lds); ph_fox_kmax(b); ph_s5<0>(b, lds);
#if MK_S5_REL
        asm volatile("s_waitcnt vmcnt(0)" ::: "memory"); __builtin_amdgcn_fence(__ATOMIC_RELEASE, "agent"); asm volatile("s_waitcnt vmcnt(0)" ::: "memory");
#endif
        } SEAM(PH_S5A);
    if (IN(PH_FOX)) for (int rep_ = 0; rep_ < REPS(PH_FOX); ++rep_) { PHB if (MK_S5_FIRST) { ph_s5<1>(b, lds); __syncthreads(); ph_fox(b, lds); } else { ph_fox(b, lds); if (MK_S5_SEP) xcd_barrier(bar); ph_s5<1>(b, lds); }
#ifdef MK_S5_PROBE
        ph_s5<MK_S5_PROBE>(b, lds);
#endif
 } SEAM(PH_FOX);
    if (IN(PH_GLU)) for (int rep_ = 0; rep_ < REPS(PH_GLU); ++rep_) { PHB pg8::Gemm g{H, (const bf16_t*)(ws + WS_GLU), NTOK, 1024, 1024}; pg8::StaticOrder S; S.init(NTOK, 1024, G, c); pg8::EpiGlu E{H, 1024, b.in[I_S5BG], O, D};
        pg8::gemm_phase<pg8::EpiGlu, pg8::StaticOrder, true, true>(lds, g, S, E); } SEAM(PH_GLU);
    if (IN(PH_OUTPROJ1)) for (int rep_ = 0; rep_ < REPS(PH_OUTPROJ1); ++rep_) { PHB pg8::Gemm g{O, (const bf16_t*)(ws + WS_CDOUT), NTOK, D, D}; pg8::StaticOrder S; S.init(NTOK, D, G, c); pg8::EpiStoreBf16 E{(bf16_t*)(ws + WS_DELTA), D, 0x7fffffff};
        pg8::gemm_phase<pg8::EpiStoreBf16, pg8::StaticOrder, true, true>(lds, g, S, E); } SEAM(PH_OUTPROJ1);
    if (IN(PH_ROUTE1)) for (int rep_ = 0; rep_ < REPS(PH_ROUTE1); ++rep_) { PHB ph_router<0>(b, 1, lds); } SEAM(PH_ROUTE1);
    if (IN(PH_SCAT1)) for (int rep_ = 0; rep_ < REPS(PH_SCAT1); ++rep_) { PHB ph_scatter(b, lds); } SEAM(PH_SCAT1);
    if (IN(PH_GU1)) for (int rep_ = 0; rep_ < REPS(PH_GU1); ++rep_) { PHB const int nt = *(const int*)(ws + WS_NT); pg8::Gemm g{H, (const bf16_t*)(ws + WS_GU), ROWS_MAX, NEXP * 1024, D}; pg8::MoeGatherOrder S{(const int*)(ws + WS_TILEE), nt * 4, 4, G, c, (const int*)(ws + WS_ROWTOK), NTOK}; pg8::EpiSwiGlu E{HID, (const float*)(ws + WS_RSP)};
        pg8::gemm_phase<pg8::EpiSwiGlu, pg8::MoeGatherOrder, true, true, true>(lds, g, S, E); } SEAM(PH_GU1);
    if (IN(PH_DN1)) for (int rep_ = 0; rep_ < REPS(PH_DN1); ++rep_) { PHB const int nt = *(const int*)(ws + WS_NT); pg8::Gemm g{HID, (const bf16_t*)(ws + WS_DN), ROWS_MAX, NEXP * D, FF}; pg8::MoeOrder S{(const int*)(ws + WS_TILEE), nt * 8, 8, G, c}; pg8::EpiStoreBf16 E{P, D, 7};
        pg8::gemm_phase<pg8::EpiStoreBf16, pg8::MoeOrder, true, true>(lds, g, S, E); } SEAM(PH_DN1);
    if (IN(PH_FINAL)) for (int rep_ = 0; rep_ < REPS(PH_FINAL); ++rep_) { PHB ph_combine(b, 1, lds); }
#ifdef MK_SELFCHK
    xcd_barrier(bar); { PHB ph_cks(b, PH_FINAL, slot_); } xcd_barrier(bar);
    if (pass_ > 0 && blockIdx.x == 0 && MK_TID == 0) { PHB unsigned* ck = (unsigned*)(b.ws + WS_CKS); unsigned* bad = (unsigned*)(b.ws + WS_BAD);
        { const unsigned* uc = (const unsigned*)(b.ws + WS_UCKS); unsigned cnt = 0u, firstu = 0u, nstr = 0u, lasts = 0xffffffffu;
          for (int u = 0; u < 8192; ++u) { const unsigned r0 = __hip_atomic_load(uc + u, __ATOMIC_RELAXED, __HIP_MEMORY_SCOPE_AGENT), r1 = __hip_atomic_load(uc + 8192 + u, __ATOMIC_RELAXED, __HIP_MEMORY_SCOPE_AGENT);
              if (r0 != r1) { if (cnt == 0u) firstu = (unsigned)u; ++cnt; if ((unsigned)(u >> 6) != lasts) { lasts = (unsigned)(u >> 6); ++nstr; } } }
          if (cnt != 0u && MK_UNITCMP) { __hip_atomic_store(bad, 0u, __ATOMIC_RELAXED, __HIP_MEMORY_SCOPE_AGENT); __hip_atomic_store(bad + 1, 1000u + firstu, __ATOMIC_RELAXED, __HIP_MEMORY_SCOPE_AGENT); __hip_atomic_store(bad + 2, 1u, __ATOMIC_RELAXED, __HIP_MEMORY_SCOPE_AGENT); } }
        for (int k = 23; k >= 0; --k) { const unsigned r0 = __hip_atomic_load(ck + k, __ATOMIC_RELAXED, __HIP_MEMORY_SCOPE_AGENT), r1 = __hip_atomic_load(ck + 32 + k, __ATOMIC_RELAXED, __HIP_MEMORY_SCOPE_AGENT);
            if (r0 != r1 && __hip_atomic_load(bad + 2, __ATOMIC_RELAXED, __HIP_MEMORY_SCOPE_AGENT) == 0u) { const unsigned cur = __hip_atomic_load(bad, __ATOMIC_RELAXED, __HIP_MEMORY_SCOPE_AGENT); if (cur == 0u || (unsigned)(k + 1) < cur) __hip_atomic_store(bad, (unsigned)(k + 1), __ATOMIC_RELAXED, __HIP_MEMORY_SCOPE_AGENT); }
            __hip_atomic_store(ck + 32 + k, 0u, __ATOMIC_RELAXED, __HIP_MEMORY_SCOPE_AGENT); }
        { unsigned* tc = (unsigned*)(b.ws + WS_TCKS); unsigned rowm[4] = {0u, 0u, 0u, 0u}, colm = 0u;
          for (int t = 0; t < 1024; ++t) { const unsigned r0 = __hip_atomic_load(tc + t, __ATOMIC_RELAXED, __HIP_MEMORY_SCOPE_AGENT), r1 = __hip_atomic_load(tc + 1024 + t, __ATOMIC_RELAXED, __HIP_MEMORY_SCOPE_AGENT);
              if (r0 != r1) { rowm[(t >> 3) >> 5] |= 1u << ((t >> 3) & 31); colm |= 1u << (t & 7); }
              __hip_atomic_store(tc + 1024 + t, 0u, __ATOMIC_RELAXED, __HIP_MEMORY_SCOPE_AGENT); }
          const int nrow = __popc(rowm[0]) + __popc(rowm[1]) + __popc(rowm[2]) + __popc(rowm[3]), ncol = __popc(colm);
          if (nrow > 0 && __hip_atomic_load(bad + 2, __ATOMIC_RELAXED, __HIP_MEMORY_SCOPE_AGENT) == 0u && __hip_atomic_load(bad + 1, __ATOMIC_RELAXED, __HIP_MEMORY_SCOPE_AGENT) == 0u) __hip_atomic_store(bad + 1, (unsigned)(10 * (nrow < 9 ? nrow : 9) + (ncol < 8 ? ncol : 8)), __ATOMIC_RELAXED, __HIP_MEMORY_SCOPE_AGENT); } }
    xcd_barrier(bar);
    if (pass_ == MK_SELFCHK - 1) { PHB const unsigned bad = __hip_atomic_load((unsigned*)(b.ws + WS_BAD), __ATOMIC_RELAXED, __HIP_MEMORY_SCOPE_AGENT);
      const unsigned tcode = __hip_atomic_load((unsigned*)(b.ws + WS_BAD) + 1, __ATOMIC_RELAXED, __HIP_MEMORY_SCOPE_AGENT);
      const unsigned long long ticks = (unsigned long long)bad * 500000ull + (unsigned long long)tcode * 2000ull; const unsigned long long t0 = wall_clock64();
      while (wall_clock64() - t0 < ticks) __builtin_amdgcn_s_sleep(8); }
#endif
#ifdef MK_GSTRESS
    if (hi == NPH) { xcd_barrier(bar); { PHB const unsigned bad = __hip_atomic_load((unsigned*)(b.ws + WS_BAD), __ATOMIC_RELAXED, __HIP_MEMORY_SCOPE_AGENT);
      if (bad != 0u) { const float sc = 1.0f + (float)bad; f32x4* q = (f32x4*)b.out; const size_t n = (size_t)NTOK * D / 4;
          for (size_t i = (size_t)blockIdx.x * 512 + MK_TID; i < n; i += (size_t)gridDim.x * 512) q[i] = q[i] * sc; } } }
#endif
#ifdef MK_TAIL
    if (hi == NPH) { xcd_barrier(bar); { PHB
        if (MK_TAIL == PH_MIXA1) RWKV_RA(b, lds);
        if (MK_TAIL == PH_ROUTE0) ph_router<0>(b, 0, lds);
        if (MK_TAIL == PH_MIXA0) ph_hgrn2<0>(b, lds);
        if (MK_TAIL == PH_MIXB0) ph_hgrn2<1>(b, lds);
        if (MK_TAIL >= 400 && MK_TAIL < 408) ph_rwkv_pre<(MK_TAIL >= 400 && MK_TAIL < 408) ? MK_TAIL - 400 : 0>(b, lds);
        if (MK_TAIL >= 300 && MK_TAIL < 316) ph_router<(MK_TAIL >= 300 && MK_TAIL < 316) ? MK_TAIL - 300 : 0>(b, 0, lds);
        if (MK_TAIL >= 200 && MK_TAIL < 264) ph_rwkv<1, (MK_TAIL >= 200 && MK_TAIL < 264) ? MK_TAIL - 200 : 0>(b, lds);
        if (MK_TAIL == 101) { if (blockIdx.x < 16) RWKV_RB(b); }
        if (MK_TAIL == 102) ph_hgrn2_chain(b, 0);
        if (MK_TAIL == 103) { convert_items<2>(b, (MK_LAS float*)lds); }
        if (MK_TAIL == 104) ph_scatter(b, lds);
        if (MK_TAIL == 105) { ph_fox_kmax(b); }
        if (MK_TAIL == 106) { xcd_barrier(bar); xcd_barrier(bar); xcd_barrier(bar); xcd_barrier(bar); xcd_barrier(bar); xcd_barrier(bar); xcd_barrier(bar); xcd_barrier(bar); xcd_barrier(bar); xcd_barrier(bar); }
    } }
#endif
#undef IN
#undef SEAM
#undef H
#undef O
#undef P
#undef HID
}

#ifdef MK_HB
template <int MIT> __global__ void __launch_bounds__(512, 2) hb_kernel(Args a) {
    extern __shared__ __attribute__((aligned(16))) unsigned char lds_raw[];
    MK_LAS unsigned char* lds = (MK_LAS unsigned char*)lds_raw;
    if (MK_TID < 16) ((MK_LAS unsigned*)(lds + LDS_MISC))[MK_TID] = 0u;
    __syncthreads();
    unsigned* ctl = (unsigned*)(a.ws + 256 * 1024);
    XcdBarrier bar = xcd_barrier_post(ctl, (volatile LAS unsigned*)(lds + LDS_MISC));
    const int c = (int)blockIdx.x, G = (int)gridDim.x, r = (c * 37 + 11) % G;
    unsigned nb = 0u, nb2 = 0u, first = 0xffffffffu;
    for (int it = 0; it < MK_HB; ++it) {
        u32x4* dst = (u32x4*)(a.ws + WS_P + (size_t)c * 262144);
#pragma unroll 8
        for (int i = 0; i < 32; ++i) { const unsigned idx = (unsigned)(MK_TID + 512 * i); const unsigned h = (unsigned)it * 0x9E3779B1u + (unsigned)c * 0x85EBCA77u + idx * 0xC2B2AE3Du;
            u32x4 v; v.x = h; v.y = h ^ 0x5555u; v.z = h + 77u; v.w = ~h;
#if MK_HB_SC1
            __builtin_nontemporal_store(v, dst + idx);
#else
            dst[idx] = v;
#endif
        }
#if MK_HB_FENCE
        asm volatile("s_waitcnt vmcnt(0)" ::: "memory"); __syncthreads();
        if (MK_TID == 0) { __builtin_amdgcn_fence(__ATOMIC_RELEASE, "agent"); asm volatile("s_waitcnt vmcnt(0)" ::: "memory"); }
#endif
        xcd_barrier(bar);
        const u32x4* src = (const u32x4*)(a.ws + WS_P + (size_t)r * 262144);
#pragma unroll 8
        for (int i = 0; i < 32; ++i) { const unsigned idx = (unsigned)(MK_TID + 512 * i); const unsigned h = (unsigned)it * 0x9E3779B1u + (unsigned)r * 0x85EBCA77u + idx * 0xC2B2AE3Du;
            const u32x4 v = src[idx]; if (v.x != h || v.y != (h ^ 0x5555u) || v.z != h + 77u || v.w != ~h) { ++nb; if (first == 0xffffffffu) first = (unsigned)it; } }
        xcd_barrier(bar);
        { unsigned* sc = (unsigned*)(a.ws + WS_P + 64 * MiB);
#pragma unroll
          for (int j = 0; j < 8; ++j) { const unsigned e = (((unsigned)(c * 4096 + MK_TID * 8 + j)) * 2654435761u + (unsigned)it * 40503u) & 0xFFFFFu; sc[e] = (unsigned)it * 0x9E3779B1u + e; }
          xcd_barrier(bar);
          const u32x4 v0 = *(const u32x4*)(sc + c * 4096 + MK_TID * 8), v1 = *(const u32x4*)(sc + c * 4096 + MK_TID * 8 + 4); const unsigned e0 = (unsigned)(c * 4096 + MK_TID * 8), kk = (unsigned)it * 0x9E3779B1u;
          if (v0.x != kk + e0 || v0.y != kk + e0 + 1 || v0.z != kk + e0 + 2 || v0.w != kk + e0 + 3 || v1.x != kk + e0 + 4 || v1.y != kk + e0 + 5 || v1.z != kk + e0 + 6 || v1.w != kk + e0 + 7) ++nb2;
          xcd_barrier(bar); }
    }
    if (nb2) atomicAdd(ctl + 8195, nb2);
    if (nb) { atomicAdd(ctl + 8192, nb); atomicAdd(ctl + 8193, 1u); atomicMin(ctl + 8194, first); }
    xcd_barrier(bar);
    { const unsigned tot = __hip_atomic_load(ctl + 8192, __ATOMIC_RELAXED, __HIP_MEMORY_SCOPE_AGENT);
      const unsigned tot2 = __hip_atomic_load(ctl + 8195, __ATOMIC_RELAXED, __HIP_MEMORY_SCOPE_AGENT);
      if (tot != 0u || tot2 != 0u) { unsigned code = (tot != 0u) ? 1u : 41u, t = (tot != 0u) ? tot : tot2; while (t > 1u) { t >>= 1; ++code; }
          const float sc = 1.0f + (float)code; f32x4* q = (f32x4*)a.out; const size_t n = (size_t)NTOK * D / 4;
          for (size_t i = (size_t)blockIdx.x * 512 + MK_TID; i < n; i += (size_t)gridDim.x * 512) q[i] = q[i] * sc; } }
}
#endif
}

#ifdef MK_PROBE_ONLY
static const void* const fn_table[1] = {(const void*)mk::fwd<MK_PROBE_ONLY>};
constexpr int N_FN = 1;
#elif MK_ONE_LAUNCH
static const void* const fn_table[1] = {(const void*)mk::fwd<-1>};
constexpr int N_FN = 1;
#else
#define FN(k) (const void*)mk::fwd<k>
static const void* const fn_table[mk::NPH] = {FN(0), FN(1), FN(2), FN(3), FN(4), FN(5), FN(6), FN(7), FN(8), FN(9), FN(10), FN(11), FN(12), FN(13), FN(14), FN(15), FN(16), FN(17), FN(18), FN(19), FN(20), FN(21)};
constexpr int N_FN = mk::NPH;
#endif
extern "C" void kernel_launch(void* const* d_in, const int* in_sizes, int n_in, void* d_out, int out_size, void* d_ws, size_t ws_size, hipStream_t stream) {
    static int grid = 0;
    if (grid == 0) {
        if (n_in != 39 || ws_size < mk::WS_END) { fprintf(stderr, "kernel_launch: built for 39 inputs and >= %zu bytes of workspace; got n_in %d, ws %zu; nothing launched\n", (size_t)mk::WS_END, n_in, ws_size); grid = -1; return; }
        int dev = 0, cus = 0, per_cu = 0;
        if (hipGetDevice(&dev) != hipSuccess || hipDeviceGetAttribute(&cus, hipDeviceAttributeMultiprocessorCount, dev) != hipSuccess) { grid = -1; return; }
        for (int ph = 0; ph < N_FN; ++ph) if (hipFuncSetAttribute(fn_table[ph], hipFuncAttributeMaxDynamicSharedMemorySize, mk::LDS_BYTES) != hipSuccess) { fprintf(stderr, "kernel_launch: hipFuncSetAttribute failed\n"); grid = -1; return; }
        if (hipOccupancyMaxActiveBlocksPerMultiprocessor(&per_cu, fn_table[0], 512, mk::LDS_BYTES) != hipSuccess || per_cu < 1) fprintf(stderr, "kernel_launch: note: occupancy query reports %d workgroups per CU\n", per_cu);
        (void)hipGetLastError();
        grid = cus > 0 ? cus : 256;
    }
    if (grid < 0) return;
    (void)in_sizes; (void)out_size;
    if (hipMemsetAsync((char*)d_ws + mk::WS_CTL, 0, mk::CTL_ZERO, stream) != hipSuccess) return;
    mk::Args a{};
    for (int i = 0; i < 39; ++i) a.in[i] = (const float*)d_in[i];
    a.out = (float*)d_out; a.ws = (unsigned char*)d_ws;
    void* kargs[] = {&a};
#if defined(MK_HB)
    a.ph_lo = 0; a.ph_hi = mk::NPH;
    (void)hipLaunchKernel(fn_table[0], dim3(grid), dim3(512), kargs, mk::LDS_BYTES, stream);
    { static bool attr = false; if (!attr) { (void)hipFuncSetAttribute((const void*)mk::hb_kernel<0>, hipFuncAttributeMaxDynamicSharedMemorySize, mk::LDS_BYTES); attr = true; }
      (void)hipLaunchKernel((const void*)mk::hb_kernel<0>, dim3(grid), dim3(512), kargs, mk::LDS_BYTES, stream); }
#elif defined(MK_GSTRESS)
    for (int pass = 0; pass < MK_GSTRESS; ++pass) {
        if (pass > 0) { if (hipMemsetAsync((char*)d_ws, 0, 128 * 1024, stream) != hipSuccess) return; }
        if (pass > 0 && pass < MK_GSTRESS - 1) { if (hipMemsetAsync((char*)d_ws + mk::WS_P, 0xAA, 480 * mk::MiB, stream) != hipSuccess) return; }
        a.ph_lo = (pass == 0) ? 0 : ((pass == MK_GSTRESS - 1) ? 2 : 1); a.ph_hi = ((pass == MK_GSTRESS - 1) ? mk::NPH : 2) | (pass << 8);
        (void)hipLaunchKernel(fn_table[0], dim3(grid), dim3(512), kargs, mk::LDS_BYTES, stream); }
#elif defined(MK_SELFCHK)
    for (int pass = 0; pass < MK_SELFCHK; ++pass) {
        { if (pass > 0 && hipMemsetAsync((char*)d_ws, 0, 128 * 1024, stream) != hipSuccess) return;
            if (hipMemsetAsync((char*)d_ws + mk::MiB, 0xAA, mk::WS_END - mk::MiB, stream) != hipSuccess) return; if (hipMemsetAsync(d_out, 0xAA, (size_t)mk::NTOK * mk::D * 4, stream) != hipSuccess) return; }
        a.ph_lo = 0; a.ph_hi = mk::NPH | (pass << 8);
        (void)hipLaunchKernel(fn_table[0], dim3(grid), dim3(512), kargs, mk::LDS_BYTES, stream); }
#elif MK_ONE_LAUNCH
    a.ph_lo = 0; a.ph_hi = mk::NPH;
    (void)hipLaunchKernel(fn_table[0], dim3(grid), dim3(512), kargs, mk::LDS_BYTES, stream);
#else
    for (int ph = 0; ph < mk::NPH; ++ph) { a.ph_lo = ph; a.ph_hi = ph + 1; (void)hipLaunchKernel(fn_table[ph], dim3(grid), dim3(512), kargs, mk::LDS_BYTES, stream); }
#endif
}
```
